# Optimizing an MI355X kernel written in HIP

```python
import math
import jax, jax.numpy as jnp
from jax import lax
import numpy as np

D_MODEL = 1024
BATCH = 8
SEQ = 4096
DEPTH = 1

EXPAND = 2
D_MIX = EXPAND * D_MODEL
D_CONV = D_MIX // 2
D_LRU = D_MIX - D_CONV
N_CONV_HEADS = 8
N_LRU_HEADS = 16
LRU_HEAD_DIM = D_LRU // N_LRU_HEADS
SHORT_CONV_WIDTH = 3
LRU_CONV_WIDTH = 4
RG_LRU_C = 8.0
RMS_EPS = 1e-6
IN_COLS = 4 * D_CONV + 2 * D_LRU

kernel_name = "hymba_shortconv_rglru_hybrid"


def rms_norm(x, g):
    xf = x.astype(jnp.float32)
    xf = xf * lax.rsqrt(jnp.mean(xf * xf, axis=-1, keepdims=True) + RMS_EPS)
    return xf.astype(x.dtype) * g


def headwise_rms_norm(y, n_heads, g):
    b, s, d = y.shape
    yh = y.reshape(b, s, n_heads, d // n_heads).astype(jnp.float32)
    yh = yh * lax.rsqrt(jnp.mean(yh * yh, axis=-1, keepdims=True) + RMS_EPS)
    return yh.reshape(b, s, d).astype(y.dtype) * g


def causal_depthwise_conv(u, w):
    k_width = w.shape[0]
    s = u.shape[1]
    up = jnp.pad(u, ((0, 0), (k_width - 1, 0), (0, 0)))
    out = up[:, 0:s, :] * w[0]
    for k in range(1, k_width):
        out = out + up[:, k:k + s, :] * w[k]
    return out


def short_conv_mixer(b_gate, c_gate, x_in, conv_w):
    return b_gate * causal_depthwise_conv(c_gate * x_in, conv_w)


def _lru_combine(left, right):
    a1, b1 = left
    a2, b2 = right
    return a1 * a2, a2 * b1 + b2


def rg_lru_mixer(x_in, conv_w, conv_b, w_a, b_a, w_i, b_i, lam):
    bsz, s, d = x_in.shape
    u = causal_depthwise_conv(x_in, conv_w) + conv_b
    uh = u.reshape(bsz, s, N_LRU_HEADS, LRU_HEAD_DIM)
    r = jax.nn.sigmoid(jnp.einsum('bshd,hde->bshe', uh, w_a).reshape(bsz, s, d) + b_a)
    i = jax.nn.sigmoid(jnp.einsum('bshd,hde->bshe', uh, w_i).reshape(bsz, s, d) + b_i)
    log_a = RG_LRU_C * r.astype(jnp.float32) * jax.nn.log_sigmoid(lam.astype(jnp.float32))
    a = jnp.exp(log_a)
    mult = jnp.sqrt(-jnp.expm1(2.0 * log_a))
    drive = mult * (i * u).astype(jnp.float32)
    _, h = lax.associative_scan(_lru_combine, (a, drive), axis=1)
    return h.astype(x_in.dtype)


def setup_inputs(seed: int = 0) -> dict:
    key = jax.random.key(seed)
    ks = jax.random.split(key, 16)
    f32 = jnp.float32
    x = jax.random.normal(ks[0], (BATCH, SEQ, D_MODEL), f32)
    ln_g = 1.0 + 0.02 * jax.random.normal(ks[1], (D_MODEL,), f32)
    w_in = jax.random.normal(ks[2], (D_MODEL, IN_COLS), f32) * D_MODEL ** -0.5
    conv_w = jax.random.normal(ks[3], (SHORT_CONV_WIDTH, D_CONV), f32) * SHORT_CONV_WIDTH ** -0.5
    lru_conv_w = jax.random.normal(ks[4], (LRU_CONV_WIDTH, D_LRU), f32) * LRU_CONV_WIDTH ** -0.5
    lru_conv_b = 0.02 * jax.random.normal(ks[5], (D_LRU,), f32)
    w_a = jax.random.normal(ks[6], (N_LRU_HEADS, LRU_HEAD_DIM, LRU_HEAD_DIM), f32) * LRU_HEAD_DIM ** -0.5
    b_a = 0.02 * jax.random.normal(ks[7], (D_LRU,), f32)
    w_i = jax.random.normal(ks[8], (N_LRU_HEADS, LRU_HEAD_DIM, LRU_HEAD_DIM), f32) * LRU_HEAD_DIM ** -0.5
    b_i = 0.02 * jax.random.normal(ks[9], (D_LRU,), f32)
    a_init = jax.random.uniform(ks[10], (D_LRU,), f32, minval=0.9, maxval=0.999)
    lam = jnp.log(a_init) - jnp.log1p(-a_init)
    conv_out_g = 1.0 + 0.02 * jax.random.normal(ks[11], (D_CONV,), f32)
    lru_out_g = 1.0 + 0.02 * jax.random.normal(ks[12], (D_LRU,), f32)
    w_out = jax.random.normal(ks[13], (D_MIX, D_MODEL), f32) * D_MIX ** -0.5
    final_g = 1.0 + 0.02 * jax.random.normal(ks[14], (D_MODEL,), f32)
    return {"x": x, "ln_g": ln_g, "w_in": w_in, "conv_w": conv_w,
            "lru_conv_w": lru_conv_w, "lru_conv_b": lru_conv_b,
            "w_a": w_a, "b_a": b_a, "w_i": w_i, "b_i": b_i, "lam": lam,
            "conv_out_g": conv_out_g, "lru_out_g": lru_out_g,
            "w_out": w_out, "final_g": final_g}


def reference(x, ln_g, w_in, conv_w, lru_conv_w, lru_conv_b, w_a, b_a, w_i, b_i,
              lam, conv_out_g, lru_out_g, w_out, final_g):
    h = x
    for _ in range(DEPTH):
        xn = rms_norm(h, ln_g)
        proj = jnp.einsum('bsd,de->bse', xn, w_in)
        splits = [D_CONV, 2 * D_CONV, 3 * D_CONV, 4 * D_CONV, 4 * D_CONV + D_LRU]
        b_gate, c_gate, x_conv, g_conv, x_lru, g_lru = jnp.split(proj, splits, axis=-1)
        y_conv = short_conv_mixer(b_gate, c_gate, x_conv, conv_w)
        y_conv = headwise_rms_norm(y_conv, N_CONV_HEADS, conv_out_g) * jax.nn.silu(g_conv)
        y_lru = rg_lru_mixer(x_lru, lru_conv_w, lru_conv_b, w_a, b_a, w_i, b_i, lam)
        y_lru = headwise_rms_norm(y_lru, N_LRU_HEADS, lru_out_g) * jax.nn.silu(g_lru)
        y = jnp.concatenate([y_conv, y_lru], axis=-1)
        h = h + jnp.einsum('bse,ed->bsd', y, w_out)
    return rms_norm(h, final_g)
```

```cpp
#include <hip/hip_runtime.h>
#include <hip/hip_cooperative_groups.h>
#include <cstdio>
namespace cg = cooperative_groups;

#define LAS __attribute__((address_space(3)))
typedef unsigned short bf16_t;
typedef short bf16x8 __attribute__((ext_vector_type(8)));
typedef float f32x4 __attribute__((ext_vector_type(4)));
typedef float f32x16 __attribute__((ext_vector_type(16)));
typedef unsigned u32x4 __attribute__((ext_vector_type(4)));
typedef unsigned u32x2 __attribute__((ext_vector_type(2)));

constexpr int T_TOK = 32768, SEQ = 4096, DM = 1024, NPROJ = 6144, DMIX = 2048;
constexpr float RMS_EPS = 1e-6f;
constexpr int COL_B = 0, COL_C = 1024, COL_XC = 2048, COL_XL = 3072, COL_GC = 4096, COL_GL = 5120;
constexpr size_t MiB = 1u << 20;
constexpr size_t WS_CTL = 0, CTL_BYTES = 4096;
constexpr size_t WS_WIN = 2 * MiB;
constexpr size_t WS_WOUT = 14 * MiB;
constexpr size_t WS_WG = 18 * MiB;
constexpr size_t WS_SS = 20 * MiB;
constexpr size_t WS_XN = 32 * MiB;
constexpr size_t WS_PROJ = 96 * MiB;
constexpr size_t WS_END = 480 * MiB;
constexpr int LDS_BYTES = 147456;
constexpr int NTHREADS = 512;

struct Args { const float* in[15]; float* out; unsigned char* ws; };
enum { I_X = 0, I_LNG, I_WIN, I_CONVW, I_LCW, I_LCB, I_WA, I_BA, I_WI, I_BI, I_LAM, I_CG, I_LG, I_WOUT, I_FG };

__device__ __forceinline__ unsigned cvt_pk_bf16(float lo, float hi) { unsigned r; asm volatile("v_cvt_pk_bf16_f32 %0, %1, %2" : "=v"(r) : "v"(lo), "v"(hi)); return r; }
__device__ __forceinline__ float bf_lo(unsigned w) { return __uint_as_float(w << 16); }
__device__ __forceinline__ float bf_hi(unsigned w) { return __uint_as_float(w & 0xffff0000u); }
__device__ __forceinline__ float wave_sum(float v) {
#pragma unroll
    for (int o = 1; o < 64; o <<= 1) v += __shfl_xor(v, o);
    return v;
}
__device__ __forceinline__ float sigmoid_fast(float x) { return __builtin_amdgcn_rcpf(1.0f + __builtin_amdgcn_exp2f(-1.44269504f * x)); }
__device__ __forceinline__ void unpack8(const u32x4 v, float (&f)[8]) {
    f[0] = bf_lo(v.x); f[1] = bf_hi(v.x); f[2] = bf_lo(v.y); f[3] = bf_hi(v.y); f[4] = bf_lo(v.z); f[5] = bf_hi(v.z); f[6] = bf_lo(v.w); f[7] = bf_hi(v.w);
}

namespace pg8 {
constexpr int BM = 256, BK = 64, HALF = 128, HTB = HALF * BK * 2, STAGE_BYTES = 8 * HTB, NXCD = 8, WGM = 8;
__host__ __device__ __forceinline__ int lds_byte(int r, int c) { const int st = (r >> 4) * 2 + (c >> 5), rr = r & 15, cc = c & 31, ob = rr * 64 + cc * 2; return st * 1024 + (ob ^ (((ob >> 9) & 1) << 5)); }
__host__ __device__ __forceinline__ void stage_rc(int b, int& R, int& C) { const int st = b / 1024, sb = b % 1024, swz = sb ^ (((sb >> 9) & 1) << 5); R = (st >> 1) * 16 + swz / 64; C = (st & 1) * 32 + (swz % 64) / 2; }
__host__ __device__ __forceinline__ int perm32(int rho) { const int n = rho >> 4, i = rho & 15; return 8 * (i >> 2) + 4 * n + (i & 3); }

struct Unit { int pm, pn; };
struct Gemm { const bf16_t* A; const bf16_t* Bt; int M, N, K, lda; };

struct StaticOrder {
    int nM, nN, nwg, G, c;
    __device__ void init(int M, int N, int G_, int c_) { nM = M / BM; nN = N / BM; nwg = nM * nN; G = G_; c = c_; }
    __device__ bool next(int i, Unit& u) const {
        const long L = (long)i * G + c; if (L >= nwg) return false;
        int wgid = (int)L; { const int q = nwg / NXCD, r = nwg % NXCD, xcd = wgid % NXCD, off = wgid / NXCD; wgid = (xcd < r ? xcd * (q + 1) : r * (q + 1) + (xcd - r) * q) + off; }
        const int nig = WGM * nN, gid = wgid / nig, fm = gid * WGM, gsz = (nM - fm) < WGM ? (nM - fm) : WGM;
        u.pm = fm + ((wgid % nig) % gsz); u.pn = (wgid % nig) / gsz; return true;
    }
};

struct EpiBf16 {
    static constexpr bool PERM = true;
    bf16_t* O; int ldc;
    __device__ __forceinline__ void operator()(const f32x4 (&acc)[2][2][4][2], const Unit& u, int wr, int wc, int fr, int fq) const {
        const int row0 = u.pm * BM + wr * 64 + fr; const int col0 = u.pn * BM + wc * 32 + 8 * fq;
#pragma unroll
        for (int ai = 0; ai < 2; ++ai)
#pragma unroll
            for (int m = 0; m < 4; ++m) { bf16_t* rowp = O + (size_t)(row0 + ai * HALF + m * 16) * ldc + col0;
#pragma unroll
                for (int bj = 0; bj < 2; ++bj) { const f32x4 v0 = acc[ai][bj][m][0], v1 = acc[ai][bj][m][1];
                    u32x4 w; w.x = cvt_pk_bf16(v0[0], v0[1]); w.y = cvt_pk_bf16(v0[2], v0[3]); w.z = cvt_pk_bf16(v1[0], v1[1]); w.w = cvt_pk_bf16(v1[2], v1[3]);
                    *(u32x4*)(rowp + bj * HALF) = w; } }
    }
};
struct EpiResid {
    static constexpr bool PERM = false;
    const float* x; float* out; float* ss;
    __device__ __forceinline__ void operator()(const f32x4 (&acc)[2][2][4][2], const Unit& u, int wr, int wc, int fr, int fq) const {
        const int row0 = u.pm * BM + wr * 64 + fr, col0 = u.pn * BM + wc * 32 + 4 * fq;
#pragma unroll
        for (int ai = 0; ai < 2; ++ai)
#pragma unroll
            for (int m = 0; m < 4; ++m) { const int row = row0 + ai * HALF + m * 16; const size_t off = (size_t)row * DM + col0; float s = 0.f;
#pragma unroll
                for (int bj = 0; bj < 2; ++bj)
#pragma unroll
                    for (int n = 0; n < 2; ++n) { const f32x4 xv = *(const f32x4*)(x + off + bj * HALF + n * 16); const f32x4 o = xv + acc[ai][bj][m][n];
                        *(f32x4*)(out + off + bj * HALF + n * 16) = o; s += (o[0] * o[0] + o[1] * o[1]) + (o[2] * o[2] + o[3] * o[3]); }
                s += __shfl_xor(s, 16); s += __shfl_xor(s, 32);
                if (fq == 0) ss[(size_t)row * 16 + u.pn * 4 + wc] = s; }
    }
};

template <class Epi>
__device__ __forceinline__ void gemm_phase(LAS unsigned char* lds, const Gemm g, const StaticOrder& S, const Epi& E) {
    const int tid = threadIdx.x, wid = __builtin_amdgcn_readfirstlane(tid >> 6), lane = tid & 63, wr = wid >> 2, wc = wid & 3, fr = lane & 15, fq = lane >> 4;
    const int K = g.K, nt = K / BK, lda = g.lda;
    unsigned voffA[2], voffB[2];
#pragma unroll
    for (int i = 0; i < 2; ++i) { int R, C; stage_rc(tid * 16 + i * 8192, R, C); const int Rb = Epi::PERM ? ((R & ~31) + perm32(R & 31)) : R;
        voffA[i] = (unsigned)(R * lda + C) * 2u; voffB[i] = (unsigned)(Rb * K + C) * 2u; }
    const size_t kstep = (size_t)(BK * 2);
    const size_t hstepA = (size_t)HALF * lda * 2, hstepB = (size_t)HALF * K * 2;
    const size_t tstepA = 2 * hstepA, tstepB = 2 * hstepB;
    const unsigned ldsw = (unsigned)wid * 1024u;
    const int aoff = lds_byte(wr * 64 + fr, fq * 8), boff = lds_byte(wc * 32 + fr, fq * 8);
#define PG8_SA(b, h) (((b) * 2 + (h)) * HTB)
#define PG8_SB(b, h) ((4 + (b) * 2 + (h)) * HTB)
#define PG8_STAGE(bufoff, gbase, voff) do { _Pragma("unroll") for (int _i = 0; _i < 2; ++_i) \
        __builtin_amdgcn_global_load_lds((const unsigned*)((const char*)(gbase) + (voff)[_i]), (LAS unsigned*)(lds + (bufoff) + ldsw + _i * 8192), 16, 0, 0); } while (0)
#define PG8_LDA(dst, b, h) do { _Pragma("unroll") for (int m = 0; m < 4; ++m) _Pragma("unroll") for (int k = 0; k < 2; ++k) dst[m][k] = *(const LAS bf16x8*)(lds + PG8_SA(b, h) + aoff + m * 2048 + k * 1024); } while (0)
#define PG8_LDB(dst, b, h) do { _Pragma("unroll") for (int n = 0; n < 2; ++n) _Pragma("unroll") for (int k = 0; k < 2; ++k) dst[n][k] = *(const LAS bf16x8*)(lds + PG8_SB(b, h) + boff + n * 2048 + k * 1024); } while (0)
#define PG8_MMA(ai, bj, At, Bt) do { __builtin_amdgcn_s_setprio(1); _Pragma("unroll") for (int m = 0; m < 4; ++m) _Pragma("unroll") for (int n = 0; n < 2; ++n) _Pragma("unroll") for (int k = 0; k < 2; ++k) \
        acc[ai][bj][m][n] = __builtin_amdgcn_mfma_f32_16x16x32_bf16(Bt[n][k], At[m][k], acc[ai][bj][m][n], 0, 0, 0); __builtin_amdgcn_s_setprio(0); } while (0)
#define PG8_WAIT_V(n) asm volatile("s_waitcnt vmcnt(" #n ")" ::: "memory")
#define PG8_WAIT_L(n) asm volatile("s_waitcnt lgkmcnt(" #n ")" ::: "memory")
#define PG8_BAR __builtin_amdgcn_s_barrier()
#define PG8_SCHED __builtin_amdgcn_sched_barrier(0)
    Unit cur, nxt; int ui = 0;
    if (!S.next(0, cur)) return;
    f32x4 acc[2][2][4][2];
#pragma unroll
    for (int a = 0; a < 2; ++a)
#pragma unroll
        for (int b = 0; b < 2; ++b)
#pragma unroll
            for (int m = 0; m < 4; ++m)
#pragma unroll
                for (int n = 0; n < 2; ++n) acc[a][b][m][n] = (f32x4){0.f, 0.f, 0.f, 0.f};
    bf16x8 At[4][2], B0[2][2], B1[2][2];
    const char* cA = (const char*)g.A + (size_t)cur.pm * tstepA; const char* cB = (const char*)g.Bt + (size_t)cur.pn * tstepB;
    PG8_STAGE(PG8_SB(0, 0), cB, voffB); PG8_STAGE(PG8_SA(0, 0), cA, voffA); PG8_STAGE(PG8_SB(0, 1), cB + hstepB, voffB); PG8_STAGE(PG8_SA(0, 1), cA + hstepA, voffA);
    if (wr == 1) PG8_BAR;
    PG8_WAIT_V(4); PG8_BAR;
    PG8_STAGE(PG8_SB(1, 0), cB + kstep, voffB); PG8_STAGE(PG8_SA(1, 0), cA + kstep, voffA); PG8_STAGE(PG8_SB(1, 1), cB + hstepB + kstep, voffB);
    PG8_WAIT_V(6); PG8_BAR;
    for (;;) {
        const bool has_next = S.next(ui + 1, nxt);
        const char* nA = has_next ? (const char*)g.A + (size_t)nxt.pm * tstepA : cA; const char* nB = has_next ? (const char*)g.Bt + (size_t)nxt.pn * tstepB : cB;
        for (int t = 0; t < nt; t += 2) {
            const bool last = (t == nt - 2);
            const char* a1 = cA + (size_t)(t + 1) * kstep;
            const char* a2 = last ? nA : cA + (size_t)(t + 2) * kstep; const char* b2 = last ? nB : cB + (size_t)(t + 2) * kstep;
            const char* a3 = a2 + kstep; const char* b3 = b2 + kstep;
            PG8_LDB(B0, 0, 0); PG8_SCHED; PG8_LDA(At, 0, 0); PG8_STAGE(PG8_SA(1, 1), a1 + hstepA, voffA);
            PG8_WAIT_L(8); PG8_BAR; PG8_WAIT_L(0); PG8_MMA(0, 0, At, B0); PG8_BAR; PG8_SCHED;
            PG8_LDB(B1, 0, 1); PG8_STAGE(PG8_SB(0, 0), b2, voffB);
            PG8_BAR; PG8_WAIT_L(0); PG8_MMA(0, 1, At, B1); PG8_BAR;
            PG8_LDA(At, 0, 1); PG8_STAGE(PG8_SA(0, 0), a2, voffA);
            PG8_BAR; PG8_WAIT_L(0); PG8_MMA(1, 0, At, B0); PG8_BAR; PG8_SCHED;
            PG8_STAGE(PG8_SB(0, 1), b2 + hstepB, voffB);
            PG8_WAIT_V(6); PG8_BAR; PG8_MMA(1, 1, At, B1); PG8_BAR;
            PG8_LDB(B0, 1, 0); PG8_SCHED; PG8_LDA(At, 1, 0); PG8_STAGE(PG8_SA(0, 1), a2 + hstepA, voffA);
            PG8_WAIT_L(8); PG8_BAR; PG8_WAIT_L(0); PG8_MMA(0, 0, At, B0); PG8_BAR; PG8_SCHED;
            PG8_LDB(B1, 1, 1); PG8_STAGE(PG8_SB(1, 0), b3, voffB);
            PG8_BAR; PG8_WAIT_L(0); PG8_MMA(0, 1, At, B1); PG8_BAR;
            PG8_LDA(At, 1, 1); PG8_STAGE(PG8_SA(1, 0), a3, voffA);
            PG8_BAR; PG8_WAIT_L(0); PG8_MMA(1, 0, At, B0); PG8_BAR; PG8_SCHED;
            PG8_STAGE(PG8_SB(1, 1), b3 + hstepB, voffB);
            PG8_WAIT_V(6); PG8_BAR; PG8_MMA(1, 1, At, B1); PG8_BAR;
        }
        E(acc, cur, wr, wc, fr, fq);
        if (!has_next) break;
#pragma unroll
        for (int a = 0; a < 2; ++a)
#pragma unroll
            for (int b = 0; b < 2; ++b)
#pragma unroll
                for (int m = 0; m < 4; ++m)
#pragma unroll
                    for (int n = 0; n < 2; ++n) acc[a][b][m][n] = (f32x4){0.f, 0.f, 0.f, 0.f};
        cur = nxt; cA = nA; cB = nB; ++ui;
    }
    PG8_WAIT_V(0);
    if (wr == 0) PG8_BAR;
    PG8_BAR;
#undef PG8_SA
#undef PG8_SB
#undef PG8_STAGE
#undef PG8_LDA
#undef PG8_LDB
#undef PG8_MMA
#undef PG8_WAIT_V
#undef PG8_WAIT_L
#undef PG8_BAR
#undef PG8_SCHED
}
}

__device__ __forceinline__ void p0_transpose_item(const float* W, int ldw, int k0, int ncol0, bf16_t* WT, int ldt, int drow0, int dk0, LAS float* scr, int lane) {
#pragma unroll 8
    for (int i = 0; i < 32; ++i) { const int kk = 2 * i + (lane >> 5); scr[kk * 33 + (lane & 31)] = W[(size_t)(k0 + kk) * ldw + ncol0 + (lane & 31)]; }
    asm volatile("s_waitcnt lgkmcnt(0)" ::: "memory");
    const int c = lane & 7;
#pragma unroll
    for (int j = 0; j < 4; ++j) { const int n = (lane >> 3) + 8 * j; const LAS float* s = scr + (8 * c) * 33 + n;
        u32x4 o; o.x = cvt_pk_bf16(s[0 * 33], s[1 * 33]); o.y = cvt_pk_bf16(s[2 * 33], s[3 * 33]); o.z = cvt_pk_bf16(s[4 * 33], s[5 * 33]); o.w = cvt_pk_bf16(s[6 * 33], s[7 * 33]);
        *(u32x4*)(WT + (size_t)(drow0 + n) * ldt + dk0 + 8 * c) = o; }
    asm volatile("s_waitcnt lgkmcnt(0)" ::: "memory");
}

__device__ __forceinline__ void phase0(const Args& a, LAS unsigned char* lds, int wave, int lane) {
    LAS float* scr = (LAS float*)(lds + wave * 16384);
    const int gw = blockIdx.x * 8 + wave, NGW = gridDim.x * 8;
    bf16_t* win_t = (bf16_t*)(a.ws + WS_WIN); bf16_t* wout_t = (bf16_t*)(a.ws + WS_WOUT); bf16_t* wg = (bf16_t*)(a.ws + WS_WG);
    constexpr int I_IN = 16 * 192, I_OUT = 32 * 32, I_G = 64;
    for (int it = gw; it < I_IN + I_OUT + I_G; it += NGW) {
        int r = it;
        if (r < I_IN) { const int kb = r / 192, nb = r % 192; const int og = nb / 32;
            const int ng = (og == 3) ? 4 : (og == 4 ? 3 : og);
            p0_transpose_item(a.in[I_WIN], NPROJ, kb * 64, nb * 32, win_t, DM, ng * 1024 + (nb % 32) * 32, kb * 64, scr, lane); continue; }
        r -= I_IN;
        if (r < I_OUT) { const int kb = r / 32, nb = r % 32; p0_transpose_item(a.in[I_WOUT], DM, kb * 64, nb * 32, wout_t, DMIX, nb * 32, kb * 64, scr, lane); continue; }
        r -= I_OUT;
        { const int mat = r / 32, h = (r % 32) / 2, nb = r & 1; const float* W = (mat ? a.in[I_WI] : a.in[I_WA]) + h * 4096;
          p0_transpose_item(W, 64, 0, nb * 32, wg + mat * 65536 + h * 4096, 64, nb * 32, 0, scr, lane); }
    }
    const float* x = a.in[I_X]; bf16_t* xn = (bf16_t*)(a.ws + WS_XN);
    f32x4 gv[4];
#pragma unroll
    for (int j = 0; j < 4; ++j) gv[j] = ((const f32x4*)a.in[I_LNG])[lane + 64 * j];
    for (int m = gw; m < T_TOK; m += NGW) {
        const f32x4* xr = (const f32x4*)(x + (size_t)m * DM) + lane;
        f32x4 v[4]; float s = 0.f;
#pragma unroll
        for (int j = 0; j < 4; ++j) { v[j] = xr[64 * j]; s += (v[j].x * v[j].x + v[j].y * v[j].y) + (v[j].z * v[j].z + v[j].w * v[j].w); }
        const float rstd = 1.0f / sqrtf(wave_sum(s) * (1.f / DM) + RMS_EPS);
        u32x2* o8 = (u32x2*)(xn + (size_t)m * DM) + lane;
#pragma unroll
        for (int j = 0; j < 4; ++j) { u32x2 w; w.x = cvt_pk_bf16(v[j].x * rstd * gv[j].x, v[j].y * rstd * gv[j].y); w.y = cvt_pk_bf16(v[j].z * rstd * gv[j].z, v[j].w * rstd * gv[j].w); o8[64 * j] = w; }
    }
}

__device__ __forceinline__ void conv_item(const Args& a, bf16_t* proj, int item, int wave, int lane) {
    const int q = lane >> 4, c8 = lane & 15, ch0 = wave * 128 + c8 * 8;
    float w0[8], w1[8], w2[8], gn[8];
    { const float* cw = a.in[I_CONVW] + ch0; const float* cg_ = a.in[I_CG] + ch0;
#pragma unroll
      for (int j = 0; j < 8; ++j) { w0[j] = cw[j]; w1[j] = cw[1024 + j]; w2[j] = cw[2048 + j]; gn[j] = cg_[j]; } }
    const int tok0 = item * 64 + q * 16;
    bf16_t* base = proj + (size_t)tok0 * NPROJ + ch0;
    float p2[8], p1[8];
    if ((tok0 & (SEQ - 1)) == 0) {
#pragma unroll
        for (int j = 0; j < 8; ++j) { p2[j] = 0.f; p1[j] = 0.f; }
    } else {
        const u32x4 c2 = *(const u32x4*)(base - 2 * NPROJ + COL_C), x2 = *(const u32x4*)(base - 2 * NPROJ + COL_XC);
        const u32x4 c1 = *(const u32x4*)(base - 1 * NPROJ + COL_C), x1 = *(const u32x4*)(base - 1 * NPROJ + COL_XC);
        float fc[8], fx[8];
        unpack8(c2, fc); unpack8(x2, fx);
#pragma unroll
        for (int j = 0; j < 8; ++j) p2[j] = fc[j] * fx[j];
        unpack8(c1, fc); unpack8(x1, fx);
#pragma unroll
        for (int j = 0; j < 8; ++j) p1[j] = fc[j] * fx[j];
    }
#pragma unroll 4
    for (int i = 0; i < 16; ++i) {
        bf16_t* rp = base + (size_t)i * NPROJ;
        const u32x4 vb = *(const u32x4*)(rp + COL_B), vc = *(const u32x4*)(rp + COL_C), vx = *(const u32x4*)(rp + COL_XC), vg = *(const u32x4*)(rp + COL_GC);
        float fb[8], fc[8], fx[8], fg[8], y[8];
        unpack8(vb, fb); unpack8(vc, fc); unpack8(vx, fx); unpack8(vg, fg);
        float ss = 0.f;
#pragma unroll
        for (int j = 0; j < 8; ++j) { const float cx = fc[j] * fx[j]; const float cv = w0[j] * p2[j] + w1[j] * p1[j] + w2[j] * cx; y[j] = fb[j] * cv; ss += y[j] * y[j]; p2[j] = p1[j]; p1[j] = cx; }
        ss += __shfl_xor(ss, 1); ss += __shfl_xor(ss, 2); ss += __shfl_xor(ss, 4); ss += __shfl_xor(ss, 8);
        const float rstd = 1.0f / sqrtf(ss * (1.f / 128.f) + RMS_EPS);
        float o[8];
#pragma unroll
        for (int j = 0; j < 8; ++j) o[j] = y[j] * rstd * gn[j] * (fg[j] * sigmoid_fast(fg[j]));
        u32x4 w; w.x = cvt_pk_bf16(o[0], o[1]); w.y = cvt_pk_bf16(o[2], o[3]); w.z = cvt_pk_bf16(o[4], o[5]); w.w = cvt_pk_bf16(o[6], o[7]);
        *(u32x4*)(rp + COL_GC) = w;
    }
}

constexpr int L_GW = 0;
constexpr int L_CW = 18432;
constexpr int L_AGG = 20992;
constexpr int L_WT = 29184;
constexpr int WT_BYTES = 8704;
static_assert(L_WT + 8 * WT_BYTES <= 131072, "lds");

__device__ __forceinline__ void lru_item(const Args& a, bf16_t* proj, LAS unsigned char* lds, int b, int h, int tid, int wave, int lane) {
    {
        const bf16_t* wg = (const bf16_t*)(a.ws + WS_WG);
        for (int i = tid; i < 1024; i += NTHREADS) { const int mat = i >> 9, e = (i >> 3) & 63, c = i & 7;
            const u32x4 v = *(const u32x4*)(wg + mat * 65536 + h * 4096 + e * 64 + c * 8);
            *(LAS u32x4*)(lds + L_GW + mat * 9216 + e * 144 + c * 16) = v; }
        LAS float* cw = (LAS float*)(lds + L_CW);
        if (tid < 256) cw[tid] = a.in[I_LCW][(tid >> 6) * 1024 + h * 64 + (tid & 63)];
        else if (tid < 320) { const int c = tid - 256, gc = h * 64 + c;
            cw[256 + c] = a.in[I_LCB][gc]; cw[320 + c] = a.in[I_BA][gc]; cw[384 + c] = a.in[I_BI][gc];
            const float lam = a.in[I_LAM][gc];
            const float logsig = (lam >= 0.f) ? -log1pf(expf(-lam)) : (lam - log1pf(expf(lam)));
            cw[448 + c] = 8.0f * logsig * 1.44269504f;
            cw[512 + c] = a.in[I_LG][gc]; }
    }
    __syncthreads();
    const int r = lane & 31, hh = lane >> 5;
    LAS unsigned char* wt = lds + L_WT + wave * WT_BYTES;
    LAS const float* cw = (LAS const float*)(lds + L_CW);
    bf16x8 I0, I1;
    {
        u32x4 t0 = (u32x4){0u, 0u, 0u, 0u}, t1 = t0;
        const int j0 = r - 8 * hh, j1 = r - 16 - 8 * hh;
#pragma unroll
        for (int d = 0; d < 4; ++d) {
            t0[d] = (j0 == 2 * d) ? 0x00003F80u : ((j0 == 2 * d + 1) ? 0x3F800000u : 0u);
            t1[d] = (j1 == 2 * d) ? 0x00003F80u : ((j1 == 2 * d + 1) ? 0x3F800000u : 0u);
        }
        I0 = __builtin_bit_cast(bf16x8, t0); I1 = __builtin_bit_cast(bf16x8, t1);
    }
    float ba[2], bi[2], cf[2];
#pragma unroll
    for (int n = 0; n < 2; ++n) { ba[n] = cw[320 + 32 * n + r]; bi[n] = cw[384 + 32 * n + r]; cf[n] = cw[448 + 32 * n + r]; }
    float carry[2] = {0.f, 0.f};

    const bf16_t* xl_base = proj + (size_t)b * SEQ * NPROJ + COL_XL + h * 64;
    bf16_t* gl_base = proj + (size_t)b * SEQ * NPROJ + COL_GL + h * 64;
    u32x4 xr[5];
#define LOAD_X(seg_) do { const int s0_ = (seg_) * 256 + wave * 32; _Pragma("unroll") for (int i = 0; i < 5; ++i) { const int idx = lane + 64 * i, row = idx >> 3, c = idx & 7; const int s = s0_ - 3 + row; \
        xr[i] = (u32x4){0u, 0u, 0u, 0u}; if (idx < 280 && s >= 0) xr[i] = *(const u32x4*)(xl_base + (size_t)s * NPROJ + c * 8); } } while (0)
    LOAD_X(0);
    for (int seg = 0; seg < 16; ++seg) {
        const int s0 = seg * 256 + wave * 32;
#pragma unroll
        for (int i = 0; i < 5; ++i) { const int idx = lane + 64 * i, row = idx >> 3, c = idx & 7; if (idx < 280) *(LAS u32x4*)(wt + row * 144 + c * 16) = xr[i]; }
        if (seg + 1 < 16) LOAD_X(seg + 1);
        asm volatile("s_waitcnt lgkmcnt(0)" ::: "memory");
        bf16x8 Af[4];
#pragma unroll
        for (int s = 0; s < 4; ++s) {
            const int c0 = 16 * s + 8 * hh;
            float u8[8];
            { const f32x4 b0 = *(LAS const f32x4*)(cw + 256 + c0), b1 = *(LAS const f32x4*)(cw + 256 + c0 + 4);
              u8[0] = b0[0]; u8[1] = b0[1]; u8[2] = b0[2]; u8[3] = b0[3]; u8[4] = b1[0]; u8[5] = b1[1]; u8[6] = b1[2]; u8[7] = b1[3]; }
#pragma unroll
            for (int k = 0; k < 4; ++k) {
                const u32x4 xv = *(LAS const u32x4*)(wt + (r + k) * 144 + c0 * 2);
                const f32x4 wv0 = *(LAS const f32x4*)(cw + k * 64 + c0), wv1 = *(LAS const f32x4*)(cw + k * 64 + c0 + 4);
                float fx[8]; unpack8(xv, fx);
                u8[0] += wv0[0] * fx[0]; u8[1] += wv0[1] * fx[1]; u8[2] += wv0[2] * fx[2]; u8[3] += wv0[3] * fx[3];
                u8[4] += wv1[0] * fx[4]; u8[5] += wv1[1] * fx[5]; u8[6] += wv1[2] * fx[6]; u8[7] += wv1[3] * fx[7];
            }
            u32x4 pk; pk.x = cvt_pk_bf16(u8[0], u8[1]); pk.y = cvt_pk_bf16(u8[2], u8[3]); pk.z = cvt_pk_bf16(u8[4], u8[5]); pk.w = cvt_pk_bf16(u8[6], u8[7]);
            Af[s] = __builtin_bit_cast(bf16x8, pk);
        }
        u32x4 gl[4];
#pragma unroll
        for (int n = 0; n < 2; ++n) {
            float hl[16], pc[16];
            f32x16 accR, accI, accU;
#pragma unroll
            for (int j = 0; j < 16; ++j) { accR[j] = 0.f; accI[j] = 0.f; accU[j] = 0.f; }
#pragma unroll
            for (int s = 0; s < 4; ++s) {
                const bf16x8 Ba = *(LAS const bf16x8*)(lds + L_GW + (32 * n + r) * 144 + (16 * s + 8 * hh) * 2);
                const bf16x8 Bi = *(LAS const bf16x8*)(lds + L_GW + 9216 + (32 * n + r) * 144 + (16 * s + 8 * hh) * 2);
                accR = __builtin_amdgcn_mfma_f32_32x32x16_bf16(Af[s], Ba, accR, 0, 0, 0);
                accI = __builtin_amdgcn_mfma_f32_32x32x16_bf16(Af[s], Bi, accI, 0, 0, 0);
            }
            accU = __builtin_amdgcn_mfma_f32_32x32x16_bf16(Af[2 * n], I0, accU, 0, 0, 0);
            accU = __builtin_amdgcn_mfma_f32_32x32x16_bf16(Af[2 * n + 1], I1, accU, 0, 0, 0);
            float cp = 1.f, ch = 0.f;
#pragma unroll
            for (int g = 0; g < 4; ++g) {
                float P = 1.f, H = 0.f;
#pragma unroll
                for (int i = 0; i < 4; ++i) { const int j = 4 * g + i;
                    const float rr = sigmoid_fast(accR[j] + ba[n]);
                    const float ii = sigmoid_fast(accI[j] + bi[n]);
                    const float l2 = rr * cf[n];
                    const float aa = __builtin_amdgcn_exp2f(l2);
                    const float t = l2 * 1.38629436f;
                    const float em_small = -t * (1.0f + t * (0.5f + t * (0.16666667f + t * 0.041666667f)));
                    const float one_m = (t > -0.0625f) ? em_small : (1.0f - aa * aa);
                    const float dd = __builtin_amdgcn_sqrtf(one_m) * ii * accU[j];
                    H = aa * H + dd; P = P * aa; hl[j] = H; pc[j] = P; }
                const float oP = __shfl_xor(P, 32), oH = __shfl_xor(H, 32);
                const float A1 = hh ? oP : P, H1 = hh ? oH : H, A2 = hh ? P : oP, H2 = hh ? H : oH;
                const float cp1 = cp * A1, ch1 = A1 * ch + H1;
                const float inP = hh ? cp1 : cp, inH = hh ? ch1 : ch;
#pragma unroll
                for (int i = 0; i < 4; ++i) { const int j = 4 * g + i; hl[j] += pc[j] * inH; pc[j] *= inP; }
                cp = cp1 * A2; ch = A2 * ch1 + H2;
            }
            typedef float f32x2 __attribute__((ext_vector_type(2)));
            if (hh == 0) *(LAS f32x2*)(lds + L_AGG + ((n * 8 + wave) * 64 + 32 * n + r) * 8) = (f32x2){cp, ch};
            if (n == 1) {
#pragma unroll
                for (int i = 0; i < 4; ++i) { const int tok = (lane >> 3) + 8 * i, c = lane & 7; gl[i] = *(const u32x4*)(gl_base + (size_t)(s0 + tok) * NPROJ + c * 8); }
            }
            __syncthreads();
            float c = carry[n], cin = 0.f;
#pragma unroll
            for (int w = 0; w < 8; ++w) {
                const f32x2 ag = *(LAS const f32x2*)(lds + L_AGG + ((n * 8 + w) * 64 + 32 * n + r) * 8);
                cin = (w == wave) ? c : cin; c = ag.x * c + ag.y; }
            carry[n] = c;
#pragma unroll
            for (int j = 0; j < 16; ++j) { const int row = (j & 3) + 8 * (j >> 2) + 4 * hh;
                *(LAS float*)(wt + row * 272 + (32 * n + r) * 4) = hl[j] + pc[j] * cin; }
        }
        asm volatile("s_waitcnt lgkmcnt(0)" ::: "memory");
#pragma unroll
        for (int i = 0; i < 4; ++i) {
            const int tok = (lane >> 3) + 8 * i, c = lane & 7;
            const f32x4 h0 = *(LAS const f32x4*)(wt + tok * 272 + c * 32), h1 = *(LAS const f32x4*)(wt + tok * 272 + c * 32 + 16);
            const f32x4 g0 = *(LAS const f32x4*)(cw + 512 + c * 8), g1 = *(LAS const f32x4*)(cw + 512 + c * 8 + 4);
            float ss = (h0[0] * h0[0] + h0[1] * h0[1]) + (h0[2] * h0[2] + h0[3] * h0[3]) + (h1[0] * h1[0] + h1[1] * h1[1]) + (h1[2] * h1[2] + h1[3] * h1[3]);
            ss += __shfl_xor(ss, 1); ss += __shfl_xor(ss, 2); ss += __shfl_xor(ss, 4);
            const float rstd = 1.0f / sqrtf(ss * (1.f / 64.f) + RMS_EPS);
            float fg[8]; unpack8(gl[i], fg);
            float o[8];
            o[0] = h0[0] * rstd * g0[0]; o[1] = h0[1] * rstd * g0[1]; o[2] = h0[2] * rstd * g0[2]; o[3] = h0[3] * rstd * g0[3];
            o[4] = h1[0] * rstd * g1[0]; o[5] = h1[1] * rstd * g1[1]; o[6] = h1[2] * rstd * g1[2]; o[7] = h1[3] * rstd * g1[3];
#pragma unroll
            for (int j = 0; j < 8; ++j) o[j] *= fg[j] * sigmoid_fast(fg[j]);
            u32x4 w; w.x = cvt_pk_bf16(o[0], o[1]); w.y = cvt_pk_bf16(o[2], o[3]); w.z = cvt_pk_bf16(o[4], o[5]); w.w = cvt_pk_bf16(o[6], o[7]);
            *(u32x4*)(gl_base + (size_t)(s0 + tok) * NPROJ + c * 8) = w;
        }
        asm volatile("s_waitcnt lgkmcnt(0)" ::: "memory");
    }
    __syncthreads();
}

__device__ __forceinline__ void phase4(const Args& a, int wave, int lane) {
    const int gw = blockIdx.x * 8 + wave, NGW = gridDim.x * 8;
    const float* ss = (const float*)(a.ws + WS_SS);
    f32x4 gv[4];
#pragma unroll
    for (int j = 0; j < 4; ++j) gv[j] = ((const f32x4*)a.in[I_FG])[lane + 64 * j];
    for (int m = gw; m < T_TOK; m += NGW) {
        float s = (lane < 16) ? ss[(size_t)m * 16 + lane] : 0.f;
        s += __shfl_xor(s, 1); s += __shfl_xor(s, 2); s += __shfl_xor(s, 4); s += __shfl_xor(s, 8);
        s = __shfl(s, 0);
        const float rstd = 1.0f / sqrtf(s * (1.f / DM) + RMS_EPS);
        f32x4* o = (f32x4*)(a.out + (size_t)m * DM) + lane;
#pragma unroll
        for (int j = 0; j < 4; ++j) { f32x4 v = o[64 * j]; v = v * rstd * gv[j]; o[64 * j] = v; }
    }
}

__global__ void __launch_bounds__(NTHREADS, 2) hymba_fwd(Args a) {
    extern __shared__ __attribute__((aligned(16))) unsigned char lds_raw[];
    LAS unsigned char* lds = (LAS unsigned char*)lds_raw;
    cg::grid_group grid = cg::this_grid();
    const int tid = threadIdx.x, lane = tid & 63, wave = __builtin_amdgcn_readfirstlane(tid >> 6);
    bf16_t* proj = (bf16_t*)(a.ws + WS_PROJ);

    phase0(a, lds, wave, lane);
    grid.sync();
    {
        pg8::Gemm g{(const bf16_t*)(a.ws + WS_XN), (const bf16_t*)(a.ws + WS_WIN), T_TOK, NPROJ, DM, DM};
        pg8::StaticOrder S; S.init(T_TOK, NPROJ, (int)gridDim.x, (int)blockIdx.x);
        pg8::EpiBf16 E{proj, NPROJ};
        pg8::gemm_phase<pg8::EpiBf16>(lds, g, S, E);
    }
    grid.sync();
    {
        for (int it = blockIdx.x; it < 128; it += gridDim.x) lru_item(a, proj, lds, it >> 4, it & 15, tid, wave, lane);
        unsigned* qctr = (unsigned*)(a.ws + WS_CTL);
        LAS unsigned* qs = (LAS unsigned*)(lds + 131072);
        for (;;) {
            if (tid == 0) qs[0] = atomicAdd(qctr, 1u);
            __syncthreads();
            const unsigned it = qs[0];
            __syncthreads();
            if (it >= (unsigned)(T_TOK / 64)) break;
            conv_item(a, proj, (int)it, wave, lane);
        }
    }
    grid.sync();
    {
        pg8::Gemm g{proj + COL_GC, (const bf16_t*)(a.ws + WS_WOUT), T_TOK, DM, DMIX, NPROJ};
        pg8::StaticOrder S; S.init(T_TOK, DM, (int)gridDim.x, (int)blockIdx.x);
        pg8::EpiResid E{a.in[I_X], a.out, (float*)(a.ws + WS_SS)};
        pg8::gemm_phase<pg8::EpiResid>(lds, g, S, E);
    }
    grid.sync();
    phase4(a, wave, lane);
}

extern "C" void kernel_launch(void* const* d_in, const int* in_sizes, int n_in, void* d_out, int out_size, void* d_ws, size_t ws_size, hipStream_t stream) {
    static int grid = 0;
    if (grid == 0) {
        if (n_in != 15 || out_size != T_TOK * DM || ws_size < WS_END) { fprintf(stderr, "kernel_launch: unexpected shapes (n_in %d out %d ws %zu)\n", n_in, out_size, ws_size); grid = -1; return; }
        int dev = 0, cus = 0, per_cu = 0;
        hipGetDevice(&dev);
        hipDeviceGetAttribute(&cus, hipDeviceAttributeMultiprocessorCount, dev);
        if (hipFuncSetAttribute((const void*)hymba_fwd, hipFuncAttributeMaxDynamicSharedMemorySize, LDS_BYTES) != hipSuccess) { fprintf(stderr, "kernel_launch: hipFuncSetAttribute failed\n"); grid = -1; return; }
        if (hipOccupancyMaxActiveBlocksPerMultiprocessor(&per_cu, (const void*)hymba_fwd, NTHREADS, LDS_BYTES) != hipSuccess || per_cu < 1) { fprintf(stderr, "kernel_launch: occupancy query says %d\n", per_cu); per_cu = 1; }
        (void)hipGetLastError();
        grid = cus;
        if (grid > 256) grid = 256;
    }
    if (grid < 0) return;
    hipMemsetAsync((char*)d_ws + WS_CTL, 0, CTL_BYTES, stream);
    Args a{};
    for (int i = 0; i < 15; ++i) a.in[i] = (const float*)d_in[i];
    a.out = (float*)d_out; a.ws = (unsigned char*)d_ws;
    void* args[] = {&a};
    hipError_t e = hipLaunchCooperativeKernel((const void*)hymba_fwd, dim3(grid), dim3(NTHREADS), args, LDS_BYTES, stream);
    if (e != hipSuccess) fprintf(stderr, "kernel_launch: cooperative launch failed: %s (grid %d)\n", hipGetErrorString(e), grid);
}
```

```cpp
#include <hip/hip_runtime.h>
#include <hip/hip_cooperative_groups.h>
#include <cstdio>
namespace cg = cooperative_groups;

#define LAS __attribute__((address_space(3)))
typedef unsigned short bf16_t;
typedef short bf16x8 __attribute__((ext_vector_type(8)));
typedef float f32x4 __attribute__((ext_vector_type(4)));
typedef float f32x16 __attribute__((ext_vector_type(16)));
typedef unsigned u32x4 __attribute__((ext_vector_type(4)));
typedef unsigned u32x2 __attribute__((ext_vector_type(2)));

constexpr int T_TOK = 32768, SEQ = 4096, DM = 1024, NPROJ = 6144, DMIX = 2048;
constexpr float RMS_EPS = 1e-6f;
constexpr int COL_B = 0, COL_C = 1024, COL_XC = 2048, COL_XL = 3072, COL_GC = 4096, COL_GL = 5120;
constexpr size_t MiB = 1u << 20;
constexpr size_t WS_CTL = 0, CTL_BYTES = 65536;
constexpr size_t WS_WIN = 2 * MiB;
constexpr size_t WS_WOUT = 14 * MiB;
constexpr size_t WS_WG = 18 * MiB;
constexpr size_t WS_SS = 20 * MiB;
constexpr size_t WS_AGG = 22 * MiB;
constexpr size_t WS_XN = 32 * MiB;
constexpr size_t WS_PROJ = 96 * MiB;
constexpr size_t WS_END = 480 * MiB;
constexpr int LDS_BYTES = 147456;
constexpr int NTHREADS = 512;
#ifndef REP0
#define REP0 1
#endif
#ifndef REP1
#define REP1 1
#endif
#ifndef REP3
#define REP3 1
#endif
#ifndef GL_EARLY
#define GL_EARLY 0
#endif
#ifndef REPLRU
#define REPLRU 1
#endif
#ifndef REPCONV
#define REPCONV 1
#endif

struct Args { const float* in[15]; float* out; unsigned char* ws; int nrep_lru, nrep_conv; };
enum { I_X = 0, I_LNG, I_WIN, I_CONVW, I_LCW, I_LCB, I_WA, I_BA, I_WI, I_BI, I_LAM, I_CG, I_LG, I_WOUT, I_FG };

__device__ __forceinline__ unsigned cvt_pk_bf16(float lo, float hi) { unsigned r; asm volatile("v_cvt_pk_bf16_f32 %0, %1, %2" : "=v"(r) : "v"(lo), "v"(hi)); return r; }
__device__ __forceinline__ float bf_lo(unsigned w) { return __uint_as_float(w << 16); }
__device__ __forceinline__ float bf_hi(unsigned w) { return __uint_as_float(w & 0xffff0000u); }
__device__ __forceinline__ float wave_sum(float v) {
#pragma unroll
    for (int o = 1; o < 64; o <<= 1) v += __shfl_xor(v, o);
    return v;
}
__device__ __forceinline__ float sigmoid_fast(float x) { return __builtin_amdgcn_rcpf(1.0f + __builtin_amdgcn_exp2f(-1.44269504f * x)); }
__device__ __forceinline__ void unpack8(const u32x4 v, float (&f)[8]) {
    f[0] = bf_lo(v.x); f[1] = bf_hi(v.x); f[2] = bf_lo(v.y); f[3] = bf_hi(v.y); f[4] = bf_lo(v.z); f[5] = bf_hi(v.z); f[6] = bf_lo(v.w); f[7] = bf_hi(v.w);
}


#define XB_TMO      128
#define XB_XCNT(j)  (256  + 64 * (j))
#define XB_XSUB(j)  (1280 + 64 * (j))
#define XB_XGEN(j)  (2304 + 64 * (j))
#define XB_TOP      3328
#define XB_TOPGEN   3392
#define XCD_BAR_WORDS 3456
#define XB_SPIN_CAP (1u << 20)
__device__ __forceinline__ unsigned xb_ld(unsigned* p)              { return __hip_atomic_load(p, __ATOMIC_RELAXED, __HIP_MEMORY_SCOPE_AGENT); }
__device__ __forceinline__ unsigned xb_add(unsigned* p, unsigned v) { return __hip_atomic_fetch_add(p, v, __ATOMIC_RELAXED, __HIP_MEMORY_SCOPE_AGENT); }
__device__ __forceinline__ unsigned xb_xcc_id() { return (unsigned)__builtin_amdgcn_s_getreg((3 << 11) | 20) & 0xFu; }
#define XB_SPIN(cond, bar) do { unsigned _sp = 0; while (cond) { __builtin_amdgcn_s_sleep(1); \
    if ((++_sp & 255u) == 0u) { if (xb_ld(&(bar)[XB_TMO])) break; if (_sp > XB_SPIN_CAP) { atomicAdd(&(bar)[XB_TMO], 1u); break; } } } } while (0)
struct XcdBarrier { unsigned* bar; unsigned x; volatile LAS unsigned* st; };
__device__ __forceinline__ XcdBarrier xcd_barrier_post(unsigned* bar, volatile LAS unsigned* st) {
    XcdBarrier b; b.bar = bar; b.x = xb_xcc_id(); b.st = st;
    if (threadIdx.x == 0) (void)xb_add(&bar[XB_XCNT(b.x)], 1u);
    return b;
}
__device__ __forceinline__ void xcd_barrier_complete(unsigned* bar, unsigned x, unsigned& nloc, unsigned& nx) {
    const unsigned G = gridDim.x * gridDim.y * gridDim.z;
    unsigned sum, cnt, mine, sp = 0u;
    for (;;) {
        sum = 0u; cnt = 0u; mine = 0u;
#pragma unroll
        for (unsigned j = 0; j < 16; ++j) { const unsigned c = xb_ld(&bar[XB_XCNT(j)]); sum += c; cnt += (c > 0u) ? 1u : 0u; mine = (j == x) ? c : mine; }
        if (sum == G) break;
        __builtin_amdgcn_s_sleep(1);
        if ((++sp & 255u) == 0u) { if (xb_ld(&bar[XB_TMO])) break; if (sp > XB_SPIN_CAP) { atomicAdd(&bar[XB_TMO], 1u); break; } }
    }
    nloc = mine > 0u ? mine : 1u; nx = cnt > 0u ? cnt : 1u;
}
__device__ __forceinline__ void xcd_barrier(const XcdBarrier& b) {
    asm volatile("s_waitcnt vmcnt(0)" ::: "memory");
    __syncthreads();
    if (threadIdx.x == 0) {
        unsigned* bar = b.bar;
        __builtin_amdgcn_s_waitcnt(0);
        unsigned nloc = b.st[0], nx = b.st[1];
        if (nloc == 0u) { xcd_barrier_complete(bar, b.x, nloc, nx); b.st[0] = nloc; b.st[1] = nx; }
        const unsigned old = xb_add(&bar[XB_XSUB(b.x)], 1u);
        const unsigned gen = old / nloc;
        if (old + 1u == (gen + 1u) * nloc) {
            __builtin_amdgcn_fence(__ATOMIC_RELEASE, "agent");
            asm volatile("s_waitcnt vmcnt(0)" ::: "memory");
            const unsigned og = xb_add(&bar[XB_TOP], 1u);
            const unsigned tg = og / nx;
            if (og + 1u == (tg + 1u) * nx) xb_add(&bar[XB_TOPGEN], 1u);
            else XB_SPIN(xb_ld(&bar[XB_TOPGEN]) == tg, bar);
            __builtin_amdgcn_fence(__ATOMIC_ACQUIRE, "agent");
            xb_add(&bar[XB_XGEN(b.x)], 1u);
            asm volatile("s_waitcnt vmcnt(0)" ::: "memory");
        } else {
            XB_SPIN(xb_ld(&bar[XB_XGEN(b.x)]) == gen, bar);
            __builtin_amdgcn_fence(__ATOMIC_ACQUIRE, "agent");
            asm volatile("s_waitcnt vmcnt(0)" ::: "memory");
        }
    }
    __syncthreads();
}

namespace pg8 {
constexpr int BM = 256, BK = 64, HALF = 128, HTB = HALF * BK * 2, STAGE_BYTES = 8 * HTB, NXCD = 8, WGM = 8;
__host__ __device__ __forceinline__ int lds_byte(int r, int c) { const int st = (r >> 4) * 2 + (c >> 5), rr = r & 15, cc = c & 31, ob = rr * 64 + cc * 2; return st * 1024 + (ob ^ (((ob >> 9) & 1) << 5)); }
__host__ __device__ __forceinline__ void stage_rc(int b, int& R, int& C) { const int st = b / 1024, sb = b % 1024, swz = sb ^ (((sb >> 9) & 1) << 5); R = (st >> 1) * 16 + swz / 64; C = (st & 1) * 32 + (swz % 64) / 2; }
__host__ __device__ __forceinline__ int perm32(int rho) { const int n = rho >> 4, i = rho & 15; return 8 * (i >> 2) + 4 * n + (i & 3); }

struct Unit { int pm, pn; };
struct Gemm { const bf16_t* A; const bf16_t* Bt; int M, N, K, lda; };

struct StaticOrder {
    int nM, nN, nwg, G, c;
    __device__ void init(int M, int N, int G_, int c_) { nM = M / BM; nN = N / BM; nwg = nM * nN; G = G_; c = c_; }
    __device__ bool next(int i, Unit& u) const {
        const long L = (long)i * G + c; if (L >= nwg) return false;
        int wgid = (int)L; { const int q = nwg / NXCD, r = nwg % NXCD, xcd = wgid % NXCD, off = wgid / NXCD; wgid = (xcd < r ? xcd * (q + 1) : r * (q + 1) + (xcd - r) * q) + off; }
        const int nig = WGM * nN, gid = wgid / nig, fm = gid * WGM, gsz = (nM - fm) < WGM ? (nM - fm) : WGM;
        u.pm = fm + ((wgid % nig) % gsz); u.pn = (wgid % nig) / gsz; return true;
    }
};

struct EpiBf16 {
    static constexpr bool PERM = true;
    bf16_t* O; int ldc;
    __device__ __forceinline__ void operator()(f32x4 (&acc)[2][2][4][2], const Unit& u, int wr, int wc, int fr, int fq) const {
        const int row0 = u.pm * BM + wr * 64 + fr; const int col0 = u.pn * BM + wc * 32 + 8 * fq;
#pragma unroll
        for (int ai = 0; ai < 2; ++ai)
#pragma unroll
            for (int m = 0; m < 4; ++m) { bf16_t* rowp = O + (size_t)(row0 + ai * HALF + m * 16) * ldc + col0;
#pragma unroll
                for (int bj = 0; bj < 2; ++bj) { const f32x4 v0 = acc[ai][bj][m][0], v1 = acc[ai][bj][m][1];
                    u32x4 w; w.x = cvt_pk_bf16(v0[0], v0[1]); w.y = cvt_pk_bf16(v0[2], v0[3]); w.z = cvt_pk_bf16(v1[0], v1[1]); w.w = cvt_pk_bf16(v1[2], v1[3]);
                    *(u32x4*)(rowp + bj * HALF) = w; } }
    }
};
struct EpiResidNorm {
    static constexpr bool PERM = false;
    const float* x; float* out; unsigned* ss; unsigned* cnt; const float* fg;
    __device__ __forceinline__ void operator()(f32x4 (&acc)[2][2][4][2], const Unit& u, int wr, int wc, int fr, int fq) const {
        const int row0 = u.pm * BM + wr * 64 + fr, col0 = u.pn * BM + wc * 32 + 4 * fq;
#pragma unroll
        for (int ai = 0; ai < 2; ++ai)
#pragma unroll
            for (int m = 0; m < 4; ++m) { const int row = row0 + ai * HALF + m * 16; const size_t off = (size_t)row * DM + col0; float s = 0.f;
#pragma unroll
                for (int bj = 0; bj < 2; ++bj)
#pragma unroll
                    for (int n = 0; n < 2; ++n) { const f32x4 xv = *(const f32x4*)(x + off + bj * HALF + n * 16); const f32x4 o = xv + acc[ai][bj][m][n];
                        acc[ai][bj][m][n] = o; s += (o[0] * o[0] + o[1] * o[1]) + (o[2] * o[2] + o[3] * o[3]); }
                s += __shfl_xor(s, 16); s += __shfl_xor(s, 32);
                if (fq == 0) __hip_atomic_store(ss + (size_t)row * 16 + u.pn * 4 + wc, __float_as_uint(s), __ATOMIC_RELAXED, __HIP_MEMORY_SCOPE_AGENT); }
        asm volatile("s_waitcnt vmcnt(0)" ::: "memory");
        unsigned* c = cnt + (u.pm * 2 + wr) * 32;
        if ((threadIdx.x & 63) == 0) __hip_atomic_fetch_add(c, 1u, __ATOMIC_RELAXED, __HIP_MEMORY_SCOPE_AGENT);
        { unsigned spins = 0;
          while ((unsigned)__builtin_amdgcn_readfirstlane(__hip_atomic_load(c, __ATOMIC_RELAXED, __HIP_MEMORY_SCOPE_AGENT)) < 16u) { __builtin_amdgcn_s_sleep(2); if (++spins > (1u << 22)) break; } }
        __builtin_amdgcn_fence(__ATOMIC_ACQUIRE, "agent");
        asm volatile("s_waitcnt vmcnt(0)" ::: "memory");
#pragma unroll
        for (int ai = 0; ai < 2; ++ai)
#pragma unroll
            for (int m = 0; m < 4; ++m) { const int row = row0 + ai * HALF + m * 16; const size_t off = (size_t)row * DM + col0;
                const unsigned long long* sp = (const unsigned long long*)(ss + (size_t)row * 16 + fq * 4);
                const unsigned long long p0 = __hip_atomic_load(sp, __ATOMIC_RELAXED, __HIP_MEMORY_SCOPE_AGENT), p1 = __hip_atomic_load(sp + 1, __ATOMIC_RELAXED, __HIP_MEMORY_SCOPE_AGENT);
                float t = (__uint_as_float((unsigned)p0) + __uint_as_float((unsigned)(p0 >> 32))) + (__uint_as_float((unsigned)p1) + __uint_as_float((unsigned)(p1 >> 32)));
                t += __shfl_xor(t, 16); t += __shfl_xor(t, 32);
                const float rstd = 1.0f / sqrtf(t * (1.f / DM) + RMS_EPS);
#pragma unroll
                for (int bj = 0; bj < 2; ++bj)
#pragma unroll
                    for (int n = 0; n < 2; ++n) { const f32x4 gv = *(const f32x4*)(fg + col0 + bj * HALF + n * 16);
                        *(f32x4*)(out + off + bj * HALF + n * 16) = acc[ai][bj][m][n] * rstd * gv; } }
    }
};

template <class Epi>
__device__ __forceinline__ void gemm_phase(LAS unsigned char* lds, const Gemm g, const StaticOrder& S, const Epi& E) {
    const int tid = threadIdx.x, wid = __builtin_amdgcn_readfirstlane(tid >> 6), lane = tid & 63, wr = wid >> 2, wc = wid & 3, fr = lane & 15, fq = lane >> 4;
    const int K = g.K, nt = K / BK, lda = g.lda;
    unsigned voffA[2], voffB[2];
#pragma unroll
    for (int i = 0; i < 2; ++i) { int R, C; stage_rc(tid * 16 + i * 8192, R, C); const int Rb = Epi::PERM ? ((R & ~31) + perm32(R & 31)) : R;
        voffA[i] = (unsigned)(R * lda + C) * 2u; voffB[i] = (unsigned)(Rb * K + C) * 2u; }
    const size_t kstep = (size_t)(BK * 2);
    const size_t hstepA = (size_t)HALF * lda * 2, hstepB = (size_t)HALF * K * 2;
    const size_t tstepA = 2 * hstepA, tstepB = 2 * hstepB;
    const unsigned ldsw = (unsigned)wid * 1024u;
    const int aoff = lds_byte(wr * 64 + fr, fq * 8), boff = lds_byte(wc * 32 + fr, fq * 8);
#define PG8_SA(b, h) (((b) * 2 + (h)) * HTB)
#define PG8_SB(b, h) ((4 + (b) * 2 + (h)) * HTB)
#define PG8_STAGE(bufoff, gbase, voff) do { _Pragma("unroll") for (int _i = 0; _i < 2; ++_i) \
        __builtin_amdgcn_global_load_lds((const unsigned*)((const char*)(gbase) + (voff)[_i]), (LAS unsigned*)(lds + (bufoff) + ldsw + _i * 8192), 16, 0, 0); } while (0)
#define PG8_LDA(dst, b, h) do { _Pragma("unroll") for (int m = 0; m < 4; ++m) _Pragma("unroll") for (int k = 0; k < 2; ++k) dst[m][k] = *(const LAS bf16x8*)(lds + PG8_SA(b, h) + aoff + m * 2048 + k * 1024); } while (0)
#define PG8_LDB(dst, b, h) do { _Pragma("unroll") for (int n = 0; n < 2; ++n) _Pragma("unroll") for (int k = 0; k < 2; ++k) dst[n][k] = *(const LAS bf16x8*)(lds + PG8_SB(b, h) + boff + n * 2048 + k * 1024); } while (0)
#define PG8_MMA(ai, bj, At, Bt) do { __builtin_amdgcn_s_setprio(1); _Pragma("unroll") for (int m = 0; m < 4; ++m) _Pragma("unroll") for (int n = 0; n < 2; ++n) _Pragma("unroll") for (int k = 0; k < 2; ++k) \
        acc[ai][bj][m][n] = __builtin_amdgcn_mfma_f32_16x16x32_bf16(Bt[n][k], At[m][k], acc[ai][bj][m][n], 0, 0, 0); __builtin_amdgcn_s_setprio(0); } while (0)
#define PG8_WAIT_V(n) asm volatile("s_waitcnt vmcnt(" #n ")" ::: "memory")
#define PG8_WAIT_L(n) asm volatile("s_waitcnt lgkmcnt(" #n ")" ::: "memory")
#define PG8_BAR __builtin_amdgcn_s_barrier()
#define PG8_SCHED __builtin_amdgcn_sched_barrier(0)
    Unit cur, nxt; int ui = 0;
    if (!S.next(0, cur)) return;
    f32x4 acc[2][2][4][2];
#pragma unroll
    for (int a = 0; a < 2; ++a)
#pragma unroll
        for (int b = 0; b < 2; ++b)
#pragma unroll
            for (int m = 0; m < 4; ++m)
#pragma unroll
                for (int n = 0; n < 2; ++n) acc[a][b][m][n] = (f32x4){0.f, 0.f, 0.f, 0.f};
    bf16x8 At[4][2], B0[2][2], B1[2][2];
    const char* cA = (const char*)g.A + (size_t)cur.pm * tstepA; const char* cB = (const char*)g.Bt + (size_t)cur.pn * tstepB;
    PG8_STAGE(PG8_SB(0, 0), cB, voffB); PG8_STAGE(PG8_SA(0, 0), cA, voffA); PG8_STAGE(PG8_SB(0, 1), cB + hstepB, voffB); PG8_STAGE(PG8_SA(0, 1), cA + hstepA, voffA);
    if (wr == 1) PG8_BAR;
    PG8_WAIT_V(4); PG8_BAR;
    PG8_STAGE(PG8_SB(1, 0), cB + kstep, voffB); PG8_STAGE(PG8_SA(1, 0), cA + kstep, voffA); PG8_STAGE(PG8_SB(1, 1), cB + hstepB + kstep, voffB);
    PG8_WAIT_V(6); PG8_BAR;
    for (;;) {
        const bool has_next = S.next(ui + 1, nxt);
        const char* nA = has_next ? (const char*)g.A + (size_t)nxt.pm * tstepA : cA; const char* nB = has_next ? (const char*)g.Bt + (size_t)nxt.pn * tstepB : cB;
        for (int t = 0; t < nt; t += 2) {
            const bool last = (t == nt - 2);
            const char* a1 = cA + (size_t)(t + 1) * kstep;
            const char* a2 = last ? nA : cA + (size_t)(t + 2) * kstep; const char* b2 = last ? nB : cB + (size_t)(t + 2) * kstep;
            const char* a3 = a2 + kstep; const char* b3 = b2 + kstep;
            PG8_LDB(B0, 0, 0); PG8_SCHED; PG8_LDA(At, 0, 0); PG8_STAGE(PG8_SA(1, 1), a1 + hstepA, voffA);
            PG8_WAIT_L(8); PG8_BAR; PG8_WAIT_L(0); PG8_MMA(0, 0, At, B0); PG8_BAR; PG8_SCHED;
            PG8_LDB(B1, 0, 1); PG8_STAGE(PG8_SB(0, 0), b2, voffB);
            PG8_BAR; PG8_WAIT_L(0); PG8_MMA(0, 1, At, B1); PG8_BAR;
            PG8_LDA(At, 0, 1); PG8_STAGE(PG8_SA(0, 0), a2, voffA);
            PG8_BAR; PG8_WAIT_L(0); PG8_MMA(1, 0, At, B0); PG8_BAR; PG8_SCHED;
            PG8_STAGE(PG8_SB(0, 1), b2 + hstepB, voffB);
            PG8_WAIT_V(6); PG8_BAR; PG8_MMA(1, 1, At, B1); PG8_BAR;
            PG8_LDB(B0, 1, 0); PG8_SCHED; PG8_LDA(At, 1, 0); PG8_STAGE(PG8_SA(0, 1), a2 + hstepA, voffA);
            PG8_WAIT_L(8); PG8_BAR; PG8_WAIT_L(0); PG8_MMA(0, 0, At, B0); PG8_BAR; PG8_SCHED;
            PG8_LDB(B1, 1, 1); PG8_STAGE(PG8_SB(1, 0), b3, voffB);
            PG8_BAR; PG8_WAIT_L(0); PG8_MMA(0, 1, At, B1); PG8_BAR;
            PG8_LDA(At, 1, 1); PG8_STAGE(PG8_SA(1, 0), a3, voffA);
            PG8_BAR; PG8_WAIT_L(0); PG8_MMA(1, 0, At, B0); PG8_BAR; PG8_SCHED;
            PG8_STAGE(PG8_SB(1, 1), b3 + hstepB, voffB);
            PG8_WAIT_V(6); PG8_BAR; PG8_MMA(1, 1, At, B1); PG8_BAR;
        }
        E(acc, cur, wr, wc, fr, fq);
        if (!has_next) break;
#pragma unroll
        for (int a = 0; a < 2; ++a)
#pragma unroll
            for (int b = 0; b < 2; ++b)
#pragma unroll
                for (int m = 0; m < 4; ++m)
#pragma unroll
                    for (int n = 0; n < 2; ++n) acc[a][b][m][n] = (f32x4){0.f, 0.f, 0.f, 0.f};
        cur = nxt; cA = nA; cB = nB; ++ui;
    }
    PG8_WAIT_V(0);
    if (wr == 0) PG8_BAR;
    PG8_BAR;
#undef PG8_SA
#undef PG8_SB
#undef PG8_STAGE
#undef PG8_LDA
#undef PG8_LDB
#undef PG8_MMA
#undef PG8_WAIT_V
#undef PG8_WAIT_L
#undef PG8_BAR
#undef PG8_SCHED
}
}

__device__ __forceinline__ void p0_transpose_item(const float* W, int ldw, int k0, int ncol0, bf16_t* WT, int ldt, int drow0, int dk0, LAS float* scr, int lane) {
#pragma unroll 8
    for (int i = 0; i < 32; ++i) { const int kk = 2 * i + (lane >> 5); scr[kk * 33 + (lane & 31)] = W[(size_t)(k0 + kk) * ldw + ncol0 + (lane & 31)]; }
    asm volatile("s_waitcnt lgkmcnt(0)" ::: "memory");
    const int c = lane & 7;
#pragma unroll
    for (int j = 0; j < 4; ++j) { const int n = (lane >> 3) + 8 * j; const LAS float* s = scr + (8 * c) * 33 + n;
        u32x4 o; o.x = cvt_pk_bf16(s[0 * 33], s[1 * 33]); o.y = cvt_pk_bf16(s[2 * 33], s[3 * 33]); o.z = cvt_pk_bf16(s[4 * 33], s[5 * 33]); o.w = cvt_pk_bf16(s[6 * 33], s[7 * 33]);
        *(u32x4*)(WT + (size_t)(drow0 + n) * ldt + dk0 + 8 * c) = o; }
    asm volatile("s_waitcnt lgkmcnt(0)" ::: "memory");
}

__device__ __forceinline__ void phase0(const Args& a, LAS unsigned char* lds, int wave, int lane) {
    LAS float* scr = (LAS float*)(lds + wave * 16384);
    const int gw = blockIdx.x * 8 + wave, NGW = gridDim.x * 8;
    bf16_t* win_t = (bf16_t*)(a.ws + WS_WIN); bf16_t* wout_t = (bf16_t*)(a.ws + WS_WOUT); bf16_t* wg = (bf16_t*)(a.ws + WS_WG);
    constexpr int I_IN = 16 * 192, I_OUT = 32 * 32, I_G = 64;
    for (int it = gw; it < I_IN + I_OUT + I_G; it += NGW) {
        int r = it;
        if (r < I_IN) { const int kb = r / 192, nb = r % 192; const int og = nb / 32;
            const int ng = (og == 3) ? 4 : (og == 4 ? 3 : og);
            p0_transpose_item(a.in[I_WIN], NPROJ, kb * 64, nb * 32, win_t, DM, ng * 1024 + (nb % 32) * 32, kb * 64, scr, lane); continue; }
        r -= I_IN;
        if (r < I_OUT) { const int kb = r / 32, nb = r % 32; p0_transpose_item(a.in[I_WOUT], DM, kb * 64, nb * 32, wout_t, DMIX, nb * 32, kb * 64, scr, lane); continue; }
        r -= I_OUT;
        { const int mat = r / 32, h = (r % 32) / 2, nb = r & 1; const float* W = (mat ? a.in[I_WI] : a.in[I_WA]) + h * 4096;
          p0_transpose_item(W, 64, 0, nb * 32, wg + mat * 65536 + h * 4096, 64, nb * 32, 0, scr, lane); }
    }
    const float* x = a.in[I_X]; bf16_t* xn = (bf16_t*)(a.ws + WS_XN);
    f32x4 gv[4];
#pragma unroll
    for (int j = 0; j < 4; ++j) gv[j] = ((const f32x4*)a.in[I_LNG])[lane + 64 * j];
    for (int m = gw; m < T_TOK; m += NGW) {
        const f32x4* xr = (const f32x4*)(x + (size_t)m * DM) + lane;
        f32x4 v[4]; float s = 0.f;
#pragma unroll
        for (int j = 0; j < 4; ++j) { v[j] = xr[64 * j]; s += (v[j].x * v[j].x + v[j].y * v[j].y) + (v[j].z * v[j].z + v[j].w * v[j].w); }
        const float rstd = 1.0f / sqrtf(wave_sum(s) * (1.f / DM) + RMS_EPS);
        u32x2* o8 = (u32x2*)(xn + (size_t)m * DM) + lane;
#pragma unroll
        for (int j = 0; j < 4; ++j) { u32x2 w; w.x = cvt_pk_bf16(v[j].x * rstd * gv[j].x, v[j].y * rstd * gv[j].y); w.y = cvt_pk_bf16(v[j].z * rstd * gv[j].z, v[j].w * rstd * gv[j].w); o8[64 * j] = w; }
    }
}

#define DPP_ADD(v, ctrl) ((v) + __uint_as_float(__builtin_amdgcn_update_dpp(0, __float_as_uint(v), (ctrl), 0xF, 0xF, false)))
__device__ __forceinline__ void conv_item(const Args& a, bf16_t* proj, bf16_t* obase, int ostride, int item, int wave, int lane) {
    const int q = lane >> 4, c8 = lane & 15, ch0 = wave * 128 + c8 * 8;
    float w0[8], w1[8], w2[8], gn[8];
    { const float* cw = a.in[I_CONVW] + ch0; const float* cg_ = a.in[I_CG] + ch0;
#pragma unroll
      for (int j = 0; j < 8; ++j) { w0[j] = cw[j]; w1[j] = cw[1024 + j]; w2[j] = cw[2048 + j]; gn[j] = cg_[j]; } }
    const int tok0 = item * 64 + q * 16;
    bf16_t* base = proj + (size_t)tok0 * NPROJ + ch0;
    float p2[8], p1[8];
    if ((tok0 & (SEQ - 1)) == 0) {
#pragma unroll
        for (int j = 0; j < 8; ++j) { p2[j] = 0.f; p1[j] = 0.f; }
    } else {
        const u32x4 c2 = *(const u32x4*)(base - 2 * NPROJ + COL_C), x2 = *(const u32x4*)(base - 2 * NPROJ + COL_XC);
        const u32x4 c1 = *(const u32x4*)(base - 1 * NPROJ + COL_C), x1 = *(const u32x4*)(base - 1 * NPROJ + COL_XC);
        float fc[8], fx[8];
        unpack8(c2, fc); unpack8(x2, fx);
#pragma unroll
        for (int j = 0; j < 8; ++j) p2[j] = fc[j] * fx[j];
        unpack8(c1, fc); unpack8(x1, fx);
#pragma unroll
        for (int j = 0; j < 8; ++j) p1[j] = fc[j] * fx[j];
    }
    u32x4 nb[2], nc[2], nx[2], ng[2];
#pragma unroll
    for (int k = 0; k < 2; ++k) { const bf16_t* rp = base + (size_t)k * NPROJ; nb[k] = *(const u32x4*)(rp + COL_B); nc[k] = *(const u32x4*)(rp + COL_C); nx[k] = *(const u32x4*)(rp + COL_XC); ng[k] = *(const u32x4*)(rp + COL_GC); }
    for (int i = 0; i < 16; i += 2) {
        u32x4 vb[2], vc[2], vx[2], vg[2];
#pragma unroll
        for (int k = 0; k < 2; ++k) { vb[k] = nb[k]; vc[k] = nc[k]; vx[k] = nx[k]; vg[k] = ng[k]; }
        if (i + 2 < 16) {
#pragma unroll
            for (int k = 0; k < 2; ++k) { const bf16_t* rp = base + (size_t)(i + 2 + k) * NPROJ; nb[k] = *(const u32x4*)(rp + COL_B); nc[k] = *(const u32x4*)(rp + COL_C); nx[k] = *(const u32x4*)(rp + COL_XC); ng[k] = *(const u32x4*)(rp + COL_GC); }
        }
#pragma unroll
        for (int k = 0; k < 2; ++k) {
            float fb[8], fc[8], fx[8], fg[8], y[8];
            unpack8(vb[k], fb); unpack8(vc[k], fc); unpack8(vx[k], fx); unpack8(vg[k], fg);
            float ss = 0.f;
#pragma unroll
            for (int j = 0; j < 8; ++j) { const float cx = fc[j] * fx[j]; const float cv = w0[j] * p2[j] + w1[j] * p1[j] + w2[j] * cx; y[j] = fb[j] * cv; ss += y[j] * y[j]; p2[j] = p1[j]; p1[j] = cx; }
            ss = DPP_ADD(ss, 0xB1); ss = DPP_ADD(ss, 0x4E); ss = DPP_ADD(ss, 0x141); ss = DPP_ADD(ss, 0x140);
            const float rstd = __builtin_amdgcn_rsqf(ss * (1.f / 128.f) + RMS_EPS);
            float o[8];
#pragma unroll
            for (int j = 0; j < 8; ++j) o[j] = y[j] * rstd * gn[j] * (fg[j] * sigmoid_fast(fg[j]));
            u32x4 w; w.x = cvt_pk_bf16(o[0], o[1]); w.y = cvt_pk_bf16(o[2], o[3]); w.z = cvt_pk_bf16(o[4], o[5]); w.w = cvt_pk_bf16(o[6], o[7]);
            *(u32x4*)(obase + (size_t)(tok0 + i + k) * ostride + ch0) = w;
        }
    }
}

constexpr int L_GW = 0;
constexpr int L_CW = 18432;
constexpr int L_AGG = 20992;
constexpr int L_WT = 29184;
constexpr int WT_BYTES = 8704;
static_assert(L_WT + 8 * WT_BYTES <= 131072, "lds");
typedef float f32x2 __attribute__((ext_vector_type(2)));

__device__ __forceinline__ void lru_item(const Args& a, bf16_t* proj, bf16_t* obase, int ostride, LAS unsigned char* lds, int chain, int part, int nsplit, int tid, int wave, int lane) {
    const int b = chain >> 4, h = chain & 15;
    {
        const bf16_t* wg = (const bf16_t*)(a.ws + WS_WG);
        for (int i = tid; i < 1024; i += NTHREADS) { const int mat = i >> 9, e = (i >> 3) & 63, c = i & 7;
            const u32x4 v = *(const u32x4*)(wg + mat * 65536 + h * 4096 + e * 64 + c * 8);
            *(LAS u32x4*)(lds + L_GW + mat * 9216 + e * 144 + c * 16) = v; }
        LAS float* cw = (LAS float*)(lds + L_CW);
        if (tid < 256) cw[tid] = a.in[I_LCW][(tid >> 6) * 1024 + h * 64 + (tid & 63)];
        else if (tid < 320) { const int c = tid - 256, gc = h * 64 + c;
            cw[256 + c] = a.in[I_LCB][gc]; cw[320 + c] = a.in[I_BA][gc]; cw[384 + c] = a.in[I_BI][gc];
            const float lam = a.in[I_LAM][gc];
            const float logsig = (lam >= 0.f) ? -log1pf(expf(-lam)) : (lam - log1pf(expf(lam)));
            cw[448 + c] = 8.0f * logsig * 1.44269504f;
            cw[512 + c] = a.in[I_LG][gc]; }
    }
    __syncthreads();
    const int r = lane & 31, hh = lane >> 5;
    LAS unsigned char* wt = lds + L_WT + wave * WT_BYTES;
    LAS const float* cw = (LAS const float*)(lds + L_CW);
    bf16x8 I0, I1;
    {
        u32x4 t0 = (u32x4){0u, 0u, 0u, 0u}, t1 = t0;
        const int j0 = r - 8 * hh, j1 = r - 16 - 8 * hh;
#pragma unroll
        for (int d = 0; d < 4; ++d) {
            t0[d] = (j0 == 2 * d) ? 0x00003F80u : ((j0 == 2 * d + 1) ? 0x3F800000u : 0u);
            t1[d] = (j1 == 2 * d) ? 0x00003F80u : ((j1 == 2 * d + 1) ? 0x3F800000u : 0u);
        }
        I0 = __builtin_bit_cast(bf16x8, t0); I1 = __builtin_bit_cast(bf16x8, t1);
    }
    float ba[2], bi[2], cf[2];
#pragma unroll
    for (int n = 0; n < 2; ++n) { ba[n] = cw[320 + 32 * n + r]; bi[n] = cw[384 + 32 * n + r]; cf[n] = cw[448 + 32 * n + r]; }
    float carry[2] = {0.f, 0.f};
    unsigned* flags = (unsigned*)(a.ws + WS_CTL + 4096) + chain * 16;
    unsigned long long* aggg = (unsigned long long*)(a.ws + WS_AGG) + (size_t)chain * 16 * 64;

    const bf16_t* xl_base = proj + (size_t)b * SEQ * NPROJ + COL_XL + h * 64;
    bf16_t* gl_base = proj + (size_t)b * SEQ * NPROJ + COL_GL + h * 64;
    u32x4 xr[5];
#define LOAD_X(seg_) do { const int s0_ = (seg_) * 256 + wave * 32; _Pragma("unroll") for (int i = 0; i < 5; ++i) { const int idx = lane + 64 * i, row = idx >> 3, c = idx & 7; const int s = s0_ - 3 + row; \
        xr[i] = (u32x4){0u, 0u, 0u, 0u}; if (idx < 280 && s >= 0) xr[i] = *(const u32x4*)(xl_base + (size_t)s * NPROJ + c * 8); } } while (0)
    LOAD_X(part);
    for (int seg = part; seg < 16; seg += nsplit) {
        const int s0 = seg * 256 + wave * 32;
#pragma unroll
        for (int i = 0; i < 5; ++i) { const int idx = lane + 64 * i, row = idx >> 3, c = idx & 7; if (idx < 280) *(LAS u32x4*)(wt + row * 144 + c * 16) = xr[i]; }
        if (seg + nsplit < 16) LOAD_X(seg + nsplit);
        u32x4 gl[4];
#define LOAD_GL() do { _Pragma("unroll") for (int i = 0; i < 4; ++i) { const int tok = (lane >> 3) + 8 * i, c = lane & 7; gl[i] = *(const u32x4*)(gl_base + (size_t)(s0 + tok) * NPROJ + c * 8); } } while (0)
#if GL_EARLY
        LOAD_GL();
#endif
        asm volatile("s_waitcnt lgkmcnt(0)" ::: "memory");
        bf16x8 Af[4];
#pragma unroll
        for (int s = 0; s < 4; ++s) {
            const int c0 = 16 * s + 8 * hh;
            float u8[8];
            { const f32x4 b0 = *(LAS const f32x4*)(cw + 256 + c0), b1 = *(LAS const f32x4*)(cw + 256 + c0 + 4);
              u8[0] = b0[0]; u8[1] = b0[1]; u8[2] = b0[2]; u8[3] = b0[3]; u8[4] = b1[0]; u8[5] = b1[1]; u8[6] = b1[2]; u8[7] = b1[3]; }
#pragma unroll
            for (int k = 0; k < 4; ++k) {
                const u32x4 xv = *(LAS const u32x4*)(wt + (r + k) * 144 + c0 * 2);
                const f32x4 wv0 = *(LAS const f32x4*)(cw + k * 64 + c0), wv1 = *(LAS const f32x4*)(cw + k * 64 + c0 + 4);
                float fx[8]; unpack8(xv, fx);
                u8[0] += wv0[0] * fx[0]; u8[1] += wv0[1] * fx[1]; u8[2] += wv0[2] * fx[2]; u8[3] += wv0[3] * fx[3];
                u8[4] += wv1[0] * fx[4]; u8[5] += wv1[1] * fx[5]; u8[6] += wv1[2] * fx[6]; u8[7] += wv1[3] * fx[7];
            }
            u32x4 pk; pk.x = cvt_pk_bf16(u8[0], u8[1]); pk.y = cvt_pk_bf16(u8[2], u8[3]); pk.z = cvt_pk_bf16(u8[4], u8[5]); pk.w = cvt_pk_bf16(u8[6], u8[7]);
            Af[s] = __builtin_bit_cast(bf16x8, pk);
        }
#pragma unroll
        for (int n = 0; n < 2; ++n) {
            float hl[16], pc[16];
            f32x16 accR, accI, accU;
#pragma unroll
            for (int j = 0; j < 16; ++j) { accR[j] = 0.f; accI[j] = 0.f; accU[j] = 0.f; }
#pragma unroll
            for (int s = 0; s < 4; ++s) {
                const bf16x8 Ba = *(LAS const bf16x8*)(lds + L_GW + (32 * n + r) * 144 + (16 * s + 8 * hh) * 2);
                const bf16x8 Bi = *(LAS const bf16x8*)(lds + L_GW + 9216 + (32 * n + r) * 144 + (16 * s + 8 * hh) * 2);
                accR = __builtin_amdgcn_mfma_f32_32x32x16_bf16(Af[s], Ba, accR, 0, 0, 0);
                accI = __builtin_amdgcn_mfma_f32_32x32x16_bf16(Af[s], Bi, accI, 0, 0, 0);
            }
            accU = __builtin_amdgcn_mfma_f32_32x32x16_bf16(Af[2 * n], I0, accU, 0, 0, 0);
            accU = __builtin_amdgcn_mfma_f32_32x32x16_bf16(Af[2 * n + 1], I1, accU, 0, 0, 0);
            float gP[4], gH[4];
#pragma unroll
            for (int g = 0; g < 4; ++g) {
                float P = 1.f, H = 0.f;
#pragma unroll
                for (int i = 0; i < 4; ++i) { const int j = 4 * g + i;
                    const float rr = sigmoid_fast(accR[j] + ba[n]);
                    const float ii = sigmoid_fast(accI[j] + bi[n]);
                    const float l2 = rr * cf[n];
                    const float aa = __builtin_amdgcn_exp2f(l2);
                    const float t = l2 * 1.38629436f;
                    const float em_small = -t * (1.0f + t * (0.5f + t * (0.16666667f + t * 0.041666667f)));
                    const float one_m = (t > -0.0625f) ? em_small : (1.0f - aa * aa);
                    const float dd = __builtin_amdgcn_sqrtf(one_m) * ii * accU[j];
                    H = aa * H + dd; P = P * aa; hl[j] = H; pc[j] = P; }
                gP[g] = P; gH[g] = H;
            }
            float cp = 1.f, ch = 0.f;
#pragma unroll
            for (int g = 0; g < 4; ++g) {
                const auto sp = __builtin_amdgcn_permlane32_swap(__float_as_uint(gP[g]), __float_as_uint(gP[g]), false, false);
                const auto sh = __builtin_amdgcn_permlane32_swap(__float_as_uint(gH[g]), __float_as_uint(gH[g]), false, false);
                const float oP = __uint_as_float(hh ? sp[0] : sp[1]), oH = __uint_as_float(hh ? sh[0] : sh[1]);
                const float P = gP[g], H = gH[g];
                const float A1 = hh ? oP : P, H1 = hh ? oH : H, A2 = hh ? P : oP, H2 = hh ? H : oH;
                const float cp1 = cp * A1, ch1 = A1 * ch + H1;
                const float inP = hh ? cp1 : cp, inH = hh ? ch1 : ch;
#pragma unroll
                for (int i = 0; i < 4; ++i) { const int j = 4 * g + i; hl[j] += pc[j] * inH; pc[j] *= inP; }
                cp = cp1 * A2; ch = A2 * ch1 + H2;
            }
            if (hh == 0) *(LAS f32x2*)(lds + L_AGG + ((n * 8 + wave) * 64 + 32 * n + r) * 8) = (f32x2){cp, ch};
#if !GL_EARLY
            if (n == 1) LOAD_GL();
#endif
            if (n == 0 && nsplit > 1 && seg > 0 && wave == 0) {
                unsigned spins = 0;
                while (__builtin_amdgcn_readfirstlane(__hip_atomic_load(flags + (seg - 1), __ATOMIC_RELAXED, __HIP_MEMORY_SCOPE_AGENT)) == 0u) { __builtin_amdgcn_s_sleep(2); if (++spins > (1u << 22)) break; }
                __builtin_amdgcn_fence(__ATOMIC_ACQUIRE, "agent");
                asm volatile("s_waitcnt vmcnt(0)" ::: "memory");
            }
            __syncthreads();
            float c = carry[n];
            if (nsplit > 1 && seg > 0) {
                const unsigned long long pw = __hip_atomic_load(aggg + (size_t)(seg - 1) * 64 + n * 32 + r, __ATOMIC_RELAXED, __HIP_MEMORY_SCOPE_AGENT);
                c = __uint_as_float((unsigned)pw) * c + __uint_as_float((unsigned)(pw >> 32));
            }
            float cin = 0.f, iP = 1.f, iH = 0.f;
#pragma unroll
            for (int w = 0; w < 8; ++w) {
                const f32x2 ag = *(LAS const f32x2*)(lds + L_AGG + ((n * 8 + w) * 64 + 32 * n + r) * 8);
                cin = (w == wave) ? c : cin; c = ag.x * c + ag.y; iH = ag.x * iH + ag.y; iP *= ag.x; }
            carry[n] = c;
            if (nsplit > 1 && wave == 0 && hh == 0)
                __hip_atomic_store(aggg + (size_t)seg * 64 + n * 32 + r, ((unsigned long long)__float_as_uint(iH) << 32) | __float_as_uint(iP), __ATOMIC_RELAXED, __HIP_MEMORY_SCOPE_AGENT);
#pragma unroll
            for (int j = 0; j < 16; ++j) { const int row = (j & 3) + 8 * (j >> 2) + 4 * hh;
                *(LAS float*)(wt + row * 272 + (32 * n + r) * 4) = hl[j] + pc[j] * cin; }
        }
        if (nsplit > 1 && wave == 0) {
            asm volatile("s_waitcnt vmcnt(0)" ::: "memory");
            if (lane == 0) __hip_atomic_store(flags + seg, 1u, __ATOMIC_RELAXED, __HIP_MEMORY_SCOPE_AGENT);
        }
        asm volatile("s_waitcnt lgkmcnt(0)" ::: "memory");
#pragma unroll
        for (int i = 0; i < 4; ++i) {
            const int tok = (lane >> 3) + 8 * i, c = lane & 7;
            const f32x4 h0 = *(LAS const f32x4*)(wt + tok * 272 + c * 32), h1 = *(LAS const f32x4*)(wt + tok * 272 + c * 32 + 16);
            const f32x4 g0 = *(LAS const f32x4*)(cw + 512 + c * 8), g1 = *(LAS const f32x4*)(cw + 512 + c * 8 + 4);
            float ss = (h0[0] * h0[0] + h0[1] * h0[1]) + (h0[2] * h0[2] + h0[3] * h0[3]) + (h1[0] * h1[0] + h1[1] * h1[1]) + (h1[2] * h1[2] + h1[3] * h1[3]);
            ss = DPP_ADD(ss, 0xB1); ss = DPP_ADD(ss, 0x4E); ss = DPP_ADD(ss, 0x141);
            const float rstd = __builtin_amdgcn_rsqf(ss * (1.f / 64.f) + RMS_EPS);
            float fg[8]; unpack8(gl[i], fg);
            float o[8];
            o[0] = h0[0] * rstd * g0[0]; o[1] = h0[1] * rstd * g0[1]; o[2] = h0[2] * rstd * g0[2]; o[3] = h0[3] * rstd * g0[3];
            o[4] = h1[0] * rstd * g1[0]; o[5] = h1[1] * rstd * g1[1]; o[6] = h1[2] * rstd * g1[2]; o[7] = h1[3] * rstd * g1[3];
#pragma unroll
            for (int j = 0; j < 8; ++j) o[j] *= fg[j] * sigmoid_fast(fg[j]);
            u32x4 w; w.x = cvt_pk_bf16(o[0], o[1]); w.y = cvt_pk_bf16(o[2], o[3]); w.z = cvt_pk_bf16(o[4], o[5]); w.w = cvt_pk_bf16(o[6], o[7]);
            *(u32x4*)(obase + (size_t)(b * SEQ + s0 + tok) * ostride + h * 64 + c * 8) = w;
        }
        asm volatile("s_waitcnt lgkmcnt(0)" ::: "memory");
    }
#undef LOAD_X
    __syncthreads();
}

__global__ void __launch_bounds__(NTHREADS, 2) hymba_fwd(Args a) {
    extern __shared__ __attribute__((aligned(16))) unsigned char lds_raw[];
    LAS unsigned char* lds = (LAS unsigned char*)lds_raw;
    cg::grid_group grid = cg::this_grid();
    if (gridDim.y == 0x7fffu) grid.sync();
    volatile LAS unsigned* bst = (volatile LAS unsigned*)(lds + 131072 + 64);
    if (threadIdx.x == 0) { bst[0] = 0u; bst[1] = 0u; }
    __syncthreads();
    const XcdBarrier bar = xcd_barrier_post((unsigned*)(a.ws + WS_CTL + 32768), bst);
    const int tid = threadIdx.x, lane = tid & 63, wave = __builtin_amdgcn_readfirstlane(tid >> 6);
    bf16_t* proj = (bf16_t*)(a.ws + WS_PROJ);

#pragma unroll
    for (int rep = 0; rep < REP0; ++rep) {
#ifndef SKIP_P0
    phase0(a, lds, wave, lane);
#endif

    xcd_barrier(bar); }
#pragma unroll
    for (int rep = 0; rep < REP1; ++rep) {
        pg8::Gemm g{(const bf16_t*)(a.ws + WS_XN), (const bf16_t*)(a.ws + WS_WIN), T_TOK, NPROJ, DM, DM};
        pg8::StaticOrder S; S.init(T_TOK, NPROJ, (int)gridDim.x, (int)blockIdx.x);
        pg8::EpiBf16 E{proj, NPROJ};
#ifndef SKIP_G1
        pg8::gemm_phase<pg8::EpiBf16>(lds, g, S, E);
#endif
    xcd_barrier(bar); }
    {
        bf16_t* xn_scratch = (bf16_t*)(a.ws + WS_XN);
        for (int rep = 0; rep < a.nrep_lru; ++rep) {
            bf16_t* ob = (rep + 1 < a.nrep_lru) ? xn_scratch : proj + COL_GL; const int os = (rep + 1 < a.nrep_lru) ? DM : NPROJ;
#ifndef SKIP_LRU
            if (gridDim.x >= 256) { if (blockIdx.x < 256) lru_item(a, proj, ob, os, lds, (int)blockIdx.x >> 1, (int)blockIdx.x & 1, 2, tid, wave, lane); }
            else for (int it = blockIdx.x; it < 128; it += gridDim.x) lru_item(a, proj, ob, os, lds, it, 0, 1, tid, wave, lane);
#endif
        }
        LAS unsigned* qs = (LAS unsigned*)(lds + 131072);
        for (int rep = 0; rep < a.nrep_conv; ++rep) {
            bf16_t* ob = (rep + 1 < a.nrep_conv) ? xn_scratch : proj + COL_GC; const int os = (rep + 1 < a.nrep_conv) ? DM : NPROJ;
            unsigned* qctr = (unsigned*)(a.ws + WS_CTL) + rep;
            for (;;) {
                if (tid == 0) qs[0] = atomicAdd(qctr, 1u);
                __syncthreads();
                const unsigned it = qs[0];
                __syncthreads();
                if (it >= (unsigned)(T_TOK / 64)) break;
#ifndef SKIP_CONV
                conv_item(a, proj, ob, os, (int)it, wave, lane);
#endif
            }
        }
    }
    xcd_barrier(bar);
#pragma unroll
    for (int rep = 0; rep < REP3; ++rep) {
        pg8::Gemm g{proj + COL_GC, (const bf16_t*)(a.ws + WS_WOUT), T_TOK, DM, DMIX, NPROJ};
        pg8::StaticOrder S; S.init(T_TOK, DM, (int)gridDim.x, (int)blockIdx.x);
        pg8::EpiResidNorm E{a.in[I_X], a.out, (unsigned*)(a.ws + WS_SS), (unsigned*)(a.ws + WS_CTL + 16384) + rep * 0, a.in[I_FG]};
#ifndef SKIP_G2
        pg8::gemm_phase<pg8::EpiResidNorm>(lds, g, S, E);
#endif
    }
}

extern "C" void kernel_launch(void* const* d_in, const int* in_sizes, int n_in, void* d_out, int out_size, void* d_ws, size_t ws_size, hipStream_t stream) {
    static int grid = 0;
    if (grid == 0) {
        if (n_in != 15 || out_size != T_TOK * DM || ws_size < WS_END) { fprintf(stderr, "kernel_launch: unexpected shapes (n_in %d out %d ws %zu)\n", n_in, out_size, ws_size); grid = -1; return; }
        int dev = 0, cus = 0, per_cu = 0;
        hipGetDevice(&dev);
        hipDeviceGetAttribute(&cus, hipDeviceAttributeMultiprocessorCount, dev);
        if (hipFuncSetAttribute((const void*)hymba_fwd, hipFuncAttributeMaxDynamicSharedMemorySize, LDS_BYTES) != hipSuccess) { fprintf(stderr, "kernel_launch: hipFuncSetAttribute failed\n"); grid = -1; return; }
        if (hipOccupancyMaxActiveBlocksPerMultiprocessor(&per_cu, (const void*)hymba_fwd, NTHREADS, LDS_BYTES) != hipSuccess || per_cu < 1) { fprintf(stderr, "kernel_launch: occupancy query says %d\n", per_cu); per_cu = 1; }
        (void)hipGetLastError();
        grid = cus;
        if (grid != 256) { fprintf(stderr, "kernel_launch: built for a 256-CU device (got %d)\n", cus); grid = -1; return; }
    }
    if (grid < 0) return;
    hipMemsetAsync((char*)d_ws + WS_CTL, 0, CTL_BYTES, stream);
    Args a{};
    for (int i = 0; i < 15; ++i) a.in[i] = (const float*)d_in[i];
    a.out = (float*)d_out; a.ws = (unsigned char*)d_ws; a.nrep_lru = REPLRU; a.nrep_conv = REPCONV;
    void* args[] = {&a};
    hipError_t e = hipLaunchCooperativeKernel((const void*)hymba_fwd, dim3(grid), dim3(NTHREADS), args, LDS_BYTES, stream);
    if (e != hipSuccess) fprintf(stderr, "kernel_launch: cooperative launch failed: %s (grid %d)\n", hipGetErrorString(e), grid);
}
```

```cpp
#include <hip/hip_runtime.h>
#include <hip/hip_cooperative_groups.h>
#include <cstdio>
namespace cg = cooperative_groups;

#define LAS __attribute__((address_space(3)))
typedef unsigned short bf16_t;
typedef short bf16x8 __attribute__((ext_vector_type(8)));
typedef float f32x4 __attribute__((ext_vector_type(4)));
typedef float f32x16 __attribute__((ext_vector_type(16)));
typedef unsigned u32x4 __attribute__((ext_vector_type(4)));
typedef unsigned u32x2 __attribute__((ext_vector_type(2)));

constexpr int T_TOK = 32768, SEQ = 4096, DM = 1024, NPROJ = 6144, DMIX = 2048;
constexpr float RMS_EPS = 1e-6f;
constexpr int COL_B = 0, COL_C = 1024, COL_XC = 2048, COL_XL = 3072, COL_GC = 4096, COL_GL = 5120;
constexpr size_t MiB = 1u << 20;
constexpr size_t WS_CTL = 0, CTL_BYTES = 65536;
constexpr size_t WS_WIN = 2 * MiB;
constexpr size_t WS_WOUT = 14 * MiB;
constexpr size_t WS_WG = 18 * MiB;
constexpr size_t WS_SS = 20 * MiB;
constexpr size_t WS_AGG = 22 * MiB;
constexpr size_t WS_XN = 32 * MiB;
constexpr size_t WS_PROJ = 96 * MiB;
constexpr int LDPA = 4096, LDPG = 2048;
constexpr size_t WS_PROJG = WS_PROJ + (size_t)T_TOK * LDPA * 2;
constexpr size_t WS_END = WS_PROJG + (size_t)T_TOK * LDPG * 2;
static_assert(WS_END <= 480 * MiB, "ws");
constexpr int LDS_BYTES = 147456;
constexpr int NTHREADS = 512;
#ifndef REP0
#define REP0 1
#endif
#ifndef REP1
#define REP1 1
#endif
#ifndef REP3
#define REP3 1
#endif
#ifndef PG8_SP2
#define PG8_SP2 1
#endif
#ifndef PG8_ALIGN
#define PG8_ALIGN 1
#endif
#ifndef SKEW1
#define SKEW1 0
#endif
#ifndef SKEW3
#define SKEW3 0
#endif
#ifndef GL_EARLY
#define GL_EARLY 0
#endif
#ifndef REPLRU
#define REPLRU 1
#endif
#ifndef REPCONV
#define REPCONV 1
#endif

struct Args { const float* in[15]; float* out; unsigned char* ws; int nrep_lru, nrep_conv; };
enum { I_X = 0, I_LNG, I_WIN, I_CONVW, I_LCW, I_LCB, I_WA, I_BA, I_WI, I_BI, I_LAM, I_CG, I_LG, I_WOUT, I_FG };

__device__ __forceinline__ unsigned cvt_pk_bf16(float lo, float hi) { unsigned r; asm volatile("v_cvt_pk_bf16_f32 %0, %1, %2" : "=v"(r) : "v"(lo), "v"(hi)); return r; }
__device__ __forceinline__ float bf_lo(unsigned w) { return __uint_as_float(w << 16); }
__device__ __forceinline__ float bf_hi(unsigned w) { return __uint_as_float(w & 0xffff0000u); }
__device__ __forceinline__ float wave_sum(float v) {
#pragma unroll
    for (int o = 1; o < 64; o <<= 1) v += __shfl_xor(v, o);
    return v;
}
__device__ __forceinline__ float sigmoid_fast(float x) { return __builtin_amdgcn_rcpf(1.0f + __builtin_amdgcn_exp2f(-1.44269504f * x)); }
__device__ __forceinline__ void unpack8(const u32x4 v, float (&f)[8]) {
    f[0] = bf_lo(v.x); f[1] = bf_hi(v.x); f[2] = bf_lo(v.y); f[3] = bf_hi(v.y); f[4] = bf_lo(v.z); f[5] = bf_hi(v.z); f[6] = bf_lo(v.w); f[7] = bf_hi(v.w);
}


#define XB_TMO      128
#define XB_XCNT(j)  (256  + 64 * (j))
#define XB_XSUB(j)  (1280 + 64 * (j))
#define XB_XGEN(j)  (2304 + 64 * (j))
#define XB_TOP      3328
#define XB_TOPGEN   3392
#define XCD_BAR_WORDS 3456
#define XB_SPIN_CAP (1u << 20)
__device__ __forceinline__ unsigned xb_ld(unsigned* p)              { return __hip_atomic_load(p, __ATOMIC_RELAXED, __HIP_MEMORY_SCOPE_AGENT); }
__device__ __forceinline__ unsigned xb_add(unsigned* p, unsigned v) { return __hip_atomic_fetch_add(p, v, __ATOMIC_RELAXED, __HIP_MEMORY_SCOPE_AGENT); }
__device__ __forceinline__ unsigned xb_xcc_id() { return (unsigned)__builtin_amdgcn_s_getreg((3 << 11) | 20) & 0xFu; }
#define XB_SPIN(cond, bar) do { unsigned _sp = 0; while (cond) { __builtin_amdgcn_s_sleep(1); \
    if ((++_sp & 255u) == 0u) { if (xb_ld(&(bar)[XB_TMO])) break; if (_sp > XB_SPIN_CAP) { atomicAdd(&(bar)[XB_TMO], 1u); break; } } } } while (0)
struct XcdBarrier { unsigned* bar; unsigned x; volatile LAS unsigned* st; };
__device__ __forceinline__ XcdBarrier xcd_barrier_post(unsigned* bar, volatile LAS unsigned* st) {
    XcdBarrier b; b.bar = bar; b.x = xb_xcc_id(); b.st = st;
    if (threadIdx.x == 0) (void)xb_add(&bar[XB_XCNT(b.x)], 1u);
    return b;
}
__device__ __forceinline__ void xcd_barrier_complete(unsigned* bar, unsigned x, unsigned& nloc, unsigned& nx) {
    const unsigned G = gridDim.x * gridDim.y * gridDim.z;
    unsigned sum, cnt, mine, sp = 0u;
    for (;;) {
        sum = 0u; cnt = 0u; mine = 0u;
#pragma unroll
        for (unsigned j = 0; j < 16; ++j) { const unsigned c = xb_ld(&bar[XB_XCNT(j)]); sum += c; cnt += (c > 0u) ? 1u : 0u; mine = (j == x) ? c : mine; }
        if (sum == G) break;
        __builtin_amdgcn_s_sleep(1);
        if ((++sp & 255u) == 0u) { if (xb_ld(&bar[XB_TMO])) break; if (sp > XB_SPIN_CAP) { atomicAdd(&bar[XB_TMO], 1u); break; } }
    }
    nloc = mine > 0u ? mine : 1u; nx = cnt > 0u ? cnt : 1u;
}
__device__ __forceinline__ void xcd_barrier(const XcdBarrier& b) {
    asm volatile("s_waitcnt vmcnt(0)" ::: "memory");
    __syncthreads();
    if (threadIdx.x == 0) {
        unsigned* bar = b.bar;
        __builtin_amdgcn_s_waitcnt(0);
        unsigned nloc = b.st[0], nx = b.st[1];
        if (nloc == 0u) { xcd_barrier_complete(bar, b.x, nloc, nx); b.st[0] = nloc; b.st[1] = nx; }
        const unsigned old = xb_add(&bar[XB_XSUB(b.x)], 1u);
        const unsigned gen = old / nloc;
        if (old + 1u == (gen + 1u) * nloc) {
            __builtin_amdgcn_fence(__ATOMIC_RELEASE, "agent");
            asm volatile("s_waitcnt vmcnt(0)" ::: "memory");
            const unsigned og = xb_add(&bar[XB_TOP], 1u);
            const unsigned tg = og / nx;
            if (og + 1u == (tg + 1u) * nx) xb_add(&bar[XB_TOPGEN], 1u);
            else XB_SPIN(xb_ld(&bar[XB_TOPGEN]) == tg, bar);
            __builtin_amdgcn_fence(__ATOMIC_ACQUIRE, "agent");
            xb_add(&bar[XB_XGEN(b.x)], 1u);
            asm volatile("s_waitcnt vmcnt(0)" ::: "memory");
        } else {
            XB_SPIN(xb_ld(&bar[XB_XGEN(b.x)]) == gen, bar);
            __builtin_amdgcn_fence(__ATOMIC_ACQUIRE, "agent");
            asm volatile("s_waitcnt vmcnt(0)" ::: "memory");
        }
    }
    __syncthreads();
}

namespace pg8 {
constexpr int BM = 256, BK = 64, HALF = 128, HTB = HALF * BK * 2, STAGE_BYTES = 8 * HTB, NXCD = 8, WGM = 8;
__host__ __device__ __forceinline__ int lds_byte(int r, int c) { const int st = (r >> 4) * 2 + (c >> 5), rr = r & 15, cc = c & 31, ob = rr * 64 + cc * 2; return st * 1024 + (ob ^ (((ob >> 9) & 1) << 5)); }
__host__ __device__ __forceinline__ void stage_rc(int b, int& R, int& C) { const int st = b / 1024, sb = b % 1024, swz = sb ^ (((sb >> 9) & 1) << 5); R = (st >> 1) * 16 + swz / 64; C = (st & 1) * 32 + (swz % 64) / 2; }
__host__ __device__ __forceinline__ int perm32(int rho) { const int n = rho >> 4, i = rho & 15; return 8 * (i >> 2) + 4 * n + (i & 3); }

struct Unit { int pm, pn; };
struct Gemm { const bf16_t* A; const bf16_t* Bt; int M, N, K, lda; int skew; };

struct StaticOrder {
    int nM, nN, nwg, G, c;
    __device__ void init(int M, int N, int G_, int c_) { nM = M / BM; nN = N / BM; nwg = nM * nN; G = G_; c = c_; }
    __device__ bool next(int i, Unit& u) const {
        const long L = (long)i * G + c; if (L >= nwg) return false;
        int wgid = (int)L; { const int q = nwg / NXCD, r = nwg % NXCD, xcd = wgid % NXCD, off = wgid / NXCD; wgid = (xcd < r ? xcd * (q + 1) : r * (q + 1) + (xcd - r) * q) + off; }
        const int nig = WGM * nN, gid = wgid / nig, fm = gid * WGM, gsz = (nM - fm) < WGM ? (nM - fm) : WGM;
        u.pm = fm + ((wgid % nig) % gsz); u.pn = (wgid % nig) / gsz; return true;
    }
};

struct EpiBf16 {
    static constexpr bool PERM = true;
    bf16_t* O; int ldc; bf16_t* O2; int ldc2;
    __device__ __forceinline__ void init(f32x4 (&acc)[2][2][4][2], const Unit&, int, int, int, int) const {
#pragma unroll
        for (int a = 0; a < 2; ++a)
#pragma unroll
            for (int b = 0; b < 2; ++b)
#pragma unroll
                for (int m = 0; m < 4; ++m)
#pragma unroll
                    for (int n = 0; n < 2; ++n) acc[a][b][m][n] = (f32x4){0.f, 0.f, 0.f, 0.f};
    }
    __device__ __forceinline__ void operator()(f32x4 (&acc)[2][2][4][2], const Unit& u, int wr, int wc, int fr, int fq) const {
        const int row0 = u.pm * BM + wr * 64 + fr; const bool second = u.pn >= 16; const int col0 = (second ? u.pn - 16 : u.pn) * BM + wc * 32 + 8 * fq;
        bf16_t* Ob = second ? O2 : O; const int ld = second ? ldc2 : ldc;
#pragma unroll
        for (int ai = 0; ai < 2; ++ai)
#pragma unroll
            for (int m = 0; m < 4; ++m) { bf16_t* rowp = Ob + (size_t)(row0 + ai * HALF + m * 16) * ld + col0;
#pragma unroll
                for (int bj = 0; bj < 2; ++bj) { const f32x4 v0 = acc[ai][bj][m][0], v1 = acc[ai][bj][m][1];
                    u32x4 w; w.x = cvt_pk_bf16(v0[0], v0[1]); w.y = cvt_pk_bf16(v0[2], v0[3]); w.z = cvt_pk_bf16(v1[0], v1[1]); w.w = cvt_pk_bf16(v1[2], v1[3]);
                    *(u32x4*)(rowp + bj * HALF) = w; } }
    }
};
struct EpiResidNorm {
    static constexpr bool PERM = false;
    const float* x; float* out; unsigned* ss; unsigned* cnt; const float* fg;
    __device__ __forceinline__ void init(f32x4 (&acc)[2][2][4][2], const Unit& u, int wr, int wc, int fr, int fq) const {
        const int row0 = u.pm * BM + wr * 64 + fr, col0 = u.pn * BM + wc * 32 + 4 * fq;
#pragma unroll
        for (int ai = 0; ai < 2; ++ai)
#pragma unroll
            for (int m = 0; m < 4; ++m) { const size_t off = (size_t)(row0 + ai * HALF + m * 16) * DM + col0;
#pragma unroll
                for (int bj = 0; bj < 2; ++bj)
#pragma unroll
                    for (int n = 0; n < 2; ++n) acc[ai][bj][m][n] = *(const f32x4*)(x + off + bj * HALF + n * 16); }
    }
    __device__ __forceinline__ void operator()(f32x4 (&acc)[2][2][4][2], const Unit& u, int wr, int wc, int fr, int fq) const {
        const int row0 = u.pm * BM + wr * 64 + fr, col0 = u.pn * BM + wc * 32 + 4 * fq;
#pragma unroll
        for (int ai = 0; ai < 2; ++ai)
#pragma unroll
            for (int m = 0; m < 4; ++m) { const int row = row0 + ai * HALF + m * 16; const size_t off = (size_t)row * DM + col0; float s = 0.f;
#pragma unroll
                for (int bj = 0; bj < 2; ++bj)
#pragma unroll
                    for (int n = 0; n < 2; ++n) { const f32x4 o = acc[ai][bj][m][n]; s += (o[0] * o[0] + o[1] * o[1]) + (o[2] * o[2] + o[3] * o[3]); }
                s += __shfl_xor(s, 16); s += __shfl_xor(s, 32);
                if (fq == 0) __hip_atomic_store(ss + (size_t)row * 16 + u.pn * 4 + wc, __float_as_uint(s), __ATOMIC_RELAXED, __HIP_MEMORY_SCOPE_AGENT); }
        asm volatile("s_waitcnt vmcnt(0)" ::: "memory");
        unsigned* c = cnt + (u.pm * 2 + wr) * 32;
        if ((threadIdx.x & 63) == 0) __hip_atomic_fetch_add(c, 1u, __ATOMIC_RELAXED, __HIP_MEMORY_SCOPE_AGENT);
        { unsigned spins = 0;
          while ((unsigned)__builtin_amdgcn_readfirstlane(__hip_atomic_load(c, __ATOMIC_RELAXED, __HIP_MEMORY_SCOPE_AGENT)) < 16u) { __builtin_amdgcn_s_sleep(2); if (++spins > (1u << 22)) break; } }
        __builtin_amdgcn_fence(__ATOMIC_ACQUIRE, "agent");
        asm volatile("s_waitcnt vmcnt(0)" ::: "memory");
#pragma unroll
        for (int ai = 0; ai < 2; ++ai)
#pragma unroll
            for (int m = 0; m < 4; ++m) { const int row = row0 + ai * HALF + m * 16; const size_t off = (size_t)row * DM + col0;
                const unsigned long long* sp = (const unsigned long long*)(ss + (size_t)row * 16 + fq * 4);
                const unsigned long long p0 = __hip_atomic_load(sp, __ATOMIC_RELAXED, __HIP_MEMORY_SCOPE_AGENT), p1 = __hip_atomic_load(sp + 1, __ATOMIC_RELAXED, __HIP_MEMORY_SCOPE_AGENT);
                float t = (__uint_as_float((unsigned)p0) + __uint_as_float((unsigned)(p0 >> 32))) + (__uint_as_float((unsigned)p1) + __uint_as_float((unsigned)(p1 >> 32)));
                t += __shfl_xor(t, 16); t += __shfl_xor(t, 32);
                const float rstd = 1.0f / sqrtf(t * (1.f / DM) + RMS_EPS);
#pragma unroll
                for (int bj = 0; bj < 2; ++bj)
#pragma unroll
                    for (int n = 0; n < 2; ++n) { const f32x4 gv = *(const f32x4*)(fg + col0 + bj * HALF + n * 16);
                        *(f32x4*)(out + off + bj * HALF + n * 16) = acc[ai][bj][m][n] * rstd * gv; } }
    }
};

template <class Epi>
__device__ __forceinline__ void gemm_phase(LAS unsigned char* lds, const Gemm g, const StaticOrder& S, const Epi& E) {
    const int tid = threadIdx.x, wid = __builtin_amdgcn_readfirstlane(tid >> 6), lane = tid & 63, wr = wid >> 2, wc = wid & 3, fr = lane & 15, fq = lane >> 4;
    const int K = g.K, nt = K / BK, lda = g.lda;
    unsigned voffA[2], voffB[2];
#pragma unroll
    for (int i = 0; i < 2; ++i) { int R, C; stage_rc(tid * 16 + i * 8192, R, C); const int Rb = Epi::PERM ? ((R & ~31) + perm32(R & 31)) : R;
        voffA[i] = (unsigned)(R * lda + C) * 2u; voffB[i] = (unsigned)(Rb * K + C) * 2u; }
    const size_t kstep = (size_t)(BK * 2);
    const size_t hstepA = (size_t)HALF * lda * 2, hstepB = (size_t)HALF * K * 2;
    const size_t tstepA = 2 * hstepA, tstepB = 2 * hstepB;
    const unsigned ldsw = (unsigned)wid * 1024u;
    const int aoff = lds_byte(wr * 64 + fr, fq * 8), boff = lds_byte(wc * 32 + fr, fq * 8);
#define PG8_SA(b, h) (((b) * 2 + (h)) * HTB)
#define PG8_SB(b, h) ((4 + (b) * 2 + (h)) * HTB)
#define PG8_STAGE(bufoff, gbase, voff) do { _Pragma("unroll") for (int _i = 0; _i < 2; ++_i) \
        __builtin_amdgcn_global_load_lds((const unsigned*)((const char*)(gbase) + (voff)[_i]), (LAS unsigned*)(lds + (bufoff) + ldsw + _i * 8192), 16, 0, 0); } while (0)
#define PG8_LDA(dst, b, h) do { _Pragma("unroll") for (int m = 0; m < 4; ++m) _Pragma("unroll") for (int k = 0; k < 2; ++k) dst[m][k] = *(const LAS bf16x8*)(lds + PG8_SA(b, h) + aoff + m * 2048 + k * 1024); } while (0)
#define PG8_LDB(dst, b, h) do { _Pragma("unroll") for (int n = 0; n < 2; ++n) _Pragma("unroll") for (int k = 0; k < 2; ++k) dst[n][k] = *(const LAS bf16x8*)(lds + PG8_SB(b, h) + boff + n * 2048 + k * 1024); } while (0)
#define PG8_MMA(ai, bj, At, Bt) do { __builtin_amdgcn_s_setprio(1); _Pragma("unroll") for (int m = 0; m < 4; ++m) _Pragma("unroll") for (int n = 0; n < 2; ++n) _Pragma("unroll") for (int k = 0; k < 2; ++k) \
        acc[ai][bj][m][n] = __builtin_amdgcn_mfma_f32_16x16x32_bf16(Bt[n][k], At[m][k], acc[ai][bj][m][n], 0, 0, 0); __builtin_amdgcn_s_setprio(0); } while (0)
#define PG8_WAIT_V(n) asm volatile("s_waitcnt vmcnt(" #n ")" ::: "memory")
#define PG8_WAIT_L(n) asm volatile("s_waitcnt lgkmcnt(" #n ")" ::: "memory")
#define PG8_BAR __builtin_amdgcn_s_barrier()
#define PG8_SCHED __builtin_amdgcn_sched_barrier(0)
    Unit cur, nxt; int ui = 0;
    if (!S.next(0, cur)) return;
    if (g.skew > 0) { const unsigned long long t0 = __builtin_amdgcn_s_memrealtime(), dt = (unsigned long long)((blockIdx.x & 7u) * (unsigned)g.skew);
        while (__builtin_amdgcn_s_memrealtime() - t0 < dt) __builtin_amdgcn_s_sleep(8); }
    f32x4 acc[2][2][4][2];
    E.init(acc, cur, wr, wc, fr, fq);
    bf16x8 At[4][2], B0[2][2], B1[2][2];
    const char* cA = (const char*)g.A + (size_t)cur.pm * tstepA; const char* cB = (const char*)g.Bt + (size_t)cur.pn * tstepB;
#if PG8_SP2
    PG8_STAGE(PG8_SB(0, 0), cB, voffB); PG8_STAGE(PG8_SB(0, 1), cB + hstepB, voffB); PG8_STAGE(PG8_SA(0, 0), cA, voffA); PG8_STAGE(PG8_SA(0, 1), cA + hstepA, voffA);
    if (wr == 1) PG8_BAR;
    PG8_WAIT_V(2); PG8_BAR;
    PG8_STAGE(PG8_SB(1, 0), cB + kstep, voffB); PG8_STAGE(PG8_SA(1, 0), cA + kstep, voffA); PG8_STAGE(PG8_SB(1, 1), cB + hstepB + kstep, voffB);
    PG8_WAIT_V(6); PG8_BAR;
#else
    PG8_STAGE(PG8_SB(0, 0), cB, voffB); PG8_STAGE(PG8_SA(0, 0), cA, voffA); PG8_STAGE(PG8_SB(0, 1), cB + hstepB, voffB); PG8_STAGE(PG8_SA(0, 1), cA + hstepA, voffA);
    if (wr == 1) PG8_BAR;
    PG8_WAIT_V(4); PG8_BAR;
    PG8_STAGE(PG8_SB(1, 0), cB + kstep, voffB); PG8_STAGE(PG8_SA(1, 0), cA + kstep, voffA); PG8_STAGE(PG8_SB(1, 1), cB + hstepB + kstep, voffB);
    PG8_WAIT_V(6); PG8_BAR;
#endif
    for (;;) {
        const bool has_next = S.next(ui + 1, nxt);
        const char* nA = has_next ? (const char*)g.A + (size_t)nxt.pm * tstepA : cA; const char* nB = has_next ? (const char*)g.Bt + (size_t)nxt.pn * tstepB : cB;
        for (int t = 0; t < nt; t += 2) {
            const bool last = (t == nt - 2);
            const char* a1 = cA + (size_t)(t + 1) * kstep;
            const char* a2 = last ? nA : cA + (size_t)(t + 2) * kstep; const char* b2 = last ? nB : cB + (size_t)(t + 2) * kstep;
            const char* a3 = a2 + kstep; const char* b3 = b2 + kstep;
#if PG8_SP2
            PG8_LDB(B0, 0, 0); PG8_LDB(B1, 0, 1); PG8_SCHED; PG8_LDA(At, 0, 0); PG8_STAGE(PG8_SA(1, 1), a1 + hstepA, voffA);
            PG8_WAIT_V(8); PG8_WAIT_L(0); PG8_BAR; PG8_MMA(0, 0, At, B0); PG8_MMA(0, 1, At, B1); PG8_BAR; PG8_SCHED;
            PG8_LDA(At, 0, 1); PG8_STAGE(PG8_SB(0, 0), b2, voffB); PG8_STAGE(PG8_SB(0, 1), b2 + hstepB, voffB); PG8_STAGE(PG8_SA(0, 0), a2, voffA);
            PG8_WAIT_V(8); PG8_WAIT_L(0); PG8_BAR; PG8_MMA(1, 0, At, B0); PG8_MMA(1, 1, At, B1); PG8_BAR; PG8_SCHED;
            PG8_LDB(B0, 1, 0); PG8_LDB(B1, 1, 1); PG8_SCHED; PG8_LDA(At, 1, 0); PG8_STAGE(PG8_SA(0, 1), a2 + hstepA, voffA);
            PG8_WAIT_V(8); PG8_WAIT_L(0); PG8_BAR; PG8_MMA(0, 0, At, B0); PG8_MMA(0, 1, At, B1); PG8_BAR; PG8_SCHED;
            PG8_LDA(At, 1, 1); PG8_STAGE(PG8_SB(1, 0), b3, voffB); PG8_STAGE(PG8_SB(1, 1), b3 + hstepB, voffB); PG8_STAGE(PG8_SA(1, 0), a3, voffA);
            PG8_WAIT_V(8); PG8_WAIT_L(0); PG8_BAR; PG8_MMA(1, 0, At, B0); PG8_MMA(1, 1, At, B1); PG8_BAR; PG8_SCHED;
#else
            PG8_LDB(B0, 0, 0); PG8_SCHED; PG8_LDA(At, 0, 0); PG8_STAGE(PG8_SA(1, 1), a1 + hstepA, voffA);
            PG8_WAIT_L(8); PG8_BAR; PG8_WAIT_L(0); PG8_MMA(0, 0, At, B0); PG8_BAR; PG8_SCHED;
            PG8_LDB(B1, 0, 1); PG8_STAGE(PG8_SB(0, 0), b2, voffB);
            PG8_BAR; PG8_WAIT_L(0); PG8_MMA(0, 1, At, B1); PG8_BAR;
            PG8_LDA(At, 0, 1); PG8_STAGE(PG8_SA(0, 0), a2, voffA);
            PG8_BAR; PG8_WAIT_L(0); PG8_MMA(1, 0, At, B0); PG8_BAR; PG8_SCHED;
            PG8_STAGE(PG8_SB(0, 1), b2 + hstepB, voffB);
            PG8_WAIT_V(6); PG8_BAR; PG8_MMA(1, 1, At, B1); PG8_BAR;
            PG8_LDB(B0, 1, 0); PG8_SCHED; PG8_LDA(At, 1, 0); PG8_STAGE(PG8_SA(0, 1), a2 + hstepA, voffA);
            PG8_WAIT_L(8); PG8_BAR; PG8_WAIT_L(0); PG8_MMA(0, 0, At, B0); PG8_BAR; PG8_SCHED;
            PG8_LDB(B1, 1, 1); PG8_STAGE(PG8_SB(1, 0), b3, voffB);
            PG8_BAR; PG8_WAIT_L(0); PG8_MMA(0, 1, At, B1); PG8_BAR;
            PG8_LDA(At, 1, 1); PG8_STAGE(PG8_SA(1, 0), a3, voffA);
            PG8_BAR; PG8_WAIT_L(0); PG8_MMA(1, 0, At, B0); PG8_BAR; PG8_SCHED;
            PG8_STAGE(PG8_SB(1, 1), b3 + hstepB, voffB);
            PG8_WAIT_V(6); PG8_BAR; PG8_MMA(1, 1, At, B1); PG8_BAR;
#endif
        }
#if PG8_ALIGN
        if (wr == 0) PG8_BAR;
#endif
        E(acc, cur, wr, wc, fr, fq);
        if (!has_next) break;
        cur = nxt; cA = nA; cB = nB; ++ui;
        E.init(acc, cur, wr, wc, fr, fq);
#if PG8_ALIGN
        if (wr == 1) PG8_BAR;
#endif
    }
    PG8_WAIT_V(0);
#if !PG8_ALIGN
    if (wr == 0) PG8_BAR;
#endif
    PG8_BAR;
#undef PG8_SA
#undef PG8_SB
#undef PG8_STAGE
#undef PG8_LDA
#undef PG8_LDB
#undef PG8_MMA
#undef PG8_WAIT_V
#undef PG8_WAIT_L
#undef PG8_BAR
#undef PG8_SCHED
}
}

__device__ __forceinline__ void p0_transpose_item(const float* W, int ldw, int k0, int ncol0, bf16_t* WT, int ldt, int drow0, int dk0, LAS float* scr, int lane) {
#pragma unroll 8
    for (int i = 0; i < 32; ++i) { const int kk = 2 * i + (lane >> 5); scr[kk * 33 + (lane & 31)] = W[(size_t)(k0 + kk) * ldw + ncol0 + (lane & 31)]; }
    asm volatile("s_waitcnt lgkmcnt(0)" ::: "memory");
    const int c = lane & 7;
#pragma unroll
    for (int j = 0; j < 4; ++j) { const int n = (lane >> 3) + 8 * j; const LAS float* s = scr + (8 * c) * 33 + n;
        u32x4 o; o.x = cvt_pk_bf16(s[0 * 33], s[1 * 33]); o.y = cvt_pk_bf16(s[2 * 33], s[3 * 33]); o.z = cvt_pk_bf16(s[4 * 33], s[5 * 33]); o.w = cvt_pk_bf16(s[6 * 33], s[7 * 33]);
        *(u32x4*)(WT + (size_t)(drow0 + n) * ldt + dk0 + 8 * c) = o; }
    asm volatile("s_waitcnt lgkmcnt(0)" ::: "memory");
}

__device__ __forceinline__ void phase0(const Args& a, LAS unsigned char* lds, int wave, int lane) {
    LAS float* scr = (LAS float*)(lds + wave * 16384);
    const int gw = blockIdx.x * 8 + wave, NGW = gridDim.x * 8;
    bf16_t* win_t = (bf16_t*)(a.ws + WS_WIN); bf16_t* wout_t = (bf16_t*)(a.ws + WS_WOUT); bf16_t* wg = (bf16_t*)(a.ws + WS_WG);
    constexpr int I_IN = 16 * 192, I_OUT = 32 * 32, I_G = 64;
    for (int it = gw; it < I_IN + I_OUT + I_G; it += NGW) {
        int r = it;
        if (r < I_IN) { const int kb = r / 192, nb = r % 192; const int og = nb / 32;
            const int ng = (og == 3) ? 4 : (og == 4 ? 3 : og);
            p0_transpose_item(a.in[I_WIN], NPROJ, kb * 64, nb * 32, win_t, DM, ng * 1024 + (nb % 32) * 32, kb * 64, scr, lane); continue; }
        r -= I_IN;
        if (r < I_OUT) { const int kb = r / 32, nb = r % 32; p0_transpose_item(a.in[I_WOUT], DM, kb * 64, nb * 32, wout_t, DMIX, nb * 32, kb * 64, scr, lane); continue; }
        r -= I_OUT;
        { const int mat = r / 32, h = (r % 32) / 2, nb = r & 1; const float* W = (mat ? a.in[I_WI] : a.in[I_WA]) + h * 4096;
          p0_transpose_item(W, 64, 0, nb * 32, wg + mat * 65536 + h * 4096, 64, nb * 32, 0, scr, lane); }
    }
    const float* x = a.in[I_X]; bf16_t* xn = (bf16_t*)(a.ws + WS_XN);
    f32x4 gv[4];
#pragma unroll
    for (int j = 0; j < 4; ++j) gv[j] = ((const f32x4*)a.in[I_LNG])[lane + 64 * j];
    for (int m = gw; m < T_TOK; m += NGW) {
        const f32x4* xr = (const f32x4*)(x + (size_t)m * DM) + lane;
        f32x4 v[4]; float s = 0.f;
#pragma unroll
        for (int j = 0; j < 4; ++j) { v[j] = xr[64 * j]; s += (v[j].x * v[j].x + v[j].y * v[j].y) + (v[j].z * v[j].z + v[j].w * v[j].w); }
        const float rstd = 1.0f / sqrtf(wave_sum(s) * (1.f / DM) + RMS_EPS);
        u32x2* o8 = (u32x2*)(xn + (size_t)m * DM) + lane;
#pragma unroll
        for (int j = 0; j < 4; ++j) { u32x2 w; w.x = cvt_pk_bf16(v[j].x * rstd * gv[j].x, v[j].y * rstd * gv[j].y); w.y = cvt_pk_bf16(v[j].z * rstd * gv[j].z, v[j].w * rstd * gv[j].w); o8[64 * j] = w; }
    }
}

#define DPP_ADD(v, ctrl) ((v) + __uint_as_float(__builtin_amdgcn_update_dpp(0, __float_as_uint(v), (ctrl), 0xF, 0xF, false)))
__device__ __forceinline__ void conv_item(const Args& a, bf16_t* proj, bf16_t* projg, bf16_t* obase, int ostride, int item, int wave, int lane) {
    const int q = lane >> 4, c8 = lane & 15, ch0 = wave * 128 + c8 * 8;
    float w0[8], w1[8], w2[8], gn[8];
    { const float* cw = a.in[I_CONVW] + ch0; const float* cg_ = a.in[I_CG] + ch0;
#pragma unroll
      for (int j = 0; j < 8; ++j) { w0[j] = cw[j]; w1[j] = cw[1024 + j]; w2[j] = cw[2048 + j]; gn[j] = cg_[j]; } }
    const int tok0 = item * 64 + q * 16;
    bf16_t* base = proj + (size_t)tok0 * LDPA + ch0; const bf16_t* gbase = projg + (size_t)tok0 * LDPG + ch0;
    float p2[8], p1[8];
    if ((tok0 & (SEQ - 1)) == 0) {
#pragma unroll
        for (int j = 0; j < 8; ++j) { p2[j] = 0.f; p1[j] = 0.f; }
    } else {
        const u32x4 c2 = *(const u32x4*)(base - 2 * LDPA + COL_C), x2 = *(const u32x4*)(base - 2 * LDPA + COL_XC);
        const u32x4 c1 = *(const u32x4*)(base - 1 * LDPA + COL_C), x1 = *(const u32x4*)(base - 1 * LDPA + COL_XC);
        float fc[8], fx[8];
        unpack8(c2, fc); unpack8(x2, fx);
#pragma unroll
        for (int j = 0; j < 8; ++j) p2[j] = fc[j] * fx[j];
        unpack8(c1, fc); unpack8(x1, fx);
#pragma unroll
        for (int j = 0; j < 8; ++j) p1[j] = fc[j] * fx[j];
    }
    u32x4 nb[2], nc[2], nx[2], ng[2];
#pragma unroll
    for (int k = 0; k < 2; ++k) { const bf16_t* rp = base + (size_t)k * LDPA; nb[k] = *(const u32x4*)(rp + COL_B); nc[k] = *(const u32x4*)(rp + COL_C); nx[k] = *(const u32x4*)(rp + COL_XC); ng[k] = *(const u32x4*)(gbase + (size_t)k * LDPG); }
    for (int i = 0; i < 16; i += 2) {
        u32x4 vb[2], vc[2], vx[2], vg[2];
#pragma unroll
        for (int k = 0; k < 2; ++k) { vb[k] = nb[k]; vc[k] = nc[k]; vx[k] = nx[k]; vg[k] = ng[k]; }
        if (i + 2 < 16) {
#pragma unroll
            for (int k = 0; k < 2; ++k) { const bf16_t* rp = base + (size_t)(i + 2 + k) * LDPA; nb[k] = *(const u32x4*)(rp + COL_B); nc[k] = *(const u32x4*)(rp + COL_C); nx[k] = *(const u32x4*)(rp + COL_XC); ng[k] = *(const u32x4*)(gbase + (size_t)(i + 2 + k) * LDPG); }
        }
#pragma unroll
        for (int k = 0; k < 2; ++k) {
            float fb[8], fc[8], fx[8], fg[8], y[8];
            unpack8(vb[k], fb); unpack8(vc[k], fc); unpack8(vx[k], fx); unpack8(vg[k], fg);
            float ss = 0.f;
#pragma unroll
            for (int j = 0; j < 8; ++j) { const float cx = fc[j] * fx[j]; const float cv = w0[j] * p2[j] + w1[j] * p1[j] + w2[j] * cx; y[j] = fb[j] * cv; ss += y[j] * y[j]; p2[j] = p1[j]; p1[j] = cx; }
            ss = DPP_ADD(ss, 0xB1); ss = DPP_ADD(ss, 0x4E); ss = DPP_ADD(ss, 0x141); ss = DPP_ADD(ss, 0x140);
            const float rstd = __builtin_amdgcn_rsqf(ss * (1.f / 128.f) + RMS_EPS);
            float o[8];
#pragma unroll
            for (int j = 0; j < 8; ++j) o[j] = y[j] * rstd * gn[j] * (fg[j] * sigmoid_fast(fg[j]));
            u32x4 w; w.x = cvt_pk_bf16(o[0], o[1]); w.y = cvt_pk_bf16(o[2], o[3]); w.z = cvt_pk_bf16(o[4], o[5]); w.w = cvt_pk_bf16(o[6], o[7]);
            *(u32x4*)(obase + (size_t)(tok0 + i + k) * ostride + ch0) = w;
        }
    }
}

constexpr int L_GW = 0;
constexpr int L_CW = 18432;
constexpr int L_AGG = 20992;
constexpr int L_WT = 29184;
constexpr int WT_BYTES = 8704;
static_assert(L_WT + 8 * WT_BYTES <= 131072, "lds");
typedef float f32x2 __attribute__((ext_vector_type(2)));

__device__ __forceinline__ void lru_item(const Args& a, bf16_t* proj, bf16_t* projg, bf16_t* obase, int ostride, LAS unsigned char* lds, int chain, int part, int nsplit, int tid, int wave, int lane) {
    const int b = chain >> 4, h = chain & 15;
    {
        const bf16_t* wg = (const bf16_t*)(a.ws + WS_WG);
        for (int i = tid; i < 1024; i += NTHREADS) { const int mat = i >> 9, e = (i >> 3) & 63, c = i & 7;
            const u32x4 v = *(const u32x4*)(wg + mat * 65536 + h * 4096 + e * 64 + c * 8);
            *(LAS u32x4*)(lds + L_GW + mat * 9216 + e * 144 + c * 16) = v; }
        LAS float* cw = (LAS float*)(lds + L_CW);
        if (tid < 256) cw[tid] = a.in[I_LCW][(tid >> 6) * 1024 + h * 64 + (tid & 63)];
        else if (tid < 320) { const int c = tid - 256, gc = h * 64 + c;
            cw[256 + c] = a.in[I_LCB][gc]; cw[320 + c] = a.in[I_BA][gc]; cw[384 + c] = a.in[I_BI][gc];
            const float lam = a.in[I_LAM][gc];
            const float logsig = (lam >= 0.f) ? -log1pf(expf(-lam)) : (lam - log1pf(expf(lam)));
            cw[448 + c] = 8.0f * logsig * 1.44269504f;
            cw[512 + c] = a.in[I_LG][gc]; }
    }
    __syncthreads();
    const int r = lane & 31, hh = lane >> 5;
    LAS unsigned char* wt = lds + L_WT + wave * WT_BYTES;
    LAS const float* cw = (LAS const float*)(lds + L_CW);
    bf16x8 I0, I1;
    {
        u32x4 t0 = (u32x4){0u, 0u, 0u, 0u}, t1 = t0;
        const int j0 = r - 8 * hh, j1 = r - 16 - 8 * hh;
#pragma unroll
        for (int d = 0; d < 4; ++d) {
            t0[d] = (j0 == 2 * d) ? 0x00003F80u : ((j0 == 2 * d + 1) ? 0x3F800000u : 0u);
            t1[d] = (j1 == 2 * d) ? 0x00003F80u : ((j1 == 2 * d + 1) ? 0x3F800000u : 0u);
        }
        I0 = __builtin_bit_cast(bf16x8, t0); I1 = __builtin_bit_cast(bf16x8, t1);
    }
    float ba[2], bi[2], cf[2];
#pragma unroll
    for (int n = 0; n < 2; ++n) { ba[n] = cw[320 + 32 * n + r]; bi[n] = cw[384 + 32 * n + r]; cf[n] = cw[448 + 32 * n + r]; }
    float carry[2] = {0.f, 0.f};
    unsigned* flags = (unsigned*)(a.ws + WS_CTL + 4096) + chain * 16;
    unsigned long long* aggg = (unsigned long long*)(a.ws + WS_AGG) + (size_t)chain * 16 * 64;

    const bf16_t* xl_base = proj + (size_t)b * SEQ * LDPA + COL_XL + h * 64;
    const bf16_t* gl_base = projg + (size_t)b * SEQ * LDPG + 1024 + h * 64;
    u32x4 xr[5];
#define LOAD_X(seg_) do { const int s0_ = (seg_) * 256 + wave * 32; _Pragma("unroll") for (int i = 0; i < 5; ++i) { const int idx = lane + 64 * i, row = idx >> 3, c = idx & 7; const int s = s0_ - 3 + row; \
        xr[i] = (u32x4){0u, 0u, 0u, 0u}; if (idx < 280 && s >= 0) xr[i] = *(const u32x4*)(xl_base + (size_t)s * LDPA + c * 8); } } while (0)
    LOAD_X(part);
    for (int seg = part; seg < 16; seg += nsplit) {
        const int s0 = seg * 256 + wave * 32;
#pragma unroll
        for (int i = 0; i < 5; ++i) { const int idx = lane + 64 * i, row = idx >> 3, c = idx & 7; if (idx < 280) *(LAS u32x4*)(wt + row * 144 + c * 16) = xr[i]; }
        if (seg + nsplit < 16) LOAD_X(seg + nsplit);
        u32x4 gl[4];
#define LOAD_GL() do { _Pragma("unroll") for (int i = 0; i < 4; ++i) { const int tok = (lane >> 3) + 8 * i, c = lane & 7; gl[i] = *(const u32x4*)(gl_base + (size_t)(s0 + tok) * LDPG + c * 8); } } while (0)
#if GL_EARLY
        LOAD_GL();
#endif
        asm volatile("s_waitcnt lgkmcnt(0)" ::: "memory");
        bf16x8 Af[4];
#pragma unroll
        for (int s = 0; s < 4; ++s) {
            const int c0 = 16 * s + 8 * hh;
            float u8[8];
            { const f32x4 b0 = *(LAS const f32x4*)(cw + 256 + c0), b1 = *(LAS const f32x4*)(cw + 256 + c0 + 4);
              u8[0] = b0[0]; u8[1] = b0[1]; u8[2] = b0[2]; u8[3] = b0[3]; u8[4] = b1[0]; u8[5] = b1[1]; u8[6] = b1[2]; u8[7] = b1[3]; }
#pragma unroll
            for (int k = 0; k < 4; ++k) {
                const u32x4 xv = *(LAS const u32x4*)(wt + (r + k) * 144 + c0 * 2);
                const f32x4 wv0 = *(LAS const f32x4*)(cw + k * 64 + c0), wv1 = *(LAS const f32x4*)(cw + k * 64 + c0 + 4);
                float fx[8]; unpack8(xv, fx);
                u8[0] += wv0[0] * fx[0]; u8[1] += wv0[1] * fx[1]; u8[2] += wv0[2] * fx[2]; u8[3] += wv0[3] * fx[3];
                u8[4] += wv1[0] * fx[4]; u8[5] += wv1[1] * fx[5]; u8[6] += wv1[2] * fx[6]; u8[7] += wv1[3] * fx[7];
            }
            u32x4 pk; pk.x = cvt_pk_bf16(u8[0], u8[1]); pk.y = cvt_pk_bf16(u8[2], u8[3]); pk.z = cvt_pk_bf16(u8[4], u8[5]); pk.w = cvt_pk_bf16(u8[6], u8[7]);
            Af[s] = __builtin_bit_cast(bf16x8, pk);
        }
#pragma unroll
        for (int n = 0; n < 2; ++n) {
            float hl[16], pc[16];
            f32x16 accR, accI, accU;
#pragma unroll
            for (int j = 0; j < 16; ++j) { accR[j] = 0.f; accI[j] = 0.f; accU[j] = 0.f; }
#pragma unroll
            for (int s = 0; s < 4; ++s) {
                const bf16x8 Ba = *(LAS const bf16x8*)(lds + L_GW + (32 * n + r) * 144 + (16 * s + 8 * hh) * 2);
                const bf16x8 Bi = *(LAS const bf16x8*)(lds + L_GW + 9216 + (32 * n + r) * 144 + (16 * s + 8 * hh) * 2);
                accR = __builtin_amdgcn_mfma_f32_32x32x16_bf16(Af[s], Ba, accR, 0, 0, 0);
                accI = __builtin_amdgcn_mfma_f32_32x32x16_bf16(Af[s], Bi, accI, 0, 0, 0);
            }
            accU = __builtin_amdgcn_mfma_f32_32x32x16_bf16(Af[2 * n], I0, accU, 0, 0, 0);
            accU = __builtin_amdgcn_mfma_f32_32x32x16_bf16(Af[2 * n + 1], I1, accU, 0, 0, 0);
            float gP[4], gH[4];
#pragma unroll
            for (int g = 0; g < 4; ++g) {
                float P = 1.f, H = 0.f;
#pragma unroll
                for (int i = 0; i < 4; ++i) { const int j = 4 * g + i;
                    const float rr = sigmoid_fast(accR[j] + ba[n]);
                    const float ii = sigmoid_fast(accI[j] + bi[n]);
                    const float l2 = rr * cf[n];
                    const float aa = __builtin_amdgcn_exp2f(l2);
                    const float t = l2 * 1.38629436f;
                    const float em_small = -t * (1.0f + t * (0.5f + t * (0.16666667f + t * 0.041666667f)));
                    const float one_m = (t > -0.0625f) ? em_small : (1.0f - aa * aa);
                    const float dd = __builtin_amdgcn_sqrtf(one_m) * ii * accU[j];
                    H = aa * H + dd; P = P * aa; hl[j] = H; pc[j] = P; }
                gP[g] = P; gH[g] = H;
            }
            float cp = 1.f, ch = 0.f;
#pragma unroll
            for (int g = 0; g < 4; ++g) {
                const auto sp = __builtin_amdgcn_permlane32_swap(__float_as_uint(gP[g]), __float_as_uint(gP[g]), false, false);
                const auto sh = __builtin_amdgcn_permlane32_swap(__float_as_uint(gH[g]), __float_as_uint(gH[g]), false, false);
                const float oP = __uint_as_float(hh ? sp[0] : sp[1]), oH = __uint_as_float(hh ? sh[0] : sh[1]);
                const float P = gP[g], H = gH[g];
                const float A1 = hh ? oP : P, H1 = hh ? oH : H, A2 = hh ? P : oP, H2 = hh ? H : oH;
                const float cp1 = cp * A1, ch1 = A1 * ch + H1;
                const float inP = hh ? cp1 : cp, inH = hh ? ch1 : ch;
#pragma unroll
                for (int i = 0; i < 4; ++i) { const int j = 4 * g + i; hl[j] += pc[j] * inH; pc[j] *= inP; }
                cp = cp1 * A2; ch = A2 * ch1 + H2;
            }
            if (hh == 0) *(LAS f32x2*)(lds + L_AGG + ((n * 8 + wave) * 64 + 32 * n + r) * 8) = (f32x2){cp, ch};
#if !GL_EARLY
            if (n == 1) LOAD_GL();
#endif
            if (n == 0 && nsplit > 1 && seg > 0 && wave == 0) {
                unsigned spins = 0;
                while (__builtin_amdgcn_readfirstlane(__hip_atomic_load(flags + (seg - 1), __ATOMIC_RELAXED, __HIP_MEMORY_SCOPE_AGENT)) == 0u) { __builtin_amdgcn_s_sleep(2); if (++spins > (1u << 22)) break; }
                __builtin_amdgcn_fence(__ATOMIC_ACQUIRE, "agent");
                asm volatile("s_waitcnt vmcnt(0)" ::: "memory");
            }
            __syncthreads();
            float c = carry[n];
            if (nsplit > 1 && seg > 0) {
                const unsigned long long pw = __hip_atomic_load(aggg + (size_t)(seg - 1) * 64 + n * 32 + r, __ATOMIC_RELAXED, __HIP_MEMORY_SCOPE_AGENT);
                c = __uint_as_float((unsigned)pw) * c + __uint_as_float((unsigned)(pw >> 32));
            }
            float cin = 0.f, iP = 1.f, iH = 0.f;
#pragma unroll
            for (int w = 0; w < 8; ++w) {
                const f32x2 ag = *(LAS const f32x2*)(lds + L_AGG + ((n * 8 + w) * 64 + 32 * n + r) * 8);
                cin = (w == wave) ? c : cin; c = ag.x * c + ag.y; iH = ag.x * iH + ag.y; iP *= ag.x; }
            carry[n] = c;
            if (nsplit > 1 && wave == 0 && hh == 0)
                __hip_atomic_store(aggg + (size_t)seg * 64 + n * 32 + r, ((unsigned long long)__float_as_uint(iH) << 32) | __float_as_uint(iP), __ATOMIC_RELAXED, __HIP_MEMORY_SCOPE_AGENT);
#pragma unroll
            for (int j = 0; j < 16; ++j) { const int row = (j & 3) + 8 * (j >> 2) + 4 * hh;
                *(LAS float*)(wt + row * 272 + (32 * n + r) * 4) = hl[j] + pc[j] * cin; }
        }
        if (nsplit > 1 && wave == 0) {
            asm volatile("s_waitcnt vmcnt(0)" ::: "memory");
            if (lane == 0) __hip_atomic_store(flags + seg, 1u, __ATOMIC_RELAXED, __HIP_MEMORY_SCOPE_AGENT);
        }
        asm volatile("s_waitcnt lgkmcnt(0)" ::: "memory");
#pragma unroll
        for (int i = 0; i < 4; ++i) {
            const int tok = (lane >> 3) + 8 * i, c = lane & 7;
            const f32x4 h0 = *(LAS const f32x4*)(wt + tok * 272 + c * 32), h1 = *(LAS const f32x4*)(wt + tok * 272 + c * 32 + 16);
            const f32x4 g0 = *(LAS const f32x4*)(cw + 512 + c * 8), g1 = *(LAS const f32x4*)(cw + 512 + c * 8 + 4);
            float ss = (h0[0] * h0[0] + h0[1] * h0[1]) + (h0[2] * h0[2] + h0[3] * h0[3]) + (h1[0] * h1[0] + h1[1] * h1[1]) + (h1[2] * h1[2] + h1[3] * h1[3]);
            ss = DPP_ADD(ss, 0xB1); ss = DPP_ADD(ss, 0x4E); ss = DPP_ADD(ss, 0x141);
            const float rstd = __builtin_amdgcn_rsqf(ss * (1.f / 64.f) + RMS_EPS);
            float fg[8]; unpack8(gl[i], fg);
            float o[8];
            o[0] = h0[0] * rstd * g0[0]; o[1] = h0[1] * rstd * g0[1]; o[2] = h0[2] * rstd * g0[2]; o[3] = h0[3] * rstd * g0[3];
            o[4] = h1[0] * rstd * g1[0]; o[5] = h1[1] * rstd * g1[1]; o[6] = h1[2] * rstd * g1[2]; o[7] = h1[3] * rstd * g1[3];
#pragma unroll
            for (int j = 0; j < 8; ++j) o[j] *= fg[j] * sigmoid_fast(fg[j]);
            u32x4 w; w.x = cvt_pk_bf16(o[0], o[1]); w.y = cvt_pk_bf16(o[2], o[3]); w.z = cvt_pk_bf16(o[4], o[5]); w.w = cvt_pk_bf16(o[6], o[7]);
            *(u32x4*)(obase + (size_t)(b * SEQ + s0 + tok) * ostride + h * 64 + c * 8) = w;
        }
        asm volatile("s_waitcnt lgkmcnt(0)" ::: "memory");
    }
#undef LOAD_X
    __syncthreads();
}

__global__ void __launch_bounds__(NTHREADS, 2) hymba_fwd(Args a) {
    extern __shared__ __attribute__((aligned(16))) unsigned char lds_raw[];
    LAS unsigned char* lds = (LAS unsigned char*)lds_raw;
    cg::grid_group grid = cg::this_grid();
    if (gridDim.y == 0x7fffu) grid.sync();
    volatile LAS unsigned* bst = (volatile LAS unsigned*)(lds + 131072 + 64);
    if (threadIdx.x == 0) { bst[0] = 0u; bst[1] = 0u; }
    __syncthreads();
    const XcdBarrier bar = xcd_barrier_post((unsigned*)(a.ws + WS_CTL + 32768), bst);
    const int tid = threadIdx.x, lane = tid & 63, wave = __builtin_amdgcn_readfirstlane(tid >> 6);
    bf16_t* proj = (bf16_t*)(a.ws + WS_PROJ); bf16_t* projg = (bf16_t*)(a.ws + WS_PROJG);

#pragma unroll
    for (int rep = 0; rep < REP0; ++rep) {
#ifndef SKIP_P0
    phase0(a, lds, wave, lane);
#endif

    xcd_barrier(bar); }
#pragma unroll
    for (int rep = 0; rep < REP1; ++rep) {
        pg8::Gemm g{(const bf16_t*)(a.ws + WS_XN), (const bf16_t*)(a.ws + WS_WIN), T_TOK, NPROJ, DM, DM, SKEW1};
        pg8::StaticOrder S; S.init(T_TOK, NPROJ, (int)gridDim.x, (int)blockIdx.x);
        pg8::EpiBf16 E{proj, LDPA, projg, LDPG};
#ifndef SKIP_G1
        pg8::gemm_phase<pg8::EpiBf16>(lds, g, S, E);
#endif
    xcd_barrier(bar); }
    {
        bf16_t* xn_scratch = (bf16_t*)(a.ws + WS_XN);
        for (int rep = 0; rep < a.nrep_lru; ++rep) {
            bf16_t* ob = (rep + 1 < a.nrep_lru) ? xn_scratch : projg + 1024; const int os = (rep + 1 < a.nrep_lru) ? DM : LDPG;
#ifndef SKIP_LRU
            if (gridDim.x >= 256) { if (blockIdx.x < 256) lru_item(a, proj, projg, ob, os, lds, (int)blockIdx.x >> 1, (int)blockIdx.x & 1, 2, tid, wave, lane); }
            else for (int it = blockIdx.x; it < 128; it += gridDim.x) lru_item(a, proj, projg, ob, os, lds, it, 0, 1, tid, wave, lane);
#endif
        }
        LAS unsigned* qs = (LAS unsigned*)(lds + 131072);
        for (int rep = 0; rep < a.nrep_conv; ++rep) {
            bf16_t* ob = (rep + 1 < a.nrep_conv) ? xn_scratch : projg; const int os = (rep + 1 < a.nrep_conv) ? DM : LDPG;
            unsigned* qctr = (unsigned*)(a.ws + WS_CTL) + rep;
            for (;;) {
                if (tid == 0) qs[0] = atomicAdd(qctr, 1u);
                __syncthreads();
                const unsigned it = qs[0];
                __syncthreads();
                if (it >= (unsigned)(T_TOK / 64)) break;
#ifndef SKIP_CONV
                conv_item(a, proj, projg, ob, os, (int)it, wave, lane);
#endif
            }
        }
    }
    xcd_barrier(bar);
#pragma unroll
    for (int rep = 0; rep < REP3; ++rep) {
        pg8::Gemm g{projg, (const bf16_t*)(a.ws + WS_WOUT), T_TOK, DM, DMIX, LDPG, SKEW3};
        pg8::StaticOrder S; S.init(T_TOK, DM, (int)gridDim.x, (int)blockIdx.x);
        pg8::EpiResidNorm E{a.in[I_X], a.out, (unsigned*)(a.ws + WS_SS), (unsigned*)(a.ws + WS_CTL + 16384) + rep * 0, a.in[I_FG]};
#ifndef SKIP_G2
        pg8::gemm_phase<pg8::EpiResidNorm>(lds, g, S, E);
#endif
    }
}

extern "C" void kernel_launch(void* const* d_in, const int* in_sizes, int n_in, void* d_out, int out_size, void* d_ws, size_t ws_size, hipStream_t stream) {
    static int grid = 0;
    if (grid == 0) {
        if (n_in != 15 || out_size != T_TOK * DM || ws_size < WS_END) { fprintf(stderr, "kernel_launch: unexpected shapes (n_in %d out %d ws %zu)\n", n_in, out_size, ws_size); grid = -1; return; }
        int dev = 0, cus = 0, per_cu = 0;
        hipGetDevice(&dev);
        hipDeviceGetAttribute(&cus, hipDeviceAttributeMultiprocessorCount, dev);
        if (hipFuncSetAttribute((const void*)hymba_fwd, hipFuncAttributeMaxDynamicSharedMemorySize, LDS_BYTES) != hipSuccess) { fprintf(stderr, "kernel_launch: hipFuncSetAttribute failed\n"); grid = -1; return; }
        if (hipOccupancyMaxActiveBlocksPerMultiprocessor(&per_cu, (const void*)hymba_fwd, NTHREADS, LDS_BYTES) != hipSuccess || per_cu < 1) { fprintf(stderr, "kernel_launch: occupancy query says %d\n", per_cu); per_cu = 1; }
        (void)hipGetLastError();
        grid = cus;
        if (grid != 256) { fprintf(stderr, "kernel_launch: built for a 256-CU device (got %d)\n", cus); grid = -1; return; }
    }
    if (grid < 0) return;
    hipMemsetAsync((char*)d_ws + WS_CTL, 0, CTL_BYTES, stream);
    Args a{};
    for (int i = 0; i < 15; ++i) a.in[i] = (const float*)d_in[i];
    a.out = (float*)d_out; a.ws = (unsigned char*)d_ws; a.nrep_lru = REPLRU; a.nrep_conv = REPCONV;
    void* args[] = {&a};
    hipError_t e = hipLaunchCooperativeKernel((const void*)hymba_fwd, dim3(grid), dim3(NTHREADS), args, LDS_BYTES, stream);
    if (e != hipSuccess) fprintf(stderr, "kernel_launch: cooperative launch failed: %s (grid %d)\n", hipGetErrorString(e), grid);
}
```

```cpp
#include <hip/hip_runtime.h>
#include <hip/hip_cooperative_groups.h>
#include <cstdio>
namespace cg = cooperative_groups;

#define LAS __attribute__((address_space(3)))
typedef unsigned short bf16_t;
typedef short bf16x8 __attribute__((ext_vector_type(8)));
typedef float f32x4 __attribute__((ext_vector_type(4)));
typedef float f32x16 __attribute__((ext_vector_type(16)));
typedef unsigned u32x4 __attribute__((ext_vector_type(4)));
typedef unsigned u32x2 __attribute__((ext_vector_type(2)));

constexpr int T_TOK = 32768, SEQ = 4096, DM = 1024, NPROJ = 6144, DMIX = 2048;
constexpr float RMS_EPS = 1e-6f;
constexpr int COL_B = 0, COL_CX = 1024, COL_XL = 2048;
constexpr size_t MiB = 1u << 20;
constexpr size_t WS_CTL = 0, CTL_BYTES = 65536;
constexpr size_t WS_WIN = 2 * MiB;
constexpr size_t WS_WOUT = 14 * MiB;
constexpr size_t WS_WG = 18 * MiB;
constexpr size_t WS_SS = 20 * MiB;
constexpr size_t WS_AGG = 22 * MiB;
constexpr size_t WS_XN = 32 * MiB;
constexpr size_t WS_PROJ = 96 * MiB;
constexpr int LDPA = 3072, LDPG = 2048;
constexpr size_t WS_PROJG = WS_PROJ + (size_t)T_TOK * LDPA * 2;
constexpr size_t WS_END = WS_PROJG + (size_t)T_TOK * LDPG * 2;
static_assert(WS_END <= 480 * MiB, "ws");
constexpr int LDS_BYTES = 147456;
constexpr int NTHREADS = 512;
#ifndef REP0
#define REP0 1
#endif
#ifndef REP1
#define REP1 1
#endif
#ifndef REP3
#define REP3 1
#endif
#ifndef PG8_SP2
#define PG8_SP2 1
#endif
#ifndef PG8_ALIGN
#define PG8_ALIGN 1
#endif
#ifndef SKEW1
#define SKEW1 0
#endif
#ifndef SKEW3
#define SKEW3 0
#endif
#ifndef GL_EARLY
#define GL_EARLY 0
#endif
#ifndef REPLRU
#define REPLRU 1
#endif
#ifndef REPCONV
#define REPCONV 1
#endif

struct Args { const float* in[15]; float* out; unsigned char* ws; int nrep_lru, nrep_conv; };
enum { I_X = 0, I_LNG, I_WIN, I_CONVW, I_LCW, I_LCB, I_WA, I_BA, I_WI, I_BI, I_LAM, I_CG, I_LG, I_WOUT, I_FG };

__device__ __forceinline__ unsigned cvt_pk_bf16(float lo, float hi) { unsigned r; asm volatile("v_cvt_pk_bf16_f32 %0, %1, %2" : "=v"(r) : "v"(lo), "v"(hi)); return r; }
__device__ __forceinline__ float bf_lo(unsigned w) { return __uint_as_float(w << 16); }
__device__ __forceinline__ float bf_hi(unsigned w) { return __uint_as_float(w & 0xffff0000u); }
__device__ __forceinline__ float wave_sum(float v) {
#pragma unroll
    for (int o = 1; o < 64; o <<= 1) v += __shfl_xor(v, o);
    return v;
}
__device__ __forceinline__ float sigmoid_fast(float x) { return __builtin_amdgcn_rcpf(1.0f + __builtin_amdgcn_exp2f(-1.44269504f * x)); }
__device__ __forceinline__ void unpack8(const u32x4 v, float (&f)[8]) {
    f[0] = bf_lo(v.x); f[1] = bf_hi(v.x); f[2] = bf_lo(v.y); f[3] = bf_hi(v.y); f[4] = bf_lo(v.z); f[5] = bf_hi(v.z); f[6] = bf_lo(v.w); f[7] = bf_hi(v.w);
}


#define XB_TMO      128
#define XB_XCNT(j)  (256  + 64 * (j))
#define XB_XSUB(j)  (1280 + 64 * (j))
#define XB_XGEN(j)  (2304 + 64 * (j))
#define XB_TOP      3328
#define XB_TOPGEN   3392
#define XCD_BAR_WORDS 3456
#define XB_SPIN_CAP (1u << 20)
__device__ __forceinline__ unsigned xb_ld(unsigned* p)              { return __hip_atomic_load(p, __ATOMIC_RELAXED, __HIP_MEMORY_SCOPE_AGENT); }
__device__ __forceinline__ unsigned xb_add(unsigned* p, unsigned v) { return __hip_atomic_fetch_add(p, v, __ATOMIC_RELAXED, __HIP_MEMORY_SCOPE_AGENT); }
__device__ __forceinline__ unsigned xb_xcc_id() { return (unsigned)__builtin_amdgcn_s_getreg((3 << 11) | 20) & 0xFu; }
#define XB_SPIN(cond, bar) do { unsigned _sp = 0; while (cond) { __builtin_amdgcn_s_sleep(1); \
    if ((++_sp & 255u) == 0u) { if (xb_ld(&(bar)[XB_TMO])) break; if (_sp > XB_SPIN_CAP) { atomicAdd(&(bar)[XB_TMO], 1u); break; } } } } while (0)
struct XcdBarrier { unsigned* bar; unsigned x; volatile LAS unsigned* st; };
__device__ __forceinline__ XcdBarrier xcd_barrier_post(unsigned* bar, volatile LAS unsigned* st) {
    XcdBarrier b; b.bar = bar; b.x = xb_xcc_id(); b.st = st;
    if (threadIdx.x == 0) (void)xb_add(&bar[XB_XCNT(b.x)], 1u);
    return b;
}
__device__ __forceinline__ void xcd_barrier_complete(unsigned* bar, unsigned x, unsigned& nloc, unsigned& nx) {
    const unsigned G = gridDim.x * gridDim.y * gridDim.z;
    unsigned sum, cnt, mine, sp = 0u;
    for (;;) {
        sum = 0u; cnt = 0u; mine = 0u;
#pragma unroll
        for (unsigned j = 0; j < 16; ++j) { const unsigned c = xb_ld(&bar[XB_XCNT(j)]); sum += c; cnt += (c > 0u) ? 1u : 0u; mine = (j == x) ? c : mine; }
        if (sum == G) break;
        __builtin_amdgcn_s_sleep(1);
        if ((++sp & 255u) == 0u) { if (xb_ld(&bar[XB_TMO])) break; if (sp > XB_SPIN_CAP) { atomicAdd(&bar[XB_TMO], 1u); break; } }
    }
    nloc = mine > 0u ? mine : 1u; nx = cnt > 0u ? cnt : 1u;
}
__device__ __forceinline__ void xcd_barrier(const XcdBarrier& b) {
    asm volatile("s_waitcnt vmcnt(0)" ::: "memory");
    __syncthreads();
    if (threadIdx.x == 0) {
        unsigned* bar = b.bar;
        __builtin_amdgcn_s_waitcnt(0);
        unsigned nloc = b.st[0], nx = b.st[1];
        if (nloc == 0u) { xcd_barrier_complete(bar, b.x, nloc, nx); b.st[0] = nloc; b.st[1] = nx; }
        const unsigned old = xb_add(&bar[XB_XSUB(b.x)], 1u);
        const unsigned gen = old / nloc;
        if (old + 1u == (gen + 1u) * nloc) {
            __builtin_amdgcn_fence(__ATOMIC_RELEASE, "agent");
            asm volatile("s_waitcnt vmcnt(0)" ::: "memory");
            const unsigned og = xb_add(&bar[XB_TOP], 1u);
            const unsigned tg = og / nx;
            if (og + 1u == (tg + 1u) * nx) xb_add(&bar[XB_TOPGEN], 1u);
            else XB_SPIN(xb_ld(&bar[XB_TOPGEN]) == tg, bar);
            __builtin_amdgcn_fence(__ATOMIC_ACQUIRE, "agent");
            xb_add(&bar[XB_XGEN(b.x)], 1u);
            asm volatile("s_waitcnt vmcnt(0)" ::: "memory");
        } else {
            XB_SPIN(xb_ld(&bar[XB_XGEN(b.x)]) == gen, bar);
            __builtin_amdgcn_fence(__ATOMIC_ACQUIRE, "agent");
            asm volatile("s_waitcnt vmcnt(0)" ::: "memory");
        }
    }
    __syncthreads();
}

namespace pg8 {
constexpr int BM = 256, BK = 64, HALF = 128, HTB = HALF * BK * 2, STAGE_BYTES = 8 * HTB, NXCD = 8, WGM = 8;
__host__ __device__ __forceinline__ int lds_byte(int r, int c) { const int st = (r >> 4) * 2 + (c >> 5), rr = r & 15, cc = c & 31, ob = rr * 64 + cc * 2; return st * 1024 + (ob ^ (((ob >> 9) & 1) << 5)); }
__host__ __device__ __forceinline__ void stage_rc(int b, int& R, int& C) { const int st = b / 1024, sb = b % 1024, swz = sb ^ (((sb >> 9) & 1) << 5); R = (st >> 1) * 16 + swz / 64; C = (st & 1) * 32 + (swz % 64) / 2; }
__host__ __device__ __forceinline__ int perm32(int rho) { const int n = rho >> 4, i = rho & 15; return 8 * (i >> 2) + 4 * n + (i & 3); }

struct Unit { int pm, pn; };
struct Gemm { const bf16_t* A; const bf16_t* Bt; int M, N, K, lda; int skew; };

struct StaticOrder {
    int nM, nN, nwg, G, c;
    __device__ void init(int M, int N, int G_, int c_) { nM = M / BM; nN = N / BM; nwg = nM * nN; G = G_; c = c_; }
    __device__ bool next(int i, Unit& u) const {
        const long L = (long)i * G + c; if (L >= nwg) return false;
        int wgid = (int)L; { const int q = nwg / NXCD, r = nwg % NXCD, xcd = wgid % NXCD, off = wgid / NXCD; wgid = (xcd < r ? xcd * (q + 1) : r * (q + 1) + (xcd - r) * q) + off; }
        const int nig = WGM * nN, gid = wgid / nig, fm = gid * WGM, gsz = (nM - fm) < WGM ? (nM - fm) : WGM;
        u.pm = fm + ((wgid % nig) % gsz); u.pn = (wgid % nig) / gsz; return true;
    }
};

struct EpiBf16 {
    static constexpr bool PERM = true;
    bf16_t* O; int ldc; bf16_t* O2; int ldc2;
    __device__ __forceinline__ void init(f32x4 (&acc)[2][2][4][2], const Unit&, int, int, int, int) const {
#pragma unroll
        for (int a = 0; a < 2; ++a)
#pragma unroll
            for (int b = 0; b < 2; ++b)
#pragma unroll
                for (int m = 0; m < 4; ++m)
#pragma unroll
                    for (int n = 0; n < 2; ++n) acc[a][b][m][n] = (f32x4){0.f, 0.f, 0.f, 0.f};
    }
    __device__ __forceinline__ void operator()(f32x4 (&acc)[2][2][4][2], const Unit& u, int wr, int wc, int fr, int fq) const {
        const int row0 = u.pm * BM + wr * 64 + fr; const int pn = u.pn;
        if (pn >= 4 && pn < 12) {
            const int colb = 1024 + 128 * (pn - 4) + 16 * wc + 4 * fq;
#pragma unroll
            for (int ai = 0; ai < 2; ++ai)
#pragma unroll
                for (int m = 0; m < 4; ++m) { bf16_t* rowp = O + (size_t)(row0 + ai * HALF + m * 16) * ldc + colb;
#pragma unroll
                    for (int bj = 0; bj < 2; ++bj) { const f32x4 p = acc[ai][bj][m][0] * acc[ai][bj][m][1];
                        u32x2 w; w.x = cvt_pk_bf16(p[0], p[1]); w.y = cvt_pk_bf16(p[2], p[3]);
                        *(u32x2*)(rowp + bj * 64) = w; } }
        } else {
            const bool second = pn >= 16;
            const int col0 = (second ? (pn - 16) * BM : (pn >= 12 ? 2048 + (pn - 12) * BM : pn * BM)) + wc * 32 + 8 * fq;
            bf16_t* Ob = second ? O2 : O; const int ld = second ? ldc2 : ldc;
#pragma unroll
            for (int ai = 0; ai < 2; ++ai)
#pragma unroll
                for (int m = 0; m < 4; ++m) { bf16_t* rowp = Ob + (size_t)(row0 + ai * HALF + m * 16) * ld + col0;
#pragma unroll
                    for (int bj = 0; bj < 2; ++bj) { f32x4 v0 = acc[ai][bj][m][0], v1 = acc[ai][bj][m][1];
                        if (second) {
#pragma unroll
                            for (int i = 0; i < 4; ++i) { v0[i] = v0[i] * sigmoid_fast(v0[i]); v1[i] = v1[i] * sigmoid_fast(v1[i]); } }
                        u32x4 w; w.x = cvt_pk_bf16(v0[0], v0[1]); w.y = cvt_pk_bf16(v0[2], v0[3]); w.z = cvt_pk_bf16(v1[0], v1[1]); w.w = cvt_pk_bf16(v1[2], v1[3]);
                        *(u32x4*)(rowp + bj * HALF) = w; } }
        }
    }
};
struct EpiResidNorm {
    static constexpr bool PERM = false;
    const float* x; float* out; unsigned* ss; unsigned* cnt; const float* fg;
    __device__ __forceinline__ void init(f32x4 (&acc)[2][2][4][2], const Unit& u, int wr, int wc, int fr, int fq) const {
        const int row0 = u.pm * BM + wr * 64 + fr, col0 = u.pn * BM + wc * 32 + 4 * fq;
#pragma unroll
        for (int ai = 0; ai < 2; ++ai)
#pragma unroll
            for (int m = 0; m < 4; ++m) { const size_t off = (size_t)(row0 + ai * HALF + m * 16) * DM + col0;
#pragma unroll
                for (int bj = 0; bj < 2; ++bj)
#pragma unroll
                    for (int n = 0; n < 2; ++n) acc[ai][bj][m][n] = *(const f32x4*)(x + off + bj * HALF + n * 16); }
    }
    __device__ __forceinline__ void operator()(f32x4 (&acc)[2][2][4][2], const Unit& u, int wr, int wc, int fr, int fq) const {
        const int row0 = u.pm * BM + wr * 64 + fr, col0 = u.pn * BM + wc * 32 + 4 * fq;
#pragma unroll
        for (int ai = 0; ai < 2; ++ai)
#pragma unroll
            for (int m = 0; m < 4; ++m) { const int row = row0 + ai * HALF + m * 16; const size_t off = (size_t)row * DM + col0; float s = 0.f;
#pragma unroll
                for (int bj = 0; bj < 2; ++bj)
#pragma unroll
                    for (int n = 0; n < 2; ++n) { const f32x4 o = acc[ai][bj][m][n]; s += (o[0] * o[0] + o[1] * o[1]) + (o[2] * o[2] + o[3] * o[3]); }
                s += __shfl_xor(s, 16); s += __shfl_xor(s, 32);
                if (fq == 0) __hip_atomic_store(ss + (size_t)row * 16 + u.pn * 4 + wc, __float_as_uint(s), __ATOMIC_RELAXED, __HIP_MEMORY_SCOPE_AGENT); }
        asm volatile("s_waitcnt vmcnt(0)" ::: "memory");
        unsigned* c = cnt + (u.pm * 2 + wr) * 32;
        if ((threadIdx.x & 63) == 0) __hip_atomic_fetch_add(c, 1u, __ATOMIC_RELAXED, __HIP_MEMORY_SCOPE_AGENT);
        { unsigned spins = 0;
          while ((unsigned)__builtin_amdgcn_readfirstlane(__hip_atomic_load(c, __ATOMIC_RELAXED, __HIP_MEMORY_SCOPE_AGENT)) < 16u) { __builtin_amdgcn_s_sleep(2); if (++spins > (1u << 22)) break; } }
        __builtin_amdgcn_fence(__ATOMIC_ACQUIRE, "agent");
        asm volatile("s_waitcnt vmcnt(0)" ::: "memory");
#pragma unroll
        for (int ai = 0; ai < 2; ++ai)
#pragma unroll
            for (int m = 0; m < 4; ++m) { const int row = row0 + ai * HALF + m * 16; const size_t off = (size_t)row * DM + col0;
                const unsigned long long* sp = (const unsigned long long*)(ss + (size_t)row * 16 + fq * 4);
                const unsigned long long p0 = __hip_atomic_load(sp, __ATOMIC_RELAXED, __HIP_MEMORY_SCOPE_AGENT), p1 = __hip_atomic_load(sp + 1, __ATOMIC_RELAXED, __HIP_MEMORY_SCOPE_AGENT);
                float t = (__uint_as_float((unsigned)p0) + __uint_as_float((unsigned)(p0 >> 32))) + (__uint_as_float((unsigned)p1) + __uint_as_float((unsigned)(p1 >> 32)));
                t += __shfl_xor(t, 16); t += __shfl_xor(t, 32);
                const float rstd = 1.0f / sqrtf(t * (1.f / DM) + RMS_EPS);
#pragma unroll
                for (int bj = 0; bj < 2; ++bj)
#pragma unroll
                    for (int n = 0; n < 2; ++n) { const f32x4 gv = *(const f32x4*)(fg + col0 + bj * HALF + n * 16);
                        *(f32x4*)(out + off + bj * HALF + n * 16) = acc[ai][bj][m][n] * rstd * gv; } }
    }
};

template <class Epi>
__device__ __forceinline__ void gemm_phase(LAS unsigned char* lds, const Gemm g, const StaticOrder& S, const Epi& E) {
    const int tid = threadIdx.x, wid = __builtin_amdgcn_readfirstlane(tid >> 6), lane = tid & 63, wr = wid >> 2, wc = wid & 3, fr = lane & 15, fq = lane >> 4;
    const int K = g.K, nt = K / BK, lda = g.lda;
    unsigned voffA[2], voffB[2];
#pragma unroll
    for (int i = 0; i < 2; ++i) { int R, C; stage_rc(tid * 16 + i * 8192, R, C); const int Rb = Epi::PERM ? ((R & ~31) + perm32(R & 31)) : R;
        voffA[i] = (unsigned)(R * lda + C) * 2u; voffB[i] = (unsigned)(Rb * K + C) * 2u; }
    const size_t kstep = (size_t)(BK * 2);
    const size_t hstepA = (size_t)HALF * lda * 2, hstepB = (size_t)HALF * K * 2;
    const size_t tstepA = 2 * hstepA, tstepB = 2 * hstepB;
    const unsigned ldsw = (unsigned)wid * 1024u;
    const int aoff = lds_byte(wr * 64 + fr, fq * 8), boff = lds_byte(wc * 32 + fr, fq * 8);
#define PG8_SA(b, h) (((b) * 2 + (h)) * HTB)
#define PG8_SB(b, h) ((4 + (b) * 2 + (h)) * HTB)
#define PG8_STAGE(bufoff, gbase, voff) do { _Pragma("unroll") for (int _i = 0; _i < 2; ++_i) \
        __builtin_amdgcn_global_load_lds((const unsigned*)((const char*)(gbase) + (voff)[_i]), (LAS unsigned*)(lds + (bufoff) + ldsw + _i * 8192), 16, 0, 0); } while (0)
#define PG8_LDA(dst, b, h) do { _Pragma("unroll") for (int m = 0; m < 4; ++m) _Pragma("unroll") for (int k = 0; k < 2; ++k) dst[m][k] = *(const LAS bf16x8*)(lds + PG8_SA(b, h) + aoff + m * 2048 + k * 1024); } while (0)
#define PG8_LDB(dst, b, h) do { _Pragma("unroll") for (int n = 0; n < 2; ++n) _Pragma("unroll") for (int k = 0; k < 2; ++k) dst[n][k] = *(const LAS bf16x8*)(lds + PG8_SB(b, h) + boff + n * 2048 + k * 1024); } while (0)
#define PG8_MMA(ai, bj, At, Bt) do { __builtin_amdgcn_s_setprio(1); _Pragma("unroll") for (int m = 0; m < 4; ++m) _Pragma("unroll") for (int n = 0; n < 2; ++n) _Pragma("unroll") for (int k = 0; k < 2; ++k) \
        acc[ai][bj][m][n] = __builtin_amdgcn_mfma_f32_16x16x32_bf16(Bt[n][k], At[m][k], acc[ai][bj][m][n], 0, 0, 0); __builtin_amdgcn_s_setprio(0); } while (0)
#define PG8_WAIT_V(n) asm volatile("s_waitcnt vmcnt(" #n ")" ::: "memory")
#define PG8_WAIT_L(n) asm volatile("s_waitcnt lgkmcnt(" #n ")" ::: "memory")
#define PG8_BAR __builtin_amdgcn_s_barrier()
#define PG8_SCHED __builtin_amdgcn_sched_barrier(0)
    Unit cur, nxt; int ui = 0;
    if (!S.next(0, cur)) return;
    if (g.skew > 0) { const unsigned long long t0 = __builtin_amdgcn_s_memrealtime(), dt = (unsigned long long)((blockIdx.x & 7u) * (unsigned)g.skew);
        while (__builtin_amdgcn_s_memrealtime() - t0 < dt) __builtin_amdgcn_s_sleep(8); }
    f32x4 acc[2][2][4][2];
    E.init(acc, cur, wr, wc, fr, fq);
    bf16x8 At[4][2], B0[2][2], B1[2][2];
    const char* cA = (const char*)g.A + (size_t)cur.pm * tstepA; const char* cB = (const char*)g.Bt + (size_t)cur.pn * tstepB;
#if PG8_SP2
    PG8_STAGE(PG8_SB(0, 0), cB, voffB); PG8_STAGE(PG8_SB(0, 1), cB + hstepB, voffB); PG8_STAGE(PG8_SA(0, 0), cA, voffA); PG8_STAGE(PG8_SA(0, 1), cA + hstepA, voffA);
    if (wr == 1) PG8_BAR;
    PG8_WAIT_V(2); PG8_BAR;
    PG8_STAGE(PG8_SB(1, 0), cB + kstep, voffB); PG8_STAGE(PG8_SA(1, 0), cA + kstep, voffA); PG8_STAGE(PG8_SB(1, 1), cB + hstepB + kstep, voffB);
    PG8_WAIT_V(6); PG8_BAR;
#else
    PG8_STAGE(PG8_SB(0, 0), cB, voffB); PG8_STAGE(PG8_SA(0, 0), cA, voffA); PG8_STAGE(PG8_SB(0, 1), cB + hstepB, voffB); PG8_STAGE(PG8_SA(0, 1), cA + hstepA, voffA);
    if (wr == 1) PG8_BAR;
    PG8_WAIT_V(4); PG8_BAR;
    PG8_STAGE(PG8_SB(1, 0), cB + kstep, voffB); PG8_STAGE(PG8_SA(1, 0), cA + kstep, voffA); PG8_STAGE(PG8_SB(1, 1), cB + hstepB + kstep, voffB);
    PG8_WAIT_V(6); PG8_BAR;
#endif
    for (;;) {
        const bool has_next = S.next(ui + 1, nxt);
        const char* nA = has_next ? (const char*)g.A + (size_t)nxt.pm * tstepA : cA; const char* nB = has_next ? (const char*)g.Bt + (size_t)nxt.pn * tstepB : cB;
        for (int t = 0; t < nt; t += 2) {
            const bool last = (t == nt - 2);
            const char* a1 = cA + (size_t)(t + 1) * kstep;
            const char* a2 = last ? nA : cA + (size_t)(t + 2) * kstep; const char* b2 = last ? nB : cB + (size_t)(t + 2) * kstep;
            const char* a3 = a2 + kstep; const char* b3 = b2 + kstep;
#if PG8_SP2
            PG8_LDB(B0, 0, 0); PG8_LDB(B1, 0, 1); PG8_SCHED; PG8_LDA(At, 0, 0); PG8_STAGE(PG8_SA(1, 1), a1 + hstepA, voffA);
            PG8_WAIT_V(8); PG8_WAIT_L(0); PG8_BAR; PG8_MMA(0, 0, At, B0); PG8_MMA(0, 1, At, B1); PG8_BAR; PG8_SCHED;
            PG8_LDA(At, 0, 1); PG8_STAGE(PG8_SB(0, 0), b2, voffB); PG8_STAGE(PG8_SB(0, 1), b2 + hstepB, voffB); PG8_STAGE(PG8_SA(0, 0), a2, voffA);
            PG8_WAIT_V(8); PG8_WAIT_L(0); PG8_BAR; PG8_MMA(1, 0, At, B0); PG8_MMA(1, 1, At, B1); PG8_BAR; PG8_SCHED;
            PG8_LDB(B0, 1, 0); PG8_LDB(B1, 1, 1); PG8_SCHED; PG8_LDA(At, 1, 0); PG8_STAGE(PG8_SA(0, 1), a2 + hstepA, voffA);
            PG8_WAIT_V(8); PG8_WAIT_L(0); PG8_BAR; PG8_MMA(0, 0, At, B0); PG8_MMA(0, 1, At, B1); PG8_BAR; PG8_SCHED;
            PG8_LDA(At, 1, 1); PG8_STAGE(PG8_SB(1, 0), b3, voffB); PG8_STAGE(PG8_SB(1, 1), b3 + hstepB, voffB); PG8_STAGE(PG8_SA(1, 0), a3, voffA);
            PG8_WAIT_V(8); PG8_WAIT_L(0); PG8_BAR; PG8_MMA(1, 0, At, B0); PG8_MMA(1, 1, At, B1); PG8_BAR; PG8_SCHED;
#else
            PG8_LDB(B0, 0, 0); PG8_SCHED; PG8_LDA(At, 0, 0); PG8_STAGE(PG8_SA(1, 1), a1 + hstepA, voffA);
            PG8_WAIT_L(8); PG8_BAR; PG8_WAIT_L(0); PG8_MMA(0, 0, At, B0); PG8_BAR; PG8_SCHED;
            PG8_LDB(B1, 0, 1); PG8_STAGE(PG8_SB(0, 0), b2, voffB);
            PG8_BAR; PG8_WAIT_L(0); PG8_MMA(0, 1, At, B1); PG8_BAR;
            PG8_LDA(At, 0, 1); PG8_STAGE(PG8_SA(0, 0), a2, voffA);
            PG8_BAR; PG8_WAIT_L(0); PG8_MMA(1, 0, At, B0); PG8_BAR; PG8_SCHED;
            PG8_STAGE(PG8_SB(0, 1), b2 + hstepB, voffB);
            PG8_WAIT_V(6); PG8_BAR; PG8_MMA(1, 1, At, B1); PG8_BAR;
            PG8_LDB(B0, 1, 0); PG8_SCHED; PG8_LDA(At, 1, 0); PG8_STAGE(PG8_SA(0, 1), a2 + hstepA, voffA);
            PG8_WAIT_L(8); PG8_BAR; PG8_WAIT_L(0); PG8_MMA(0, 0, At, B0); PG8_BAR; PG8_SCHED;
            PG8_LDB(B1, 1, 1); PG8_STAGE(PG8_SB(1, 0), b3, voffB);
            PG8_BAR; PG8_WAIT_L(0); PG8_MMA(0, 1, At, B1); PG8_BAR;
            PG8_LDA(At, 1, 1); PG8_STAGE(PG8_SA(1, 0), a3, voffA);
            PG8_BAR; PG8_WAIT_L(0); PG8_MMA(1, 0, At, B0); PG8_BAR; PG8_SCHED;
            PG8_STAGE(PG8_SB(1, 1), b3 + hstepB, voffB);
            PG8_WAIT_V(6); PG8_BAR; PG8_MMA(1, 1, At, B1); PG8_BAR;
#endif
        }
#if PG8_ALIGN
        if (wr == 0) PG8_BAR;
#endif
        E(acc, cur, wr, wc, fr, fq);
        if (!has_next) break;
        cur = nxt; cA = nA; cB = nB; ++ui;
        E.init(acc, cur, wr, wc, fr, fq);
#if PG8_ALIGN
        if (wr == 1) PG8_BAR;
#endif
    }
    PG8_WAIT_V(0);
#if !PG8_ALIGN
    if (wr == 0) PG8_BAR;
#endif
    PG8_BAR;
#undef PG8_SA
#undef PG8_SB
#undef PG8_STAGE
#undef PG8_LDA
#undef PG8_LDB
#undef PG8_MMA
#undef PG8_WAIT_V
#undef PG8_WAIT_L
#undef PG8_BAR
#undef PG8_SCHED
}
}

__device__ __forceinline__ void p0_transpose_item(const float* W, int ldw, int k0, int ncol0, bf16_t* WT, int ldt, int drow0, int dk0, LAS float* scr, int lane, int mode = 0) {
#pragma unroll 8
    for (int i = 0; i < 32; ++i) { const int kk = 2 * i + (lane >> 5); scr[kk * 33 + (lane & 31)] = W[(size_t)(k0 + kk) * ldw + ncol0 + (lane & 31)]; }
    asm volatile("s_waitcnt lgkmcnt(0)" ::: "memory");
    const int c = lane & 7;
#pragma unroll
    for (int j = 0; j < 4; ++j) { const int n = (lane >> 3) + 8 * j; const LAS float* s = scr + (8 * c) * 33 + n;
        u32x4 o; o.x = cvt_pk_bf16(s[0 * 33], s[1 * 33]); o.y = cvt_pk_bf16(s[2 * 33], s[3 * 33]); o.z = cvt_pk_bf16(s[4 * 33], s[5 * 33]); o.w = cvt_pk_bf16(s[6 * 33], s[7 * 33]);
        int drow = drow0 + n;
        if (mode) { const int ch = drow0 + n; drow = 1024 + 256 * (ch >> 7) + 128 * ((ch >> 6) & 1) + 32 * ((ch >> 4) & 3) + 8 * ((ch >> 2) & 3) + 4 * (mode - 1) + (ch & 3); }
        *(u32x4*)(WT + (size_t)drow * ldt + dk0 + 8 * c) = o; }
    asm volatile("s_waitcnt lgkmcnt(0)" ::: "memory");
}

__device__ __forceinline__ void phase0(const Args& a, LAS unsigned char* lds, int wave, int lane) {
    LAS float* scr = (LAS float*)(lds + wave * 16384);
    const int gw = blockIdx.x * 8 + wave, NGW = gridDim.x * 8;
    bf16_t* win_t = (bf16_t*)(a.ws + WS_WIN); bf16_t* wout_t = (bf16_t*)(a.ws + WS_WOUT); bf16_t* wg = (bf16_t*)(a.ws + WS_WG);
    constexpr int I_IN = 16 * 192, I_OUT = 32 * 32, I_G = 64;
    for (int it = gw; it < I_IN + I_OUT + I_G; it += NGW) {
        int r = it;
        if (r < I_IN) { const int kb = r / 192, nb = r % 192; const int og = nb / 32;
            if (og == 1 || og == 2) p0_transpose_item(a.in[I_WIN], NPROJ, kb * 64, nb * 32, win_t, DM, (nb % 32) * 32, kb * 64, scr, lane, og);
            else { const int nbase = (og == 0) ? 0 : (og == 4 ? 3072 : (og == 3 ? 4096 : 5120));
                p0_transpose_item(a.in[I_WIN], NPROJ, kb * 64, nb * 32, win_t, DM, nbase + (nb % 32) * 32, kb * 64, scr, lane, 0); }
            continue; }
        r -= I_IN;
        if (r < I_OUT) { const int kb = r / 32, nb = r % 32; p0_transpose_item(a.in[I_WOUT], DM, kb * 64, nb * 32, wout_t, DMIX, nb * 32, kb * 64, scr, lane); continue; }
        r -= I_OUT;
        { const int mat = r / 32, h = (r % 32) / 2, nb = r & 1; const float* W = (mat ? a.in[I_WI] : a.in[I_WA]) + h * 4096;
          p0_transpose_item(W, 64, 0, nb * 32, wg + mat * 65536 + h * 4096, 64, nb * 32, 0, scr, lane); }
    }
    const float* x = a.in[I_X]; bf16_t* xn = (bf16_t*)(a.ws + WS_XN);
    f32x4 gv[4];
#pragma unroll
    for (int j = 0; j < 4; ++j) gv[j] = ((const f32x4*)a.in[I_LNG])[lane + 64 * j];
    for (int m = gw; m < T_TOK; m += NGW) {
        const f32x4* xr = (const f32x4*)(x + (size_t)m * DM) + lane;
        f32x4 v[4]; float s = 0.f;
#pragma unroll
        for (int j = 0; j < 4; ++j) { v[j] = xr[64 * j]; s += (v[j].x * v[j].x + v[j].y * v[j].y) + (v[j].z * v[j].z + v[j].w * v[j].w); }
        const float rstd = 1.0f / sqrtf(wave_sum(s) * (1.f / DM) + RMS_EPS);
        u32x2* o8 = (u32x2*)(xn + (size_t)m * DM) + lane;
#pragma unroll
        for (int j = 0; j < 4; ++j) { u32x2 w; w.x = cvt_pk_bf16(v[j].x * rstd * gv[j].x, v[j].y * rstd * gv[j].y); w.y = cvt_pk_bf16(v[j].z * rstd * gv[j].z, v[j].w * rstd * gv[j].w); o8[64 * j] = w; }
    }
}

#define DPP_ADD(v, ctrl) ((v) + __uint_as_float(__builtin_amdgcn_update_dpp(0, __float_as_uint(v), (ctrl), 0xF, 0xF, false)))
__device__ __forceinline__ void conv_item(const Args& a, bf16_t* proj, bf16_t* projg, bf16_t* obase, int ostride, int item, int wave, int lane) {
    const int q = lane >> 4, c8 = lane & 15, ch0 = wave * 128 + c8 * 8;
    float w0[8], w1[8], w2[8], gn[8];
    { const float* cw = a.in[I_CONVW] + ch0; const float* cg_ = a.in[I_CG] + ch0;
#pragma unroll
      for (int j = 0; j < 8; ++j) { w0[j] = cw[j]; w1[j] = cw[1024 + j]; w2[j] = cw[2048 + j]; gn[j] = cg_[j]; } }
    const int tok0 = item * 64 + q * 16;
    bf16_t* base = proj + (size_t)tok0 * LDPA + ch0; const bf16_t* gbase = projg + (size_t)tok0 * LDPG + ch0;
    float p2[8], p1[8];
    if ((tok0 & (SEQ - 1)) == 0) {
#pragma unroll
        for (int j = 0; j < 8; ++j) { p2[j] = 0.f; p1[j] = 0.f; }
    } else {
        const u32x4 c2 = *(const u32x4*)(base - 2 * LDPA + COL_CX), c1 = *(const u32x4*)(base - 1 * LDPA + COL_CX);
        unpack8(c2, p2); unpack8(c1, p1);
    }
    u32x4 nb[2], nc[2], ng[2];
#pragma unroll
    for (int k = 0; k < 2; ++k) { const bf16_t* rp = base + (size_t)k * LDPA; nb[k] = *(const u32x4*)(rp + COL_B); nc[k] = *(const u32x4*)(rp + COL_CX); ng[k] = *(const u32x4*)(gbase + (size_t)k * LDPG); }
    for (int i = 0; i < 16; i += 2) {
        u32x4 vb[2], vc[2], vg[2];
#pragma unroll
        for (int k = 0; k < 2; ++k) { vb[k] = nb[k]; vc[k] = nc[k]; vg[k] = ng[k]; }
        if (i + 2 < 16) {
#pragma unroll
            for (int k = 0; k < 2; ++k) { const bf16_t* rp = base + (size_t)(i + 2 + k) * LDPA; nb[k] = *(const u32x4*)(rp + COL_B); nc[k] = *(const u32x4*)(rp + COL_CX); ng[k] = *(const u32x4*)(gbase + (size_t)(i + 2 + k) * LDPG); }
        }
#pragma unroll
        for (int k = 0; k < 2; ++k) {
            float fb[8], cx[8], fg[8], y[8];
            unpack8(vb[k], fb); unpack8(vc[k], cx); unpack8(vg[k], fg);
            float ss = 0.f;
#pragma unroll
            for (int j = 0; j < 8; ++j) { const float cv = w0[j] * p2[j] + w1[j] * p1[j] + w2[j] * cx[j]; y[j] = fb[j] * cv; ss += y[j] * y[j]; p2[j] = p1[j]; p1[j] = cx[j]; }
            ss = DPP_ADD(ss, 0xB1); ss = DPP_ADD(ss, 0x4E); ss = DPP_ADD(ss, 0x141); ss = DPP_ADD(ss, 0x140);
            const float rstd = __builtin_amdgcn_rsqf(ss * (1.f / 128.f) + RMS_EPS);
            float o[8];
#pragma unroll
            for (int j = 0; j < 8; ++j) o[j] = y[j] * rstd * gn[j] * fg[j];
            u32x4 w; w.x = cvt_pk_bf16(o[0], o[1]); w.y = cvt_pk_bf16(o[2], o[3]); w.z = cvt_pk_bf16(o[4], o[5]); w.w = cvt_pk_bf16(o[6], o[7]);
            *(u32x4*)(obase + (size_t)(tok0 + i + k) * ostride + ch0) = w;
        }
    }
}

constexpr int L_GW = 0;
constexpr int L_CW = 18432;
constexpr int L_AGG = 20992;
constexpr int L_WT = 29184;
constexpr int WT_BYTES = 8704;
static_assert(L_WT + 8 * WT_BYTES <= 131072, "lds");
typedef float f32x2 __attribute__((ext_vector_type(2)));

__device__ __forceinline__ void lru_item(const Args& a, bf16_t* proj, bf16_t* projg, bf16_t* obase, int ostride, LAS unsigned char* lds, int chain, int part, int nsplit, int tid, int wave, int lane) {
    const int b = chain >> 4, h = chain & 15;
    {
        const bf16_t* wg = (const bf16_t*)(a.ws + WS_WG);
        for (int i = tid; i < 1024; i += NTHREADS) { const int mat = i >> 9, e = (i >> 3) & 63, c = i & 7;
            const u32x4 v = *(const u32x4*)(wg + mat * 65536 + h * 4096 + e * 64 + c * 8);
            *(LAS u32x4*)(lds + L_GW + mat * 9216 + e * 144 + c * 16) = v; }
        LAS float* cw = (LAS float*)(lds + L_CW);
        if (tid < 256) cw[tid] = a.in[I_LCW][(tid >> 6) * 1024 + h * 64 + (tid & 63)];
        else if (tid < 320) { const int c = tid - 256, gc = h * 64 + c;
            cw[256 + c] = a.in[I_LCB][gc]; cw[320 + c] = a.in[I_BA][gc]; cw[384 + c] = a.in[I_BI][gc];
            const float lam = a.in[I_LAM][gc];
            const float logsig = (lam >= 0.f) ? -log1pf(expf(-lam)) : (lam - log1pf(expf(lam)));
            cw[448 + c] = 8.0f * logsig * 1.44269504f;
            cw[512 + c] = a.in[I_LG][gc]; }
    }
    __syncthreads();
    const int r = lane & 31, hh = lane >> 5;
    LAS unsigned char* wt = lds + L_WT + wave * WT_BYTES;
    LAS const float* cw = (LAS const float*)(lds + L_CW);
    bf16x8 I0, I1;
    {
        u32x4 t0 = (u32x4){0u, 0u, 0u, 0u}, t1 = t0;
        const int j0 = r - 8 * hh, j1 = r - 16 - 8 * hh;
#pragma unroll
        for (int d = 0; d < 4; ++d) {
            t0[d] = (j0 == 2 * d) ? 0x00003F80u : ((j0 == 2 * d + 1) ? 0x3F800000u : 0u);
            t1[d] = (j1 == 2 * d) ? 0x00003F80u : ((j1 == 2 * d + 1) ? 0x3F800000u : 0u);
        }
        I0 = __builtin_bit_cast(bf16x8, t0); I1 = __builtin_bit_cast(bf16x8, t1);
    }
    float ba[2], bi[2], cf[2];
#pragma unroll
    for (int n = 0; n < 2; ++n) { ba[n] = cw[320 + 32 * n + r]; bi[n] = cw[384 + 32 * n + r]; cf[n] = cw[448 + 32 * n + r]; }
    float carry[2] = {0.f, 0.f};
    unsigned* flags = (unsigned*)(a.ws + WS_CTL + 4096) + chain * 16;
    unsigned long long* aggg = (unsigned long long*)(a.ws + WS_AGG) + (size_t)chain * 16 * 64;

    const bf16_t* xl_base = proj + (size_t)b * SEQ * LDPA + COL_XL + h * 64;
    const bf16_t* gl_base = projg + (size_t)b * SEQ * LDPG + 1024 + h * 64;
    u32x4 xr[5];
#define LOAD_X(seg_) do { const int s0_ = (seg_) * 256 + wave * 32; _Pragma("unroll") for (int i = 0; i < 5; ++i) { const int idx = lane + 64 * i, row = idx >> 3, c = idx & 7; const int s = s0_ - 3 + row; \
        xr[i] = (u32x4){0u, 0u, 0u, 0u}; if (idx < 280 && s >= 0) xr[i] = *(const u32x4*)(xl_base + (size_t)s * LDPA + c * 8); } } while (0)
    LOAD_X(part);
    for (int seg = part; seg < 16; seg += nsplit) {
        const int s0 = seg * 256 + wave * 32;
#pragma unroll
        for (int i = 0; i < 5; ++i) { const int idx = lane + 64 * i, row = idx >> 3, c = idx & 7; if (idx < 280) *(LAS u32x4*)(wt + row * 144 + c * 16) = xr[i]; }
        if (seg + nsplit < 16) LOAD_X(seg + nsplit);
        u32x4 gl[4];
#define LOAD_GL() do { _Pragma("unroll") for (int i = 0; i < 4; ++i) { const int tok = (lane >> 3) + 8 * i, c = lane & 7; gl[i] = *(const u32x4*)(gl_base + (size_t)(s0 + tok) * LDPG + c * 8); } } while (0)
#if GL_EARLY
        LOAD_GL();
#endif
        asm volatile("s_waitcnt lgkmcnt(0)" ::: "memory");
        bf16x8 Af[4];
#pragma unroll
        for (int s = 0; s < 4; ++s) {
            const int c0 = 16 * s + 8 * hh;
            float u8[8];
            { const f32x4 b0 = *(LAS const f32x4*)(cw + 256 + c0), b1 = *(LAS const f32x4*)(cw + 256 + c0 + 4);
              u8[0] = b0[0]; u8[1] = b0[1]; u8[2] = b0[2]; u8[3] = b0[3]; u8[4] = b1[0]; u8[5] = b1[1]; u8[6] = b1[2]; u8[7] = b1[3]; }
#pragma unroll
            for (int k = 0; k < 4; ++k) {
                const u32x4 xv = *(LAS const u32x4*)(wt + (r + k) * 144 + c0 * 2);
                const f32x4 wv0 = *(LAS const f32x4*)(cw + k * 64 + c0), wv1 = *(LAS const f32x4*)(cw + k * 64 + c0 + 4);
                float fx[8]; unpack8(xv, fx);
                u8[0] += wv0[0] * fx[0]; u8[1] += wv0[1] * fx[1]; u8[2] += wv0[2] * fx[2]; u8[3] += wv0[3] * fx[3];
                u8[4] += wv1[0] * fx[4]; u8[5] += wv1[1] * fx[5]; u8[6] += wv1[2] * fx[6]; u8[7] += wv1[3] * fx[7];
            }
            u32x4 pk; pk.x = cvt_pk_bf16(u8[0], u8[1]); pk.y = cvt_pk_bf16(u8[2], u8[3]); pk.z = cvt_pk_bf16(u8[4], u8[5]); pk.w = cvt_pk_bf16(u8[6], u8[7]);
            Af[s] = __builtin_bit_cast(bf16x8, pk);
        }
#pragma unroll
        for (int n = 0; n < 2; ++n) {
            float hl[16], pc[16];
            f32x16 accR, accI, accU;
#pragma unroll
            for (int j = 0; j < 16; ++j) { accR[j] = 0.f; accI[j] = 0.f; accU[j] = 0.f; }
#pragma unroll
            for (int s = 0; s < 4; ++s) {
                const bf16x8 Ba = *(LAS const bf16x8*)(lds + L_GW + (32 * n + r) * 144 + (16 * s + 8 * hh) * 2);
                const bf16x8 Bi = *(LAS const bf16x8*)(lds + L_GW + 9216 + (32 * n + r) * 144 + (16 * s + 8 * hh) * 2);
                accR = __builtin_amdgcn_mfma_f32_32x32x16_bf16(Af[s], Ba, accR, 0, 0, 0);
                accI = __builtin_amdgcn_mfma_f32_32x32x16_bf16(Af[s], Bi, accI, 0, 0, 0);
            }
            accU = __builtin_amdgcn_mfma_f32_32x32x16_bf16(Af[2 * n], I0, accU, 0, 0, 0);
            accU = __builtin_amdgcn_mfma_f32_32x32x16_bf16(Af[2 * n + 1], I1, accU, 0, 0, 0);
            float gP[4], gH[4];
#pragma unroll
            for (int g = 0; g < 4; ++g) {
                float P = 1.f, H = 0.f;
#pragma unroll
                for (int i = 0; i < 4; ++i) { const int j = 4 * g + i;
                    const float rr = sigmoid_fast(accR[j] + ba[n]);
                    const float ii = sigmoid_fast(accI[j] + bi[n]);
                    const float l2 = rr * cf[n];
                    const float aa = __builtin_amdgcn_exp2f(l2);
                    const float t = l2 * 1.38629436f;
                    const float em_small = -t * (1.0f + t * (0.5f + t * (0.16666667f + t * 0.041666667f)));
                    const float one_m = (t > -0.0625f) ? em_small : (1.0f - aa * aa);
                    const float dd = __builtin_amdgcn_sqrtf(one_m) * ii * accU[j];
                    H = aa * H + dd; P = P * aa; hl[j] = H; pc[j] = P; }
                gP[g] = P; gH[g] = H;
            }
            float cp = 1.f, ch = 0.f;
#pragma unroll
            for (int g = 0; g < 4; ++g) {
                const auto sp = __builtin_amdgcn_permlane32_swap(__float_as_uint(gP[g]), __float_as_uint(gP[g]), false, false);
                const auto sh = __builtin_amdgcn_permlane32_swap(__float_as_uint(gH[g]), __float_as_uint(gH[g]), false, false);
                const float oP = __uint_as_float(hh ? sp[0] : sp[1]), oH = __uint_as_float(hh ? sh[0] : sh[1]);
                const float P = gP[g], H = gH[g];
                const float A1 = hh ? oP : P, H1 = hh ? oH : H, A2 = hh ? P : oP, H2 = hh ? H : oH;
                const float cp1 = cp * A1, ch1 = A1 * ch + H1;
                const float inP = hh ? cp1 : cp, inH = hh ? ch1 : ch;
#pragma unroll
                for (int i = 0; i < 4; ++i) { const int j = 4 * g + i; hl[j] += pc[j] * inH; pc[j] *= inP; }
                cp = cp1 * A2; ch = A2 * ch1 + H2;
            }
            if (hh == 0) *(LAS f32x2*)(lds + L_AGG + ((n * 8 + wave) * 64 + 32 * n + r) * 8) = (f32x2){cp, ch};
#if !GL_EARLY
            if (n == 1) LOAD_GL();
#endif
            if (n == 0 && nsplit > 1 && seg > 0 && wave == 0) {
                unsigned spins = 0;
                while (__builtin_amdgcn_readfirstlane(__hip_atomic_load(flags + (seg - 1), __ATOMIC_RELAXED, __HIP_MEMORY_SCOPE_AGENT)) == 0u) { __builtin_amdgcn_s_sleep(2); if (++spins > (1u << 22)) break; }
                __builtin_amdgcn_fence(__ATOMIC_ACQUIRE, "agent");
                asm volatile("s_waitcnt vmcnt(0)" ::: "memory");
            }
            __syncthreads();
            float c = carry[n];
            if (nsplit > 1 && seg > 0) {
                const unsigned long long pw = __hip_atomic_load(aggg + (size_t)(seg - 1) * 64 + n * 32 + r, __ATOMIC_RELAXED, __HIP_MEMORY_SCOPE_AGENT);
                c = __uint_as_float((unsigned)pw) * c + __uint_as_float((unsigned)(pw >> 32));
            }
            float cin = 0.f, iP = 1.f, iH = 0.f;
#pragma unroll
            for (int w = 0; w < 8; ++w) {
                const f32x2 ag = *(LAS const f32x2*)(lds + L_AGG + ((n * 8 + w) * 64 + 32 * n + r) * 8);
                cin = (w == wave) ? c : cin; c = ag.x * c + ag.y; iH = ag.x * iH + ag.y; iP *= ag.x; }
            carry[n] = c;
            if (nsplit > 1 && wave == 0 && hh == 0)
                __hip_atomic_store(aggg + (size_t)seg * 64 + n * 32 + r, ((unsigned long long)__float_as_uint(iH) << 32) | __float_as_uint(iP), __ATOMIC_RELAXED, __HIP_MEMORY_SCOPE_AGENT);
#pragma unroll
            for (int j = 0; j < 16; ++j) { const int row = (j & 3) + 8 * (j >> 2) + 4 * hh;
                *(LAS float*)(wt + row * 272 + (32 * n + r) * 4) = hl[j] + pc[j] * cin; }
        }
        if (nsplit > 1 && wave == 0) {
            asm volatile("s_waitcnt vmcnt(0)" ::: "memory");
            if (lane == 0) __hip_atomic_store(flags + seg, 1u, __ATOMIC_RELAXED, __HIP_MEMORY_SCOPE_AGENT);
        }
        asm volatile("s_waitcnt lgkmcnt(0)" ::: "memory");
#pragma unroll
        for (int i = 0; i < 4; ++i) {
            const int tok = (lane >> 3) + 8 * i, c = lane & 7;
            const f32x4 h0 = *(LAS const f32x4*)(wt + tok * 272 + c * 32), h1 = *(LAS const f32x4*)(wt + tok * 272 + c * 32 + 16);
            const f32x4 g0 = *(LAS const f32x4*)(cw + 512 + c * 8), g1 = *(LAS const f32x4*)(cw + 512 + c * 8 + 4);
            float ss = (h0[0] * h0[0] + h0[1] * h0[1]) + (h0[2] * h0[2] + h0[3] * h0[3]) + (h1[0] * h1[0] + h1[1] * h1[1]) + (h1[2] * h1[2] + h1[3] * h1[3]);
            ss = DPP_ADD(ss, 0xB1); ss = DPP_ADD(ss, 0x4E); ss = DPP_ADD(ss, 0x141);
            const float rstd = __builtin_amdgcn_rsqf(ss * (1.f / 64.f) + RMS_EPS);
            float fg[8]; unpack8(gl[i], fg);
            float o[8];
            o[0] = h0[0] * rstd * g0[0]; o[1] = h0[1] * rstd * g0[1]; o[2] = h0[2] * rstd * g0[2]; o[3] = h0[3] * rstd * g0[3];
            o[4] = h1[0] * rstd * g1[0]; o[5] = h1[1] * rstd * g1[1]; o[6] = h1[2] * rstd * g1[2]; o[7] = h1[3] * rstd * g1[3];
#pragma unroll
            for (int j = 0; j < 8; ++j) o[j] *= fg[j];
            u32x4 w; w.x = cvt_pk_bf16(o[0], o[1]); w.y = cvt_pk_bf16(o[2], o[3]); w.z = cvt_pk_bf16(o[4], o[5]); w.w = cvt_pk_bf16(o[6], o[7]);
            *(u32x4*)(obase + (size_t)(b * SEQ + s0 + tok) * ostride + h * 64 + c * 8) = w;
        }
        asm volatile("s_waitcnt lgkmcnt(0)" ::: "memory");
    }
#undef LOAD_X
    __syncthreads();
}

__global__ void __launch_bounds__(NTHREADS, 2) hymba_fwd(Args a) {
    extern __shared__ __attribute__((aligned(16))) unsigned char lds_raw[];
    LAS unsigned char* lds = (LAS unsigned char*)lds_raw;
    cg::grid_group grid = cg::this_grid();
    if (gridDim.y == 0x7fffu) grid.sync();
    volatile LAS unsigned* bst = (volatile LAS unsigned*)(lds + 131072 + 64);
    if (threadIdx.x == 0) { bst[0] = 0u; bst[1] = 0u; }
    __syncthreads();
    const XcdBarrier bar = xcd_barrier_post((unsigned*)(a.ws + WS_CTL + 32768), bst);
    const int tid = threadIdx.x, lane = tid & 63, wave = __builtin_amdgcn_readfirstlane(tid >> 6);
    bf16_t* proj = (bf16_t*)(a.ws + WS_PROJ); bf16_t* projg = (bf16_t*)(a.ws + WS_PROJG);

#pragma unroll
    for (int rep = 0; rep < REP0; ++rep) {
#ifndef SKIP_P0
    phase0(a, lds, wave, lane);
#endif

    xcd_barrier(bar); }
#pragma unroll
    for (int rep = 0; rep < REP1; ++rep) {
        pg8::Gemm g{(const bf16_t*)(a.ws + WS_XN), (const bf16_t*)(a.ws + WS_WIN), T_TOK, NPROJ, DM, DM, SKEW1};
        pg8::StaticOrder S; S.init(T_TOK, NPROJ, (int)gridDim.x, (int)blockIdx.x);
        pg8::EpiBf16 E{proj, LDPA, projg, LDPG};
#ifndef SKIP_G1
        pg8::gemm_phase<pg8::EpiBf16>(lds, g, S, E);
#endif
    xcd_barrier(bar); }
    {
        bf16_t* xn_scratch = (bf16_t*)(a.ws + WS_XN);
        for (int rep = 0; rep < a.nrep_lru; ++rep) {
            bf16_t* ob = (rep + 1 < a.nrep_lru) ? xn_scratch : projg + 1024; const int os = (rep + 1 < a.nrep_lru) ? DM : LDPG;
#ifndef SKIP_LRU
            if (gridDim.x >= 256) { if (blockIdx.x < 256) lru_item(a, proj, projg, ob, os, lds, (int)blockIdx.x >> 1, (int)blockIdx.x & 1, 2, tid, wave, lane); }
            else for (int it = blockIdx.x; it < 128; it += gridDim.x) lru_item(a, proj, projg, ob, os, lds, it, 0, 1, tid, wave, lane);
#endif
        }
        LAS unsigned* qs = (LAS unsigned*)(lds + 131072);
        for (int rep = 0; rep < a.nrep_conv; ++rep) {
            bf16_t* ob = (rep + 1 < a.nrep_conv) ? xn_scratch : projg; const int os = (rep + 1 < a.nrep_conv) ? DM : LDPG;
            unsigned* qctr = (unsigned*)(a.ws + WS_CTL) + rep;
            for (;;) {
                if (tid == 0) qs[0] = atomicAdd(qctr, 1u);
                __syncthreads();
                const unsigned it = qs[0];
                __syncthreads();
                if (it >= (unsigned)(T_TOK / 64)) break;
#ifndef SKIP_CONV
                conv_item(a, proj, projg, ob, os, (int)it, wave, lane);
#endif
            }
        }
    }
    xcd_barrier(bar);
#pragma unroll
    for (int rep = 0; rep < REP3; ++rep) {
        pg8::Gemm g{projg, (const bf16_t*)(a.ws + WS_WOUT), T_TOK, DM, DMIX, LDPG, SKEW3};
        pg8::StaticOrder S; S.init(T_TOK, DM, (int)gridDim.x, (int)blockIdx.x);
        pg8::EpiResidNorm E{a.in[I_X], a.out, (unsigned*)(a.ws + WS_SS), (unsigned*)(a.ws + WS_CTL + 16384) + rep * 0, a.in[I_FG]};
#ifndef SKIP_G2
        pg8::gemm_phase<pg8::EpiResidNorm>(lds, g, S, E);
#endif
    }
}

extern "C" void kernel_launch(void* const* d_in, const int* in_sizes, int n_in, void* d_out, int out_size, void* d_ws, size_t ws_size, hipStream_t stream) {
    static int grid = 0;
    if (grid == 0) {
        if (n_in != 15 || out_size != T_TOK * DM || ws_size < WS_END) { fprintf(stderr, "kernel_launch: unexpected shapes (n_in %d out %d ws %zu)\n", n_in, out_size, ws_size); grid = -1; return; }
        int dev = 0, cus = 0, per_cu = 0;
        hipGetDevice(&dev);
        hipDeviceGetAttribute(&cus, hipDeviceAttributeMultiprocessorCount, dev);
        if (hipFuncSetAttribute((const void*)hymba_fwd, hipFuncAttributeMaxDynamicSharedMemorySize, LDS_BYTES) != hipSuccess) { fprintf(stderr, "kernel_launch: hipFuncSetAttribute failed\n"); grid = -1; return; }
        if (hipOccupancyMaxActiveBlocksPerMultiprocessor(&per_cu, (const void*)hymba_fwd, NTHREADS, LDS_BYTES) != hipSuccess || per_cu < 1) { fprintf(stderr, "kernel_launch: occupancy query says %d\n", per_cu); per_cu = 1; }
        (void)hipGetLastError();
        grid = cus;
        if (grid != 256) { fprintf(stderr, "kernel_launch: built for a 256-CU device (got %d)\n", cus); grid = -1; return; }
    }
    if (grid < 0) return;
    hipMemsetAsync((char*)d_ws + WS_CTL, 0, CTL_BYTES, stream);
    Args a{};
    for (int i = 0; i < 15; ++i) a.in[i] = (const float*)d_in[i];
    a.out = (float*)d_out; a.ws = (unsigned char*)d_ws; a.nrep_lru = REPLRU; a.nrep_conv = REPCONV;
    void* args[] = {&a};
    hipError_t e = hipLaunchCooperativeKernel((const void*)hymba_fwd, dim3(grid), dim3(NTHREADS), args, LDS_BYTES, stream);
    if (e != hipSuccess) fprintf(stderr, "kernel_launch: cooperative launch failed: %s (grid %d)\n", hipGetErrorString(e), grid);
}
```

```cpp
#include <hip/hip_runtime.h>
#include <hip/hip_cooperative_groups.h>
#include <cstdio>
namespace cg = cooperative_groups;

#define LAS __attribute__((address_space(3)))
typedef unsigned short bf16_t;
typedef short bf16x8 __attribute__((ext_vector_type(8)));
typedef float f32x4 __attribute__((ext_vector_type(4)));
typedef float f32x16 __attribute__((ext_vector_type(16)));
typedef unsigned u32x4 __attribute__((ext_vector_type(4)));
typedef unsigned u32x2 __attribute__((ext_vector_type(2)));

constexpr int T_TOK = 32768, SEQ = 4096, DM = 1024, NPROJ = 6144, DMIX = 2048;
constexpr float RMS_EPS = 1e-6f;
constexpr int COL_B = 0, COL_CX = 1024, COL_XL = 2048;
constexpr size_t MiB = 1u << 20;
constexpr size_t WS_CTL = 0, CTL_BYTES = 131072;
constexpr size_t WS_WIN = 2 * MiB;
constexpr size_t WS_WOUT = 14 * MiB;
constexpr size_t WS_WG = 18 * MiB;
constexpr size_t WS_SS = 20 * MiB;
constexpr size_t WS_AGG = 22 * MiB;
constexpr size_t WS_XN = 32 * MiB;
constexpr size_t WS_PROJ = 96 * MiB;
constexpr int LDPA = 3072, LDPG = 2048;
constexpr size_t WS_PROJG = WS_PROJ + (size_t)T_TOK * LDPA * 2;
constexpr size_t WS_END = WS_PROJG + (size_t)T_TOK * LDPG * 2;
static_assert(WS_END <= 480 * MiB, "ws");
constexpr int LDS_BYTES = 147456;
constexpr int NTHREADS = 512;
#ifndef REP0
#define REP0 1
#endif
#ifndef REP1
#define REP1 1
#endif
#ifndef REP3
#define REP3 1
#endif
#ifndef PG8_SP2
#define PG8_SP2 1
#endif
#ifndef PG8_ALIGN
#define PG8_ALIGN 1
#endif
#ifndef SKEW1
#define SKEW1 0
#endif
#ifndef SKEW3
#define SKEW3 0
#endif
#ifndef GL_EARLY
#define GL_EARLY 1
#endif
#ifndef REPLRU
#define REPLRU 1
#endif
#ifndef REPCONV
#define REPCONV 1
#endif

struct Args { const float* in[15]; float* out; unsigned char* ws; };
enum { I_X = 0, I_LNG, I_WIN, I_CONVW, I_LCW, I_LCB, I_WA, I_BA, I_WI, I_BI, I_LAM, I_CG, I_LG, I_WOUT, I_FG };

__device__ __forceinline__ unsigned cvt_pk_bf16(float lo, float hi) { unsigned r; asm volatile("v_cvt_pk_bf16_f32 %0, %1, %2" : "=v"(r) : "v"(lo), "v"(hi)); return r; }
__device__ __forceinline__ float bf_lo(unsigned w) { return __uint_as_float(w << 16); }
__device__ __forceinline__ float bf_hi(unsigned w) { return __uint_as_float(w & 0xffff0000u); }
__device__ __forceinline__ float wave_sum(float v) {
#pragma unroll
    for (int o = 1; o < 64; o <<= 1) v += __shfl_xor(v, o);
    return v;
}
__device__ __forceinline__ float sigmoid_fast(float x) { return __builtin_amdgcn_rcpf(1.0f + __builtin_amdgcn_exp2f(-1.44269504f * x)); }
__device__ __forceinline__ void unpack8(const u32x4 v, float (&f)[8]) {
    f[0] = bf_lo(v.x); f[1] = bf_hi(v.x); f[2] = bf_lo(v.y); f[3] = bf_hi(v.y); f[4] = bf_lo(v.z); f[5] = bf_hi(v.z); f[6] = bf_lo(v.w); f[7] = bf_hi(v.w);
}


#define XB_TMO      128
#define XB_XCNT(j)  (256  + 64 * (j))
#define XB_XSUB(j)  (1280 + 64 * (j))
#define XB_XGEN(j)  (2304 + 64 * (j))
#define XB_TOP      3328
#define XB_TOPGEN   3392
#define XCD_BAR_WORDS 3456
#define XB_SPIN_CAP (1u << 20)
__device__ __forceinline__ unsigned xb_ld(unsigned* p)              { return __hip_atomic_load(p, __ATOMIC_RELAXED, __HIP_MEMORY_SCOPE_AGENT); }
__device__ __forceinline__ unsigned xb_add(unsigned* p, unsigned v) { return __hip_atomic_fetch_add(p, v, __ATOMIC_RELAXED, __HIP_MEMORY_SCOPE_AGENT); }
__device__ __forceinline__ unsigned xb_xcc_id() { return (unsigned)__builtin_amdgcn_s_getreg((3 << 11) | 20) & 0xFu; }
#define XB_SPIN(cond, bar) do { unsigned _sp = 0; while (cond) { __builtin_amdgcn_s_sleep(1); \
    if ((++_sp & 255u) == 0u) { if (xb_ld(&(bar)[XB_TMO])) break; if (_sp > XB_SPIN_CAP) { atomicAdd(&(bar)[XB_TMO], 1u); break; } } } } while (0)
struct XcdBarrier { unsigned* bar; unsigned x; volatile LAS unsigned* st; };
__device__ __forceinline__ XcdBarrier xcd_barrier_post(unsigned* bar, volatile LAS unsigned* st) {
    XcdBarrier b; b.bar = bar; b.x = xb_xcc_id(); b.st = st;
    if (threadIdx.x == 0) (void)xb_add(&bar[XB_XCNT(b.x)], 1u);
    return b;
}
__device__ __forceinline__ void xcd_barrier_complete(unsigned* bar, unsigned x, unsigned& nloc, unsigned& nx) {
    const unsigned G = gridDim.x * gridDim.y * gridDim.z;
    unsigned sum, cnt, mine, sp = 0u;
    for (;;) {
        sum = 0u; cnt = 0u; mine = 0u;
#pragma unroll
        for (unsigned j = 0; j < 16; ++j) { const unsigned c = xb_ld(&bar[XB_XCNT(j)]); sum += c; cnt += (c > 0u) ? 1u : 0u; mine = (j == x) ? c : mine; }
        if (sum == G) break;
        __builtin_amdgcn_s_sleep(1);
        if ((++sp & 255u) == 0u) { if (xb_ld(&bar[XB_TMO])) break; if (sp > XB_SPIN_CAP) { atomicAdd(&bar[XB_TMO], 1u); break; } }
    }
    nloc = mine > 0u ? mine : 1u; nx = cnt > 0u ? cnt : 1u;
}
__device__ __forceinline__ void xcd_barrier(const XcdBarrier& b) {
    asm volatile("s_waitcnt vmcnt(0)" ::: "memory");
    __syncthreads();
    if (threadIdx.x == 0) {
        unsigned* bar = b.bar;
        __builtin_amdgcn_s_waitcnt(0);
        unsigned nloc = b.st[0], nx = b.st[1];
        if (nloc == 0u) { xcd_barrier_complete(bar, b.x, nloc, nx); b.st[0] = nloc; b.st[1] = nx; }
        const unsigned old = xb_add(&bar[XB_XSUB(b.x)], 1u);
        const unsigned gen = old / nloc;
        if (old + 1u == (gen + 1u) * nloc) {
            __builtin_amdgcn_fence(__ATOMIC_RELEASE, "agent");
            asm volatile("s_waitcnt vmcnt(0)" ::: "memory");
            const unsigned og = xb_add(&bar[XB_TOP], 1u);
            const unsigned tg = og / nx;
            if (og + 1u == (tg + 1u) * nx) xb_add(&bar[XB_TOPGEN], 1u);
            else XB_SPIN(xb_ld(&bar[XB_TOPGEN]) == tg, bar);
            __builtin_amdgcn_fence(__ATOMIC_ACQUIRE, "agent");
            xb_add(&bar[XB_XGEN(b.x)], 1u);
            asm volatile("s_waitcnt vmcnt(0)" ::: "memory");
        } else {
            XB_SPIN(xb_ld(&bar[XB_XGEN(b.x)]) == gen, bar);
            __builtin_amdgcn_fence(__ATOMIC_ACQUIRE, "agent");
            asm volatile("s_waitcnt vmcnt(0)" ::: "memory");
        }
    }
    __syncthreads();
}

namespace pg8 {
constexpr int BM = 256, BK = 64, HALF = 128, HTB = HALF * BK * 2, STAGE_BYTES = 8 * HTB, NXCD = 8, WGM = 8;
__host__ __device__ __forceinline__ int lds_byte(int r, int c) { const int st = (r >> 4) * 2 + (c >> 5), rr = r & 15, cc = c & 31, ob = rr * 64 + cc * 2; return st * 1024 + (ob ^ (((ob >> 9) & 1) << 5)); }
__host__ __device__ __forceinline__ void stage_rc(int b, int& R, int& C) { const int st = b / 1024, sb = b % 1024, swz = sb ^ (((sb >> 9) & 1) << 5); R = (st >> 1) * 16 + swz / 64; C = (st & 1) * 32 + (swz % 64) / 2; }
__host__ __device__ __forceinline__ int perm32(int rho) { const int n = rho >> 4, i = rho & 15; return 8 * (i >> 2) + 4 * n + (i & 3); }

struct Unit { int pm, pn; };
struct Gemm { const bf16_t* A; const bf16_t* Bt; int M, N, K, lda; int skew; };

struct StaticOrder {
    int nM, nN, nwg, G, c;
    __device__ void init(int M, int N, int G_, int c_) { nM = M / BM; nN = N / BM; nwg = nM * nN; G = G_; c = c_; }
    __device__ bool next(int i, Unit& u) const {
        const long L = (long)i * G + c; if (L >= nwg) return false;
        int wgid = (int)L; { const int q = nwg / NXCD, r = nwg % NXCD, xcd = wgid % NXCD, off = wgid / NXCD; wgid = (xcd < r ? xcd * (q + 1) : r * (q + 1) + (xcd - r) * q) + off; }
        const int nig = WGM * nN, gid = wgid / nig, fm = gid * WGM, gsz = (nM - fm) < WGM ? (nM - fm) : WGM;
        u.pm = fm + ((wgid % nig) % gsz); u.pn = (wgid % nig) / gsz; return true;
    }
};

struct EpiBf16 {
    static constexpr bool PERM = true;
    bf16_t* O; int ldc; bf16_t* O2; int ldc2;
    __device__ __forceinline__ void init(f32x4 (&acc)[2][2][4][2], const Unit&, int, int, int, int) const {
#pragma unroll
        for (int a = 0; a < 2; ++a)
#pragma unroll
            for (int b = 0; b < 2; ++b)
#pragma unroll
                for (int m = 0; m < 4; ++m)
#pragma unroll
                    for (int n = 0; n < 2; ++n) acc[a][b][m][n] = (f32x4){0.f, 0.f, 0.f, 0.f};
    }
    __device__ __forceinline__ void operator()(f32x4 (&acc)[2][2][4][2], const Unit& u, int wr, int wc, int fr, int fq) const {
        const int row0 = u.pm * BM + wr * 64 + fr; const int pn = u.pn;
        if (pn >= 4 && pn < 12) {
            const int colb = 1024 + 128 * (pn - 4) + 16 * wc + 4 * fq;
#pragma unroll
            for (int ai = 0; ai < 2; ++ai)
#pragma unroll
                for (int m = 0; m < 4; ++m) { bf16_t* rowp = O + (size_t)(row0 + ai * HALF + m * 16) * ldc + colb;
#pragma unroll
                    for (int bj = 0; bj < 2; ++bj) { const f32x4 p = acc[ai][bj][m][0] * acc[ai][bj][m][1];
                        u32x2 w; w.x = cvt_pk_bf16(p[0], p[1]); w.y = cvt_pk_bf16(p[2], p[3]);
                        *(u32x2*)(rowp + bj * 64) = w; } }
        } else {
            const bool second = pn >= 16;
            const int col0 = (second ? (pn - 16) * BM : (pn >= 12 ? 2048 + (pn - 12) * BM : pn * BM)) + wc * 32 + 8 * fq;
            bf16_t* Ob = second ? O2 : O; const int ld = second ? ldc2 : ldc;
#pragma unroll
            for (int ai = 0; ai < 2; ++ai)
#pragma unroll
                for (int m = 0; m < 4; ++m) { bf16_t* rowp = Ob + (size_t)(row0 + ai * HALF + m * 16) * ld + col0;
#pragma unroll
                    for (int bj = 0; bj < 2; ++bj) { f32x4 v0 = acc[ai][bj][m][0], v1 = acc[ai][bj][m][1];
                        if (second) {
#pragma unroll
                            for (int i = 0; i < 4; ++i) { v0[i] = v0[i] * sigmoid_fast(v0[i]); v1[i] = v1[i] * sigmoid_fast(v1[i]); } }
                        u32x4 w; w.x = cvt_pk_bf16(v0[0], v0[1]); w.y = cvt_pk_bf16(v0[2], v0[3]); w.z = cvt_pk_bf16(v1[0], v1[1]); w.w = cvt_pk_bf16(v1[2], v1[3]);
                        *(u32x4*)(rowp + bj * HALF) = w; } }
        }
    }
};
struct EpiResidNorm {
    static constexpr bool PERM = false;
    const float* x; float* out; unsigned* ss; unsigned* cnt; const float* fg;
    __device__ __forceinline__ void init(f32x4 (&acc)[2][2][4][2], const Unit& u, int wr, int wc, int fr, int fq) const {
        const int row0 = u.pm * BM + wr * 64 + fr, col0 = u.pn * BM + wc * 32 + 4 * fq;
#pragma unroll
        for (int ai = 0; ai < 2; ++ai)
#pragma unroll
            for (int m = 0; m < 4; ++m) { const size_t off = (size_t)(row0 + ai * HALF + m * 16) * DM + col0;
#pragma unroll
                for (int bj = 0; bj < 2; ++bj)
#pragma unroll
                    for (int n = 0; n < 2; ++n) acc[ai][bj][m][n] = *(const f32x4*)(x + off + bj * HALF + n * 16); }
    }
    __device__ __forceinline__ void operator()(f32x4 (&acc)[2][2][4][2], const Unit& u, int wr, int wc, int fr, int fq) const {
        const int row0 = u.pm * BM + wr * 64 + fr, col0 = u.pn * BM + wc * 32 + 4 * fq;
#pragma unroll
        for (int ai = 0; ai < 2; ++ai)
#pragma unroll
            for (int m = 0; m < 4; ++m) { const int row = row0 + ai * HALF + m * 16; const size_t off = (size_t)row * DM + col0; float s = 0.f;
#pragma unroll
                for (int bj = 0; bj < 2; ++bj)
#pragma unroll
                    for (int n = 0; n < 2; ++n) { const f32x4 o = acc[ai][bj][m][n]; s += (o[0] * o[0] + o[1] * o[1]) + (o[2] * o[2] + o[3] * o[3]); }
                s += __shfl_xor(s, 16); s += __shfl_xor(s, 32);
                if (fq == 0) __hip_atomic_store(ss + (size_t)row * 16 + u.pn * 4 + wc, __float_as_uint(s), __ATOMIC_RELAXED, __HIP_MEMORY_SCOPE_AGENT); }
        asm volatile("s_waitcnt vmcnt(0)" ::: "memory");
        unsigned* c = cnt + (u.pm * 2 + wr) * 32;
        if ((threadIdx.x & 63) == 0) __hip_atomic_fetch_add(c, 1u, __ATOMIC_RELAXED, __HIP_MEMORY_SCOPE_AGENT);
        { unsigned spins = 0;
          while ((unsigned)__builtin_amdgcn_readfirstlane(__hip_atomic_load(c, __ATOMIC_RELAXED, __HIP_MEMORY_SCOPE_AGENT)) < 16u) { __builtin_amdgcn_s_sleep(2); if (++spins > (1u << 22)) break; } }
        asm volatile("" ::: "memory");
#pragma unroll
        for (int ai = 0; ai < 2; ++ai)
#pragma unroll
            for (int m = 0; m < 4; ++m) { const int row = row0 + ai * HALF + m * 16; const size_t off = (size_t)row * DM + col0;
                const unsigned long long* sp = (const unsigned long long*)(ss + (size_t)row * 16 + fq * 4);
                const unsigned long long p0 = __hip_atomic_load(sp, __ATOMIC_RELAXED, __HIP_MEMORY_SCOPE_AGENT), p1 = __hip_atomic_load(sp + 1, __ATOMIC_RELAXED, __HIP_MEMORY_SCOPE_AGENT);
                float t = (__uint_as_float((unsigned)p0) + __uint_as_float((unsigned)(p0 >> 32))) + (__uint_as_float((unsigned)p1) + __uint_as_float((unsigned)(p1 >> 32)));
                t += __shfl_xor(t, 16); t += __shfl_xor(t, 32);
                const float rstd = 1.0f / sqrtf(t * (1.f / DM) + RMS_EPS);
#pragma unroll
                for (int bj = 0; bj < 2; ++bj)
#pragma unroll
                    for (int n = 0; n < 2; ++n) { const f32x4 gv = *(const f32x4*)(fg + col0 + bj * HALF + n * 16);
                        *(f32x4*)(out + off + bj * HALF + n * 16) = acc[ai][bj][m][n] * rstd * gv; } }
    }
};

template <class Epi>
__device__ __forceinline__ void gemm_phase(LAS unsigned char* lds, const Gemm g, const StaticOrder& S, const Epi& E) {
    const int tid = threadIdx.x, wid = __builtin_amdgcn_readfirstlane(tid >> 6), lane = tid & 63, wr = wid >> 2, wc = wid & 3, fr = lane & 15, fq = lane >> 4;
    const int K = g.K, nt = K / BK, lda = g.lda;
    unsigned voffA[2], voffB[2];
#pragma unroll
    for (int i = 0; i < 2; ++i) { int R, C; stage_rc(tid * 16 + i * 8192, R, C); const int Rb = Epi::PERM ? ((R & ~31) + perm32(R & 31)) : R;
        voffA[i] = (unsigned)(R * lda + C) * 2u; voffB[i] = (unsigned)(Rb * K + C) * 2u; }
    const size_t kstep = (size_t)(BK * 2);
    const size_t hstepA = (size_t)HALF * lda * 2, hstepB = (size_t)HALF * K * 2;
    const size_t tstepA = 2 * hstepA, tstepB = 2 * hstepB;
    const unsigned ldsw = (unsigned)wid * 1024u;
    const int aoff = lds_byte(wr * 64 + fr, fq * 8), boff = lds_byte(wc * 32 + fr, fq * 8);
#define PG8_SA(b, h) (((b) * 2 + (h)) * HTB)
#define PG8_SB(b, h) ((4 + (b) * 2 + (h)) * HTB)
#define PG8_STAGE(bufoff, gbase, voff) do { _Pragma("unroll") for (int _i = 0; _i < 2; ++_i) \
        __builtin_amdgcn_global_load_lds((const unsigned*)((const char*)(gbase) + (voff)[_i]), (LAS unsigned*)(lds + (bufoff) + ldsw + _i * 8192), 16, 0, 0); } while (0)
#define PG8_LDA(dst, b, h) do { _Pragma("unroll") for (int m = 0; m < 4; ++m) _Pragma("unroll") for (int k = 0; k < 2; ++k) dst[m][k] = *(const LAS bf16x8*)(lds + PG8_SA(b, h) + aoff + m * 2048 + k * 1024); } while (0)
#define PG8_LDB(dst, b, h) do { _Pragma("unroll") for (int n = 0; n < 2; ++n) _Pragma("unroll") for (int k = 0; k < 2; ++k) dst[n][k] = *(const LAS bf16x8*)(lds + PG8_SB(b, h) + boff + n * 2048 + k * 1024); } while (0)
#define PG8_MMA(ai, bj, At, Bt) do { __builtin_amdgcn_s_setprio(1); _Pragma("unroll") for (int m = 0; m < 4; ++m) _Pragma("unroll") for (int n = 0; n < 2; ++n) _Pragma("unroll") for (int k = 0; k < 2; ++k) \
        acc[ai][bj][m][n] = __builtin_amdgcn_mfma_f32_16x16x32_bf16(Bt[n][k], At[m][k], acc[ai][bj][m][n], 0, 0, 0); __builtin_amdgcn_s_setprio(0); } while (0)
#define PG8_WAIT_V(n) asm volatile("s_waitcnt vmcnt(" #n ")" ::: "memory")
#define PG8_WAIT_L(n) asm volatile("s_waitcnt lgkmcnt(" #n ")" ::: "memory")
#define PG8_BAR __builtin_amdgcn_s_barrier()
#define PG8_SCHED __builtin_amdgcn_sched_barrier(0)
    Unit cur, nxt; int ui = 0;
    if (!S.next(0, cur)) return;
    if (g.skew > 0) { const unsigned long long t0 = __builtin_amdgcn_s_memrealtime(), dt = (unsigned long long)((blockIdx.x & 7u) * (unsigned)g.skew);
        while (__builtin_amdgcn_s_memrealtime() - t0 < dt) __builtin_amdgcn_s_sleep(8); }
    f32x4 acc[2][2][4][2];
    E.init(acc, cur, wr, wc, fr, fq);
    bf16x8 At[4][2], B0[2][2], B1[2][2];
    const char* cA = (const char*)g.A + (size_t)cur.pm * tstepA; const char* cB = (const char*)g.Bt + (size_t)cur.pn * tstepB;
#if PG8_SP2
    PG8_STAGE(PG8_SB(0, 0), cB, voffB); PG8_STAGE(PG8_SB(0, 1), cB + hstepB, voffB); PG8_STAGE(PG8_SA(0, 0), cA, voffA); PG8_STAGE(PG8_SA(0, 1), cA + hstepA, voffA);
    if (wr == 1) PG8_BAR;
    PG8_WAIT_V(2); PG8_BAR;
    PG8_STAGE(PG8_SB(1, 0), cB + kstep, voffB); PG8_STAGE(PG8_SA(1, 0), cA + kstep, voffA); PG8_STAGE(PG8_SB(1, 1), cB + hstepB + kstep, voffB);
    PG8_WAIT_V(6); PG8_BAR;
#else
    PG8_STAGE(PG8_SB(0, 0), cB, voffB); PG8_STAGE(PG8_SA(0, 0), cA, voffA); PG8_STAGE(PG8_SB(0, 1), cB + hstepB, voffB); PG8_STAGE(PG8_SA(0, 1), cA + hstepA, voffA);
    if (wr == 1) PG8_BAR;
    PG8_WAIT_V(4); PG8_BAR;
    PG8_STAGE(PG8_SB(1, 0), cB + kstep, voffB); PG8_STAGE(PG8_SA(1, 0), cA + kstep, voffA); PG8_STAGE(PG8_SB(1, 1), cB + hstepB + kstep, voffB);
    PG8_WAIT_V(6); PG8_BAR;
#endif
    for (;;) {
        const bool has_next = S.next(ui + 1, nxt);
        const char* nA = has_next ? (const char*)g.A + (size_t)nxt.pm * tstepA : cA; const char* nB = has_next ? (const char*)g.Bt + (size_t)nxt.pn * tstepB : cB;
        for (int t = 0; t < nt; t += 2) {
            const bool last = (t == nt - 2);
            const char* a1 = cA + (size_t)(t + 1) * kstep;
            const char* a2 = last ? nA : cA + (size_t)(t + 2) * kstep; const char* b2 = last ? nB : cB + (size_t)(t + 2) * kstep;
            const char* a3 = a2 + kstep; const char* b3 = b2 + kstep;
#if PG8_SP2
            PG8_LDB(B0, 0, 0); PG8_LDB(B1, 0, 1); PG8_SCHED; PG8_LDA(At, 0, 0); PG8_STAGE(PG8_SA(1, 1), a1 + hstepA, voffA);
            PG8_WAIT_V(8); PG8_WAIT_L(0); PG8_BAR; PG8_MMA(0, 0, At, B0); PG8_MMA(0, 1, At, B1); PG8_BAR; PG8_SCHED;
            PG8_LDA(At, 0, 1); PG8_STAGE(PG8_SB(0, 0), b2, voffB); PG8_STAGE(PG8_SB(0, 1), b2 + hstepB, voffB); PG8_STAGE(PG8_SA(0, 0), a2, voffA);
            PG8_WAIT_V(8); PG8_WAIT_L(0); PG8_BAR; PG8_MMA(1, 0, At, B0); PG8_MMA(1, 1, At, B1); PG8_BAR; PG8_SCHED;
            PG8_LDB(B0, 1, 0); PG8_LDB(B1, 1, 1); PG8_SCHED; PG8_LDA(At, 1, 0); PG8_STAGE(PG8_SA(0, 1), a2 + hstepA, voffA);
            PG8_WAIT_V(8); PG8_WAIT_L(0); PG8_BAR; PG8_MMA(0, 0, At, B0); PG8_MMA(0, 1, At, B1); PG8_BAR; PG8_SCHED;
            PG8_LDA(At, 1, 1); PG8_STAGE(PG8_SB(1, 0), b3, voffB); PG8_STAGE(PG8_SB(1, 1), b3 + hstepB, voffB); PG8_STAGE(PG8_SA(1, 0), a3, voffA);
            PG8_WAIT_V(8); PG8_WAIT_L(0); PG8_BAR; PG8_MMA(1, 0, At, B0); PG8_MMA(1, 1, At, B1); PG8_BAR; PG8_SCHED;
#else
            PG8_LDB(B0, 0, 0); PG8_SCHED; PG8_LDA(At, 0, 0); PG8_STAGE(PG8_SA(1, 1), a1 + hstepA, voffA);
            PG8_WAIT_L(8); PG8_BAR; PG8_WAIT_L(0); PG8_MMA(0, 0, At, B0); PG8_BAR; PG8_SCHED;
            PG8_LDB(B1, 0, 1); PG8_STAGE(PG8_SB(0, 0), b2, voffB);
            PG8_BAR; PG8_WAIT_L(0); PG8_MMA(0, 1, At, B1); PG8_BAR;
            PG8_LDA(At, 0, 1); PG8_STAGE(PG8_SA(0, 0), a2, voffA);
            PG8_BAR; PG8_WAIT_L(0); PG8_MMA(1, 0, At, B0); PG8_BAR; PG8_SCHED;
            PG8_STAGE(PG8_SB(0, 1), b2 + hstepB, voffB);
            PG8_WAIT_V(6); PG8_BAR; PG8_MMA(1, 1, At, B1); PG8_BAR;
            PG8_LDB(B0, 1, 0); PG8_SCHED; PG8_LDA(At, 1, 0); PG8_STAGE(PG8_SA(0, 1), a2 + hstepA, voffA);
            PG8_WAIT_L(8); PG8_BAR; PG8_WAIT_L(0); PG8_MMA(0, 0, At, B0); PG8_BAR; PG8_SCHED;
            PG8_LDB(B1, 1, 1); PG8_STAGE(PG8_SB(1, 0), b3, voffB);
            PG8_BAR; PG8_WAIT_L(0); PG8_MMA(0, 1, At, B1); PG8_BAR;
            PG8_LDA(At, 1, 1); PG8_STAGE(PG8_SA(1, 0), a3, voffA);
            PG8_BAR; PG8_WAIT_L(0); PG8_MMA(1, 0, At, B0); PG8_BAR; PG8_SCHED;
            PG8_STAGE(PG8_SB(1, 1), b3 + hstepB, voffB);
            PG8_WAIT_V(6); PG8_BAR; PG8_MMA(1, 1, At, B1); PG8_BAR;
#endif
        }
#if PG8_ALIGN
        if (wr == 0) PG8_BAR;
#endif
        E(acc, cur, wr, wc, fr, fq);
        if (!has_next) break;
        cur = nxt; cA = nA; cB = nB; ++ui;
        E.init(acc, cur, wr, wc, fr, fq);
#if PG8_ALIGN
        if (wr == 1) PG8_BAR;
#endif
    }
    PG8_WAIT_V(0);
#if !PG8_ALIGN
    if (wr == 0) PG8_BAR;
#endif
    PG8_BAR;
#undef PG8_SA
#undef PG8_SB
#undef PG8_STAGE
#undef PG8_LDA
#undef PG8_LDB
#undef PG8_MMA
#undef PG8_WAIT_V
#undef PG8_WAIT_L
#undef PG8_BAR
#undef PG8_SCHED
}
}

__device__ __forceinline__ void p0_transpose_item(const float* W, int ldw, int k0, int ncol0, bf16_t* WT, int ldt, int drow0, int dk0, LAS float* scr, int lane, int mode = 0) {
#pragma unroll 8
    for (int i = 0; i < 32; ++i) { const int kk = 2 * i + (lane >> 5); scr[kk * 33 + (lane & 31)] = W[(size_t)(k0 + kk) * ldw + ncol0 + (lane & 31)]; }
    asm volatile("s_waitcnt lgkmcnt(0)" ::: "memory");
    const int c = lane & 7;
#pragma unroll
    for (int j = 0; j < 4; ++j) { const int n = (lane >> 3) + 8 * j; const LAS float* s = scr + (8 * c) * 33 + n;
        u32x4 o; o.x = cvt_pk_bf16(s[0 * 33], s[1 * 33]); o.y = cvt_pk_bf16(s[2 * 33], s[3 * 33]); o.z = cvt_pk_bf16(s[4 * 33], s[5 * 33]); o.w = cvt_pk_bf16(s[6 * 33], s[7 * 33]);
        int drow = drow0 + n;
        if (mode) { const int ch = drow0 + n; drow = 1024 + 256 * (ch >> 7) + 128 * ((ch >> 6) & 1) + 32 * ((ch >> 4) & 3) + 8 * ((ch >> 2) & 3) + 4 * (mode - 1) + (ch & 3); }
        *(u32x4*)(WT + (size_t)drow * ldt + dk0 + 8 * c) = o; }
    asm volatile("s_waitcnt lgkmcnt(0)" ::: "memory");
}

__device__ __forceinline__ void phase0(const Args& a, LAS unsigned char* lds, int wave, int lane) {
    LAS float* scr = (LAS float*)(lds + wave * 16384);
    const int gw = blockIdx.x * 8 + wave, NGW = gridDim.x * 8;
    bf16_t* win_t = (bf16_t*)(a.ws + WS_WIN); bf16_t* wout_t = (bf16_t*)(a.ws + WS_WOUT); bf16_t* wg = (bf16_t*)(a.ws + WS_WG);
    constexpr int I_IN = 16 * 192, I_OUT = 32 * 32, I_G = 64;
    for (int it = gw; it < I_IN + I_OUT + I_G; it += NGW) {
        int r = it;
        if (r < I_IN) { const int kb = r / 192, nb = r % 192; const int og = nb / 32;
            if (og == 1 || og == 2) p0_transpose_item(a.in[I_WIN], NPROJ, kb * 64, nb * 32, win_t, DM, (nb % 32) * 32, kb * 64, scr, lane, og);
            else { const int nbase = (og == 0) ? 0 : (og == 4 ? 3072 : (og == 3 ? 4096 : 5120));
                p0_transpose_item(a.in[I_WIN], NPROJ, kb * 64, nb * 32, win_t, DM, nbase + (nb % 32) * 32, kb * 64, scr, lane, 0); }
            continue; }
        r -= I_IN;
        if (r < I_OUT) { const int kb = r / 32, nb = r % 32; p0_transpose_item(a.in[I_WOUT], DM, kb * 64, nb * 32, wout_t, DMIX, nb * 32, kb * 64, scr, lane); continue; }
        r -= I_OUT;
        { const int mat = r / 32, h = (r % 32) / 2, nb = r & 1; const float* W = (mat ? a.in[I_WI] : a.in[I_WA]) + h * 4096;
          p0_transpose_item(W, 64, 0, nb * 32, wg + mat * 65536 + h * 4096, 64, nb * 32, 0, scr, lane); }
    }
    const float* x = a.in[I_X]; bf16_t* xn = (bf16_t*)(a.ws + WS_XN);
    f32x4 gv[4];
#pragma unroll
    for (int j = 0; j < 4; ++j) gv[j] = ((const f32x4*)a.in[I_LNG])[lane + 64 * j];
    for (int m = gw; m < T_TOK; m += NGW) {
        const f32x4* xr = (const f32x4*)(x + (size_t)m * DM) + lane;
        f32x4 v[4]; float s = 0.f;
#pragma unroll
        for (int j = 0; j < 4; ++j) { v[j] = xr[64 * j]; s += (v[j].x * v[j].x + v[j].y * v[j].y) + (v[j].z * v[j].z + v[j].w * v[j].w); }
        const float rstd = 1.0f / sqrtf(wave_sum(s) * (1.f / DM) + RMS_EPS);
        u32x2* o8 = (u32x2*)(xn + (size_t)m * DM) + lane;
#pragma unroll
        for (int j = 0; j < 4; ++j) { u32x2 w; w.x = cvt_pk_bf16(v[j].x * rstd * gv[j].x, v[j].y * rstd * gv[j].y); w.y = cvt_pk_bf16(v[j].z * rstd * gv[j].z, v[j].w * rstd * gv[j].w); o8[64 * j] = w; }
    }
}

#define DPP_ADD(v, ctrl) ((v) + __uint_as_float(__builtin_amdgcn_update_dpp(0, __float_as_uint(v), (ctrl), 0xF, 0xF, false)))
__device__ __forceinline__ void conv_item(const Args& a, bf16_t* proj, bf16_t* projg, bf16_t* obase, int ostride, int item, int wave, int lane) {
    const int q = lane >> 4, c8 = lane & 15, ch0 = wave * 128 + c8 * 8;
    float w0[8], w1[8], w2[8], gn[8];
    { const float* cw = a.in[I_CONVW] + ch0; const float* cg_ = a.in[I_CG] + ch0;
#pragma unroll
      for (int j = 0; j < 8; ++j) { w0[j] = cw[j]; w1[j] = cw[1024 + j]; w2[j] = cw[2048 + j]; gn[j] = cg_[j]; } }
    const int tok0 = item * 64 + q * 16;
    bf16_t* base = proj + (size_t)tok0 * LDPA + ch0; const bf16_t* gbase = projg + (size_t)tok0 * LDPG + ch0;
    float p2[8], p1[8];
    if ((tok0 & (SEQ - 1)) == 0) {
#pragma unroll
        for (int j = 0; j < 8; ++j) { p2[j] = 0.f; p1[j] = 0.f; }
    } else {
        const u32x4 c2 = *(const u32x4*)(base - 2 * LDPA + COL_CX), c1 = *(const u32x4*)(base - 1 * LDPA + COL_CX);
        unpack8(c2, p2); unpack8(c1, p1);
    }
    u32x4 nb[2], nc[2], ng[2];
#pragma unroll
    for (int k = 0; k < 2; ++k) { const bf16_t* rp = base + (size_t)k * LDPA; nb[k] = *(const u32x4*)(rp + COL_B); nc[k] = *(const u32x4*)(rp + COL_CX); ng[k] = *(const u32x4*)(gbase + (size_t)k * LDPG); }
    for (int i = 0; i < 16; i += 2) {
        u32x4 vb[2], vc[2], vg[2];
#pragma unroll
        for (int k = 0; k < 2; ++k) { vb[k] = nb[k]; vc[k] = nc[k]; vg[k] = ng[k]; }
        if (i + 2 < 16) {
#pragma unroll
            for (int k = 0; k < 2; ++k) { const bf16_t* rp = base + (size_t)(i + 2 + k) * LDPA; nb[k] = *(const u32x4*)(rp + COL_B); nc[k] = *(const u32x4*)(rp + COL_CX); ng[k] = *(const u32x4*)(gbase + (size_t)(i + 2 + k) * LDPG); }
        }
#pragma unroll
        for (int k = 0; k < 2; ++k) {
            float fb[8], cx[8], fg[8], y[8];
            unpack8(vb[k], fb); unpack8(vc[k], cx); unpack8(vg[k], fg);
            float ss = 0.f;
#pragma unroll
            for (int j = 0; j < 8; ++j) { const float cv = w0[j] * p2[j] + w1[j] * p1[j] + w2[j] * cx[j]; y[j] = fb[j] * cv; ss += y[j] * y[j]; p2[j] = p1[j]; p1[j] = cx[j]; }
            ss = DPP_ADD(ss, 0xB1); ss = DPP_ADD(ss, 0x4E); ss = DPP_ADD(ss, 0x141); ss = DPP_ADD(ss, 0x140);
            const float rstd = __builtin_amdgcn_rsqf(ss * (1.f / 128.f) + RMS_EPS);
            float o[8];
#pragma unroll
            for (int j = 0; j < 8; ++j) o[j] = y[j] * rstd * gn[j] * fg[j];
            u32x4 w; w.x = cvt_pk_bf16(o[0], o[1]); w.y = cvt_pk_bf16(o[2], o[3]); w.z = cvt_pk_bf16(o[4], o[5]); w.w = cvt_pk_bf16(o[6], o[7]);
            *(u32x4*)(obase + (size_t)(tok0 + i + k) * ostride + ch0) = w;
        }
    }
}

constexpr int L_GW = 0;
constexpr int L_CW = 18432;
constexpr int L_AGG = 20992;
constexpr int L_WT = 29184;
constexpr int WT_BYTES = 8704;
static_assert(L_WT + 8 * WT_BYTES <= 131072, "lds");
typedef float f32x2 __attribute__((ext_vector_type(2)));

__device__ __forceinline__ void lru_item(const Args& a, bf16_t* proj, bf16_t* projg, bf16_t* obase, int ostride, LAS unsigned char* lds, int chain, int part, int nsplit, int tid, int wave, int lane) {
    const int b = chain >> 4, h = chain & 15;
    {
        const bf16_t* wg = (const bf16_t*)(a.ws + WS_WG);
        for (int i = tid; i < 1024; i += NTHREADS) { const int mat = i >> 9, e = (i >> 3) & 63, c = i & 7;
            const u32x4 v = *(const u32x4*)(wg + mat * 65536 + h * 4096 + e * 64 + c * 8);
            *(LAS u32x4*)(lds + L_GW + mat * 9216 + e * 144 + c * 16) = v; }
        LAS float* cw = (LAS float*)(lds + L_CW);
        if (tid < 256) cw[tid] = a.in[I_LCW][(tid >> 6) * 1024 + h * 64 + (tid & 63)];
        else if (tid < 320) { const int c = tid - 256, gc = h * 64 + c;
            cw[256 + c] = a.in[I_LCB][gc]; cw[320 + c] = a.in[I_BA][gc]; cw[384 + c] = a.in[I_BI][gc];
            const float lam = a.in[I_LAM][gc];
            const float logsig = (lam >= 0.f) ? -log1pf(expf(-lam)) : (lam - log1pf(expf(lam)));
            cw[448 + c] = 8.0f * logsig * 1.44269504f;
            cw[512 + c] = a.in[I_LG][gc]; }
    }
    __syncthreads();
    const int r = lane & 31, hh = lane >> 5;
    LAS unsigned char* wt = lds + L_WT + wave * WT_BYTES;
    LAS const float* cw = (LAS const float*)(lds + L_CW);
    bf16x8 I0, I1;
    {
        u32x4 t0 = (u32x4){0u, 0u, 0u, 0u}, t1 = t0;
        const int j0 = r - 8 * hh, j1 = r - 16 - 8 * hh;
#pragma unroll
        for (int d = 0; d < 4; ++d) {
            t0[d] = (j0 == 2 * d) ? 0x00003F80u : ((j0 == 2 * d + 1) ? 0x3F800000u : 0u);
            t1[d] = (j1 == 2 * d) ? 0x00003F80u : ((j1 == 2 * d + 1) ? 0x3F800000u : 0u);
        }
        I0 = __builtin_bit_cast(bf16x8, t0); I1 = __builtin_bit_cast(bf16x8, t1);
    }
    float ba[2], bi[2], cf[2];
#pragma unroll
    for (int n = 0; n < 2; ++n) { ba[n] = cw[320 + 32 * n + r]; bi[n] = cw[384 + 32 * n + r]; cf[n] = cw[448 + 32 * n + r]; }
    float carry[2] = {0.f, 0.f};
    unsigned* flags = (unsigned*)(a.ws + WS_CTL + 4096) + chain * 32;
    unsigned long long* aggg = (unsigned long long*)(a.ws + WS_AGG) + (size_t)chain * 16 * 64;

    const bf16_t* xl_base = proj + (size_t)b * SEQ * LDPA + COL_XL + h * 64;
    const bf16_t* gl_base = projg + (size_t)b * SEQ * LDPG + 1024 + h * 64;
    u32x4 xr[5];
#define LOAD_X(seg_) do { const int s0_ = (seg_) * 256 + wave * 32; _Pragma("unroll") for (int i = 0; i < 5; ++i) { const int idx = lane + 64 * i, row = idx >> 3, c = idx & 7; const int s = s0_ - 3 + row; \
        xr[i] = (u32x4){0u, 0u, 0u, 0u}; if (idx < 280 && s >= 0) xr[i] = *(const u32x4*)(xl_base + (size_t)s * LDPA + c * 8); } } while (0)
    LOAD_X(part);
    for (int seg = part; seg < 16; seg += nsplit) {
        const int s0 = seg * 256 + wave * 32;
#pragma unroll
        for (int i = 0; i < 5; ++i) { const int idx = lane + 64 * i, row = idx >> 3, c = idx & 7; if (idx < 280) *(LAS u32x4*)(wt + row * 144 + c * 16) = xr[i]; }
        if (seg + nsplit < 16) LOAD_X(seg + nsplit);
        u32x4 gl[4];
#define LOAD_GL() do { _Pragma("unroll") for (int i = 0; i < 4; ++i) { const int tok = (lane >> 3) + 8 * i, c = lane & 7; gl[i] = *(const u32x4*)(gl_base + (size_t)(s0 + tok) * LDPG + c * 8); } } while (0)
#if GL_EARLY
        LOAD_GL();
#endif
        asm volatile("s_waitcnt lgkmcnt(0)" ::: "memory");
        bf16x8 Af[4];
#pragma unroll
        for (int s = 0; s < 4; ++s) {
            const int c0 = 16 * s + 8 * hh;
            float u8[8];
            { const f32x4 b0 = *(LAS const f32x4*)(cw + 256 + c0), b1 = *(LAS const f32x4*)(cw + 256 + c0 + 4);
              u8[0] = b0[0]; u8[1] = b0[1]; u8[2] = b0[2]; u8[3] = b0[3]; u8[4] = b1[0]; u8[5] = b1[1]; u8[6] = b1[2]; u8[7] = b1[3]; }
#pragma unroll
            for (int k = 0; k < 4; ++k) {
                const u32x4 xv = *(LAS const u32x4*)(wt + (r + k) * 144 + c0 * 2);
                const f32x4 wv0 = *(LAS const f32x4*)(cw + k * 64 + c0), wv1 = *(LAS const f32x4*)(cw + k * 64 + c0 + 4);
                float fx[8]; unpack8(xv, fx);
                u8[0] += wv0[0] * fx[0]; u8[1] += wv0[1] * fx[1]; u8[2] += wv0[2] * fx[2]; u8[3] += wv0[3] * fx[3];
                u8[4] += wv1[0] * fx[4]; u8[5] += wv1[1] * fx[5]; u8[6] += wv1[2] * fx[6]; u8[7] += wv1[3] * fx[7];
            }
            u32x4 pk; pk.x = cvt_pk_bf16(u8[0], u8[1]); pk.y = cvt_pk_bf16(u8[2], u8[3]); pk.z = cvt_pk_bf16(u8[4], u8[5]); pk.w = cvt_pk_bf16(u8[6], u8[7]);
            Af[s] = __builtin_bit_cast(bf16x8, pk);
        }
#pragma unroll
        for (int n = 0; n < 2; ++n) {
            float hl[16], pc[16];
            f32x16 accR, accI, accU;
#pragma unroll
            for (int j = 0; j < 16; ++j) { accR[j] = 0.f; accI[j] = 0.f; accU[j] = 0.f; }
#pragma unroll
            for (int s = 0; s < 4; ++s) {
                const bf16x8 Ba = *(LAS const bf16x8*)(lds + L_GW + (32 * n + r) * 144 + (16 * s + 8 * hh) * 2);
                const bf16x8 Bi = *(LAS const bf16x8*)(lds + L_GW + 9216 + (32 * n + r) * 144 + (16 * s + 8 * hh) * 2);
                accR = __builtin_amdgcn_mfma_f32_32x32x16_bf16(Af[s], Ba, accR, 0, 0, 0);
                accI = __builtin_amdgcn_mfma_f32_32x32x16_bf16(Af[s], Bi, accI, 0, 0, 0);
            }
            accU = __builtin_amdgcn_mfma_f32_32x32x16_bf16(Af[2 * n], I0, accU, 0, 0, 0);
            accU = __builtin_amdgcn_mfma_f32_32x32x16_bf16(Af[2 * n + 1], I1, accU, 0, 0, 0);
            float gP[4], gH[4];
#pragma unroll
            for (int g = 0; g < 4; ++g) {
                float P = 1.f, H = 0.f;
#pragma unroll
                for (int i = 0; i < 4; ++i) { const int j = 4 * g + i;
                    const float rr = sigmoid_fast(accR[j] + ba[n]);
                    const float ii = sigmoid_fast(accI[j] + bi[n]);
                    const float l2 = rr * cf[n];
                    const float aa = __builtin_amdgcn_exp2f(l2);
                    const float t = l2 * 1.38629436f;
                    const float em_small = -t * (1.0f + t * (0.5f + t * (0.16666667f + t * 0.041666667f)));
                    const float one_m = (t > -0.0625f) ? em_small : (1.0f - aa * aa);
                    const float dd = __builtin_amdgcn_sqrtf(one_m) * ii * accU[j];
                    H = aa * H + dd; P = P * aa; hl[j] = H; pc[j] = P; }
                gP[g] = P; gH[g] = H;
            }
            float cp = 1.f, ch = 0.f;
#pragma unroll
            for (int g = 0; g < 4; ++g) {
                const auto sp = __builtin_amdgcn_permlane32_swap(__float_as_uint(gP[g]), __float_as_uint(gP[g]), false, false);
                const auto sh = __builtin_amdgcn_permlane32_swap(__float_as_uint(gH[g]), __float_as_uint(gH[g]), false, false);
                const float oP = __uint_as_float(hh ? sp[0] : sp[1]), oH = __uint_as_float(hh ? sh[0] : sh[1]);
                const float P = gP[g], H = gH[g];
                const float A1 = hh ? oP : P, H1 = hh ? oH : H, A2 = hh ? P : oP, H2 = hh ? H : oH;
                const float cp1 = cp * A1, ch1 = A1 * ch + H1;
                const float inP = hh ? cp1 : cp, inH = hh ? ch1 : ch;
#pragma unroll
                for (int i = 0; i < 4; ++i) { const int j = 4 * g + i; hl[j] += pc[j] * inH; pc[j] *= inP; }
                cp = cp1 * A2; ch = A2 * ch1 + H2;
            }
            if (hh == 0) *(LAS f32x2*)(lds + L_AGG + ((n * 8 + wave) * 64 + 32 * n + r) * 8) = (f32x2){cp, ch};
#if !GL_EARLY
            if (n == 1) LOAD_GL();
#endif
            if (nsplit > 1 && seg > 0 && wave == 0) {
                unsigned spins = 0;
                while (__builtin_amdgcn_readfirstlane(__hip_atomic_load(flags + (seg - 1) * 2 + n, __ATOMIC_RELAXED, __HIP_MEMORY_SCOPE_AGENT)) == 0u) { __builtin_amdgcn_s_sleep(2); if (++spins > (1u << 22)) break; }
                asm volatile("" ::: "memory");
            }
            __syncthreads();
            float c = carry[n];
            if (nsplit > 1 && seg > 0) {
                const unsigned long long pw = __hip_atomic_load(aggg + (size_t)(seg - 1) * 64 + n * 32 + r, __ATOMIC_RELAXED, __HIP_MEMORY_SCOPE_AGENT);
                c = __uint_as_float((unsigned)pw) * c + __uint_as_float((unsigned)(pw >> 32));
            }
            float cin = 0.f, iP = 1.f, iH = 0.f;
#pragma unroll
            for (int w = 0; w < 8; ++w) {
                const f32x2 ag = *(LAS const f32x2*)(lds + L_AGG + ((n * 8 + w) * 64 + 32 * n + r) * 8);
                cin = (w == wave) ? c : cin; c = ag.x * c + ag.y; iH = ag.x * iH + ag.y; iP *= ag.x; }
            carry[n] = c;
            if (nsplit > 1 && wave == 0) {
                if (hh == 0) __hip_atomic_store(aggg + (size_t)seg * 64 + n * 32 + r, ((unsigned long long)__float_as_uint(iH) << 32) | __float_as_uint(iP), __ATOMIC_RELAXED, __HIP_MEMORY_SCOPE_AGENT);
                asm volatile("s_waitcnt vmcnt(0)" ::: "memory");
                if (lane == 0) __hip_atomic_store(flags + seg * 2 + n, 1u, __ATOMIC_RELAXED, __HIP_MEMORY_SCOPE_AGENT);
            }
#pragma unroll
            for (int j = 0; j < 16; ++j) { const int row = (j & 3) + 8 * (j >> 2) + 4 * hh;
                *(LAS float*)(wt + row * 272 + (32 * n + r) * 4) = hl[j] + pc[j] * cin; }
        }
        asm volatile("s_waitcnt lgkmcnt(0)" ::: "memory");
#pragma unroll
        for (int i = 0; i < 4; ++i) {
            const int tok = (lane >> 3) + 8 * i, c = lane & 7;
            const f32x4 h0 = *(LAS const f32x4*)(wt + tok * 272 + c * 32), h1 = *(LAS const f32x4*)(wt + tok * 272 + c * 32 + 16);
            const f32x4 g0 = *(LAS const f32x4*)(cw + 512 + c * 8), g1 = *(LAS const f32x4*)(cw + 512 + c * 8 + 4);
            float ss = (h0[0] * h0[0] + h0[1] * h0[1]) + (h0[2] * h0[2] + h0[3] * h0[3]) + (h1[0] * h1[0] + h1[1] * h1[1]) + (h1[2] * h1[2] + h1[3] * h1[3]);
            ss = DPP_ADD(ss, 0xB1); ss = DPP_ADD(ss, 0x4E); ss = DPP_ADD(ss, 0x141);
            const float rstd = __builtin_amdgcn_rsqf(ss * (1.f / 64.f) + RMS_EPS);
            float fg[8]; unpack8(gl[i], fg);
            float o[8];
            o[0] = h0[0] * rstd * g0[0]; o[1] = h0[1] * rstd * g0[1]; o[2] = h0[2] * rstd * g0[2]; o[3] = h0[3] * rstd * g0[3];
            o[4] = h1[0] * rstd * g1[0]; o[5] = h1[1] * rstd * g1[1]; o[6] = h1[2] * rstd * g1[2]; o[7] = h1[3] * rstd * g1[3];
#pragma unroll
            for (int j = 0; j < 8; ++j) o[j] *= fg[j];
            u32x4 w; w.x = cvt_pk_bf16(o[0], o[1]); w.y = cvt_pk_bf16(o[2], o[3]); w.z = cvt_pk_bf16(o[4], o[5]); w.w = cvt_pk_bf16(o[6], o[7]);
            *(u32x4*)(obase + (size_t)(b * SEQ + s0 + tok) * ostride + h * 64 + c * 8) = w;
        }
        asm volatile("s_waitcnt lgkmcnt(0)" ::: "memory");
    }
#undef LOAD_X
    __syncthreads();
}

__global__ void __launch_bounds__(NTHREADS, 2) hymba_fwd(Args a) {
    extern __shared__ __attribute__((aligned(16))) unsigned char lds_raw[];
    LAS unsigned char* lds = (LAS unsigned char*)lds_raw;
    cg::grid_group grid = cg::this_grid();
    if (gridDim.y == 0x7fffu) grid.sync();
    volatile LAS unsigned* bst = (volatile LAS unsigned*)(lds + 131072 + 64);
    if (threadIdx.x == 0) { bst[0] = 0u; bst[1] = 0u; }
    __syncthreads();
    const XcdBarrier bar = xcd_barrier_post((unsigned*)(a.ws + WS_CTL + 32768), bst);
    const int tid = threadIdx.x, lane = tid & 63, wave = __builtin_amdgcn_readfirstlane(tid >> 6);
    bf16_t* proj = (bf16_t*)(a.ws + WS_PROJ); bf16_t* projg = (bf16_t*)(a.ws + WS_PROJG);

#pragma unroll
    for (int rep = 0; rep < REP0; ++rep) {
#ifndef SKIP_P0
    phase0(a, lds, wave, lane);
#endif

    xcd_barrier(bar); }
#pragma unroll
    for (int rep = 0; rep < REP1; ++rep) {
        pg8::Gemm g{(const bf16_t*)(a.ws + WS_XN), (const bf16_t*)(a.ws + WS_WIN), T_TOK, NPROJ, DM, DM, SKEW1};
        pg8::StaticOrder S; S.init(T_TOK, NPROJ, (int)gridDim.x, (int)blockIdx.x);
        pg8::EpiBf16 E{proj, LDPA, projg, LDPG};
#ifndef SKIP_G1
        pg8::gemm_phase<pg8::EpiBf16>(lds, g, S, E);
#endif
    xcd_barrier(bar); }
    {
#ifndef SKIP_LRU
        if (gridDim.x >= 256) { if (blockIdx.x < 256) lru_item(a, proj, projg, projg + 1024, LDPG, lds, (int)blockIdx.x >> 1, (int)blockIdx.x & 1, 2, tid, wave, lane); }
        else for (int it = blockIdx.x; it < 128; it += gridDim.x) lru_item(a, proj, projg, projg + 1024, LDPG, lds, it, 0, 1, tid, wave, lane);
#endif
        LAS unsigned* qs = (LAS unsigned*)(lds + 131072);
        unsigned* qctr = (unsigned*)(a.ws + WS_CTL);
        for (;;) {
            if (tid == 0) qs[0] = atomicAdd(qctr, 1u);
            __syncthreads();
            const unsigned it = qs[0];
            __syncthreads();
            if (it >= (unsigned)(T_TOK / 64)) break;
#ifndef SKIP_CONV
            conv_item(a, proj, projg, projg, LDPG, (int)it, wave, lane);
#endif
        }
    }
    xcd_barrier(bar);
#pragma unroll
    for (int rep = 0; rep < REP3; ++rep) {
        pg8::Gemm g{projg, (const bf16_t*)(a.ws + WS_WOUT), T_TOK, DM, DMIX, LDPG, SKEW3};
        pg8::StaticOrder S; S.init(T_TOK, DM, (int)gridDim.x, (int)blockIdx.x);
        pg8::EpiResidNorm E{a.in[I_X], a.out, (unsigned*)(a.ws + WS_SS), (unsigned*)(a.ws + WS_CTL + 65536), a.in[I_FG]};
#ifndef SKIP_G2
        pg8::gemm_phase<pg8::EpiResidNorm>(lds, g, S, E);
#endif
    }
}

extern "C" void kernel_launch(void* const* d_in, const int* in_sizes, int n_in, void* d_out, int out_size, void* d_ws, size_t ws_size, hipStream_t stream) {
    static int grid = 0;
    if (grid == 0) {
        if (n_in != 15 || out_size != T_TOK * DM || ws_size < WS_END) { fprintf(stderr, "kernel_launch: unexpected shapes (n_in %d out %d ws %zu)\n", n_in, out_size, ws_size); grid = -1; return; }
        int dev = 0, cus = 0, per_cu = 0;
        hipGetDevice(&dev);
        hipDeviceGetAttribute(&cus, hipDeviceAttributeMultiprocessorCount, dev);
        if (hipFuncSetAttribute((const void*)hymba_fwd, hipFuncAttributeMaxDynamicSharedMemorySize, LDS_BYTES) != hipSuccess) { fprintf(stderr, "kernel_launch: hipFuncSetAttribute failed\n"); grid = -1; return; }
        if (hipOccupancyMaxActiveBlocksPerMultiprocessor(&per_cu, (const void*)hymba_fwd, NTHREADS, LDS_BYTES) != hipSuccess || per_cu < 1) { fprintf(stderr, "kernel_launch: occupancy query says %d\n", per_cu); per_cu = 1; }
        (void)hipGetLastError();
        grid = cus;
        if (grid != 256) { fprintf(stderr, "kernel_launch: built for a 256-CU device (got %d)\n", cus); grid = -1; return; }
    }
    if (grid < 0) return;
    hipMemsetAsync((char*)d_ws + WS_CTL, 0, CTL_BYTES, stream);
    Args a{};
    for (int i = 0; i < 15; ++i) a.in[i] = (const float*)d_in[i];
    a.out = (float*)d_out; a.ws = (unsigned char*)d_ws;
    void* args[] = {&a};
    hipError_t e = hipLaunchCooperativeKernel((const void*)hymba_fwd, dim3(grid), dim3(NTHREADS), args, LDS_BYTES, stream);
    if (e != hipSuccess) fprintf(stderr, "kernel_launch: cooperative launch failed: %s (grid %d)\n", hipGetErrorString(e), grid);
}
```

```cpp
#include <hip/hip_runtime.h>
#include <hip/hip_cooperative_groups.h>
#include <cstdio>
namespace cg = cooperative_groups;

#define LAS __attribute__((address_space(3)))
typedef unsigned short bf16_t;
typedef short bf16x8 __attribute__((ext_vector_type(8)));
typedef float f32x4 __attribute__((ext_vector_type(4)));
typedef float f32x16 __attribute__((ext_vector_type(16)));
typedef unsigned u32x4 __attribute__((ext_vector_type(4)));
typedef unsigned u32x2 __attribute__((ext_vector_type(2)));

constexpr int T_TOK = 32768, SEQ = 4096, DM = 1024, NPROJ = 6144, DMIX = 2048;
constexpr float RMS_EPS = 1e-6f;
constexpr int COL_B = 0, COL_CX = 1024, COL_XL = 2048;
constexpr size_t MiB = 1u << 20;
constexpr size_t WS_CTL = 0, CTL_BYTES = 131072;
constexpr size_t WS_WIN = 2 * MiB;
constexpr size_t WS_WOUT = 14 * MiB;
constexpr size_t WS_WG = 18 * MiB;
constexpr size_t WS_SS = 20 * MiB;
constexpr size_t WS_AGG = 22 * MiB;
constexpr size_t WS_XN = 32 * MiB;
constexpr size_t WS_PROJ = 96 * MiB;
constexpr int LDPA = 3072, LDPG = 2048;
constexpr size_t WS_PROJG = WS_PROJ + (size_t)T_TOK * LDPA * 2;
constexpr size_t WS_END = WS_PROJG + (size_t)T_TOK * LDPG * 2;
static_assert(WS_END <= 480 * MiB, "ws");
constexpr int LDS_BYTES = 147456;
constexpr int NTHREADS = 512;
#ifndef REP0
#define REP0 1
#endif
#ifndef REP1
#define REP1 1
#endif
#ifndef REP3
#define REP3 1
#endif
#ifndef CONV_R
#define CONV_R 8
#endif
#ifndef PG8_SP2
#define PG8_SP2 1
#endif
#ifndef PG8_ALIGN
#define PG8_ALIGN 1
#endif
#ifndef SKEW1
#define SKEW1 0
#endif
#ifndef SKEW3
#define SKEW3 0
#endif
#ifndef GL_EARLY
#define GL_EARLY 1
#endif
#ifndef REPLRU
#define REPLRU 1
#endif
#ifndef REPCONV
#define REPCONV 1
#endif

struct Args { const float* in[15]; float* out; unsigned char* ws; };
enum { I_X = 0, I_LNG, I_WIN, I_CONVW, I_LCW, I_LCB, I_WA, I_BA, I_WI, I_BI, I_LAM, I_CG, I_LG, I_WOUT, I_FG };

__device__ __forceinline__ unsigned cvt_pk_bf16(float lo, float hi) { unsigned r; asm volatile("v_cvt_pk_bf16_f32 %0, %1, %2" : "=v"(r) : "v"(lo), "v"(hi)); return r; }
__device__ __forceinline__ float bf_lo(unsigned w) { return __uint_as_float(w << 16); }
__device__ __forceinline__ float bf_hi(unsigned w) { return __uint_as_float(w & 0xffff0000u); }
__device__ __forceinline__ float wave_sum(float v) {
#pragma unroll
    for (int o = 1; o < 64; o <<= 1) v += __shfl_xor(v, o);
    return v;
}
__device__ __forceinline__ float sigmoid_fast(float x) { return __builtin_amdgcn_rcpf(1.0f + __builtin_amdgcn_exp2f(-1.44269504f * x)); }
__device__ __forceinline__ void unpack8(const u32x4 v, float (&f)[8]) {
    f[0] = bf_lo(v.x); f[1] = bf_hi(v.x); f[2] = bf_lo(v.y); f[3] = bf_hi(v.y); f[4] = bf_lo(v.z); f[5] = bf_hi(v.z); f[6] = bf_lo(v.w); f[7] = bf_hi(v.w);
}


#define XB_TMO      128
#define XB_XCNT(j)  (256  + 64 * (j))
#define XB_XSUB(j)  (1280 + 64 * (j))
#define XB_XGEN(j)  (2304 + 64 * (j))
#define XB_TOP      3328
#define XB_TOPGEN   3392
#define XCD_BAR_WORDS 3456
#define XB_SPIN_CAP (1u << 20)
__device__ __forceinline__ unsigned xb_ld(unsigned* p)              { return __hip_atomic_load(p, __ATOMIC_RELAXED, __HIP_MEMORY_SCOPE_AGENT); }
__device__ __forceinline__ unsigned xb_add(unsigned* p, unsigned v) { return __hip_atomic_fetch_add(p, v, __ATOMIC_RELAXED, __HIP_MEMORY_SCOPE_AGENT); }
__device__ __forceinline__ unsigned xb_xcc_id() { return (unsigned)__builtin_amdgcn_s_getreg((3 << 11) | 20) & 0xFu; }
#define XB_SPIN(cond, bar) do { unsigned _sp = 0; while (cond) { __builtin_amdgcn_s_sleep(1); \
    if ((++_sp & 255u) == 0u) { if (xb_ld(&(bar)[XB_TMO])) break; if (_sp > XB_SPIN_CAP) { atomicAdd(&(bar)[XB_TMO], 1u); break; } } } } while (0)
struct XcdBarrier { unsigned* bar; unsigned x; volatile LAS unsigned* st; };
__device__ __forceinline__ XcdBarrier xcd_barrier_post(unsigned* bar, volatile LAS unsigned* st) {
    XcdBarrier b; b.bar = bar; b.x = xb_xcc_id(); b.st = st;
    if (threadIdx.x == 0) (void)xb_add(&bar[XB_XCNT(b.x)], 1u);
    return b;
}
__device__ __forceinline__ void xcd_barrier_complete(unsigned* bar, unsigned x, unsigned& nloc, unsigned& nx) {
    const unsigned G = gridDim.x * gridDim.y * gridDim.z;
    unsigned sum, cnt, mine, sp = 0u;
    for (;;) {
        sum = 0u; cnt = 0u; mine = 0u;
#pragma unroll
        for (unsigned j = 0; j < 16; ++j) { const unsigned c = xb_ld(&bar[XB_XCNT(j)]); sum += c; cnt += (c > 0u) ? 1u : 0u; mine = (j == x) ? c : mine; }
        if (sum == G) break;
        __builtin_amdgcn_s_sleep(1);
        if ((++sp & 255u) == 0u) { if (xb_ld(&bar[XB_TMO])) break; if (sp > XB_SPIN_CAP) { atomicAdd(&bar[XB_TMO], 1u); break; } }
    }
    nloc = mine > 0u ? mine : 1u; nx = cnt > 0u ? cnt : 1u;
}
__device__ __forceinline__ void xcd_barrier(const XcdBarrier& b) {
    asm volatile("s_waitcnt vmcnt(0)" ::: "memory");
    __syncthreads();
    if (threadIdx.x == 0) {
        unsigned* bar = b.bar;
        __builtin_amdgcn_s_waitcnt(0);
        unsigned nloc = b.st[0], nx = b.st[1];
        if (nloc == 0u) { xcd_barrier_complete(bar, b.x, nloc, nx); b.st[0] = nloc; b.st[1] = nx; }
        const unsigned old = xb_add(&bar[XB_XSUB(b.x)], 1u);
        const unsigned gen = old / nloc;
        if (old + 1u == (gen + 1u) * nloc) {
            __builtin_amdgcn_fence(__ATOMIC_RELEASE, "agent");
            asm volatile("s_waitcnt vmcnt(0)" ::: "memory");
            const unsigned og = xb_add(&bar[XB_TOP], 1u);
            const unsigned tg = og / nx;
            if (og + 1u == (tg + 1u) * nx) xb_add(&bar[XB_TOPGEN], 1u);
            else XB_SPIN(xb_ld(&bar[XB_TOPGEN]) == tg, bar);
            __builtin_amdgcn_fence(__ATOMIC_ACQUIRE, "agent");
            xb_add(&bar[XB_XGEN(b.x)], 1u);
            asm volatile("s_waitcnt vmcnt(0)" ::: "memory");
        } else {
            XB_SPIN(xb_ld(&bar[XB_XGEN(b.x)]) == gen, bar);
            __builtin_amdgcn_fence(__ATOMIC_ACQUIRE, "agent");
            asm volatile("s_waitcnt vmcnt(0)" ::: "memory");
        }
    }
    __syncthreads();
}

namespace pg8 {
constexpr int BM = 256, BK = 64, HALF = 128, HTB = HALF * BK * 2, STAGE_BYTES = 8 * HTB, NXCD = 8, WGM = 8;
__host__ __device__ __forceinline__ int lds_byte(int r, int c) { const int st = (r >> 4) * 2 + (c >> 5), rr = r & 15, cc = c & 31, ob = rr * 64 + cc * 2; return st * 1024 + (ob ^ (((ob >> 9) & 1) << 5)); }
__host__ __device__ __forceinline__ void stage_rc(int b, int& R, int& C) { const int st = b / 1024, sb = b % 1024, swz = sb ^ (((sb >> 9) & 1) << 5); R = (st >> 1) * 16 + swz / 64; C = (st & 1) * 32 + (swz % 64) / 2; }
__host__ __device__ __forceinline__ int perm32(int rho) { const int n = rho >> 4, i = rho & 15; return 8 * (i >> 2) + 4 * n + (i & 3); }

struct Unit { int pm, pn; };
struct Gemm { const bf16_t* A; const bf16_t* Bt; int M, N, K, lda; int skew; };

struct StaticOrder {
    int nM, nN, nwg, G, c;
    __device__ void init(int M, int N, int G_, int c_) { nM = M / BM; nN = N / BM; nwg = nM * nN; G = G_; c = c_; }
    __device__ bool next(int i, Unit& u) const {
        const long L = (long)i * G + c; if (L >= nwg) return false;
        int wgid = (int)L; { const int q = nwg / NXCD, r = nwg % NXCD, xcd = wgid % NXCD, off = wgid / NXCD; wgid = (xcd < r ? xcd * (q + 1) : r * (q + 1) + (xcd - r) * q) + off; }
        const int nig = WGM * nN, gid = wgid / nig, fm = gid * WGM, gsz = (nM - fm) < WGM ? (nM - fm) : WGM;
        u.pm = fm + ((wgid % nig) % gsz); u.pn = (wgid % nig) / gsz; return true;
    }
};

struct EpiBf16 {
    static constexpr bool PERM = true;
    bf16_t* O; int ldc; bf16_t* O2; int ldc2;
    __device__ __forceinline__ void init(f32x4 (&acc)[2][2][4][2], const Unit&, int, int, int, int) const {
#pragma unroll
        for (int a = 0; a < 2; ++a)
#pragma unroll
            for (int b = 0; b < 2; ++b)
#pragma unroll
                for (int m = 0; m < 4; ++m)
#pragma unroll
                    for (int n = 0; n < 2; ++n) acc[a][b][m][n] = (f32x4){0.f, 0.f, 0.f, 0.f};
    }
    __device__ __forceinline__ void operator()(f32x4 (&acc)[2][2][4][2], const Unit& u, int wr, int wc, int fr, int fq) const {
        const int row0 = u.pm * BM + wr * 64 + fr; const int pn = u.pn;
        if (pn >= 4 && pn < 12) {
            const int colb = 1024 + 128 * (pn - 4) + 16 * wc + 4 * fq;
#pragma unroll
            for (int ai = 0; ai < 2; ++ai)
#pragma unroll
                for (int m = 0; m < 4; ++m) { bf16_t* rowp = O + (size_t)(row0 + ai * HALF + m * 16) * ldc + colb;
#pragma unroll
                    for (int bj = 0; bj < 2; ++bj) { const f32x4 p = acc[ai][bj][m][0] * acc[ai][bj][m][1];
                        u32x2 w; w.x = cvt_pk_bf16(p[0], p[1]); w.y = cvt_pk_bf16(p[2], p[3]);
                        *(u32x2*)(rowp + bj * 64) = w; } }
        } else {
            const bool second = pn >= 16;
            const int col0 = (second ? (pn - 16) * BM : (pn >= 12 ? 2048 + (pn - 12) * BM : pn * BM)) + wc * 32 + 8 * fq;
            bf16_t* Ob = second ? O2 : O; const int ld = second ? ldc2 : ldc;
#pragma unroll
            for (int ai = 0; ai < 2; ++ai)
#pragma unroll
                for (int m = 0; m < 4; ++m) { bf16_t* rowp = Ob + (size_t)(row0 + ai * HALF + m * 16) * ld + col0;
#pragma unroll
                    for (int bj = 0; bj < 2; ++bj) { f32x4 v0 = acc[ai][bj][m][0], v1 = acc[ai][bj][m][1];
                        if (second) {
#pragma unroll
                            for (int i = 0; i < 4; ++i) { v0[i] = v0[i] * sigmoid_fast(v0[i]); v1[i] = v1[i] * sigmoid_fast(v1[i]); } }
                        u32x4 w; w.x = cvt_pk_bf16(v0[0], v0[1]); w.y = cvt_pk_bf16(v0[2], v0[3]); w.z = cvt_pk_bf16(v1[0], v1[1]); w.w = cvt_pk_bf16(v1[2], v1[3]);
                        *(u32x4*)(rowp + bj * HALF) = w; } }
        }
    }
};
struct EpiResidNorm {
    static constexpr bool PERM = false;
    const float* x; float* out; unsigned* ss; unsigned* cnt; const float* fg;
    __device__ __forceinline__ void init(f32x4 (&acc)[2][2][4][2], const Unit& u, int wr, int wc, int fr, int fq) const {
        const int row0 = u.pm * BM + wr * 64 + fr, col0 = u.pn * BM + wc * 32 + 4 * fq;
#pragma unroll
        for (int ai = 0; ai < 2; ++ai)
#pragma unroll
            for (int m = 0; m < 4; ++m) { const size_t off = (size_t)(row0 + ai * HALF + m * 16) * DM + col0;
#pragma unroll
                for (int bj = 0; bj < 2; ++bj)
#pragma unroll
                    for (int n = 0; n < 2; ++n) acc[ai][bj][m][n] = *(const f32x4*)(x + off + bj * HALF + n * 16); }
    }
    __device__ __forceinline__ void operator()(f32x4 (&acc)[2][2][4][2], const Unit& u, int wr, int wc, int fr, int fq) const {
        const int row0 = u.pm * BM + wr * 64 + fr, col0 = u.pn * BM + wc * 32 + 4 * fq;
#pragma unroll
        for (int ai = 0; ai < 2; ++ai)
#pragma unroll
            for (int m = 0; m < 4; ++m) { const int row = row0 + ai * HALF + m * 16; const size_t off = (size_t)row * DM + col0; float s = 0.f;
#pragma unroll
                for (int bj = 0; bj < 2; ++bj)
#pragma unroll
                    for (int n = 0; n < 2; ++n) { const f32x4 o = acc[ai][bj][m][n]; s += (o[0] * o[0] + o[1] * o[1]) + (o[2] * o[2] + o[3] * o[3]); }
                s += __shfl_xor(s, 16); s += __shfl_xor(s, 32);
                if (fq == 0) __hip_atomic_store(ss + (size_t)row * 16 + u.pn * 4 + wc, __float_as_uint(s), __ATOMIC_RELAXED, __HIP_MEMORY_SCOPE_AGENT); }
        asm volatile("s_waitcnt vmcnt(0)" ::: "memory");
        unsigned* c = cnt + (u.pm * 2 + wr) * 32;
        if ((threadIdx.x & 63) == 0) __hip_atomic_fetch_add(c, 1u, __ATOMIC_RELAXED, __HIP_MEMORY_SCOPE_AGENT);
        { unsigned spins = 0;
          while ((unsigned)__builtin_amdgcn_readfirstlane(__hip_atomic_load(c, __ATOMIC_RELAXED, __HIP_MEMORY_SCOPE_AGENT)) < 16u) { __builtin_amdgcn_s_sleep(2); if (++spins > (1u << 22)) break; } }
        asm volatile("" ::: "memory");
#pragma unroll
        for (int ai = 0; ai < 2; ++ai)
#pragma unroll
            for (int m = 0; m < 4; ++m) { const int row = row0 + ai * HALF + m * 16; const size_t off = (size_t)row * DM + col0;
                const unsigned long long* sp = (const unsigned long long*)(ss + (size_t)row * 16 + fq * 4);
                const unsigned long long p0 = __hip_atomic_load(sp, __ATOMIC_RELAXED, __HIP_MEMORY_SCOPE_AGENT), p1 = __hip_atomic_load(sp + 1, __ATOMIC_RELAXED, __HIP_MEMORY_SCOPE_AGENT);
                float t = (__uint_as_float((unsigned)p0) + __uint_as_float((unsigned)(p0 >> 32))) + (__uint_as_float((unsigned)p1) + __uint_as_float((unsigned)(p1 >> 32)));
                t += __shfl_xor(t, 16); t += __shfl_xor(t, 32);
                const float rstd = 1.0f / sqrtf(t * (1.f / DM) + RMS_EPS);
#pragma unroll
                for (int bj = 0; bj < 2; ++bj)
#pragma unroll
                    for (int n = 0; n < 2; ++n) { const f32x4 gv = *(const f32x4*)(fg + col0 + bj * HALF + n * 16);
                        *(f32x4*)(out + off + bj * HALF + n * 16) = acc[ai][bj][m][n] * rstd * gv; } }
    }
};

template <class Epi>
__device__ __forceinline__ void gemm_phase(LAS unsigned char* lds, const Gemm g, const StaticOrder& S, const Epi& E) {
    const int tid = threadIdx.x, wid = __builtin_amdgcn_readfirstlane(tid >> 6), lane = tid & 63, wr = wid >> 2, wc = wid & 3, fr = lane & 15, fq = lane >> 4;
    const int K = g.K, nt = K / BK, lda = g.lda;
    unsigned voffA[2], voffB[2];
#pragma unroll
    for (int i = 0; i < 2; ++i) { int R, C; stage_rc(tid * 16 + i * 8192, R, C); const int Rb = Epi::PERM ? ((R & ~31) + perm32(R & 31)) : R;
        voffA[i] = (unsigned)(R * lda + C) * 2u; voffB[i] = (unsigned)(Rb * K + C) * 2u; }
    const size_t kstep = (size_t)(BK * 2);
    const size_t hstepA = (size_t)HALF * lda * 2, hstepB = (size_t)HALF * K * 2;
    const size_t tstepA = 2 * hstepA, tstepB = 2 * hstepB;
    const unsigned ldsw = (unsigned)wid * 1024u;
    const int aoff = lds_byte(wr * 64 + fr, fq * 8), boff = lds_byte(wc * 32 + fr, fq * 8);
#define PG8_SA(b, h) (((b) * 2 + (h)) * HTB)
#define PG8_SB(b, h) ((4 + (b) * 2 + (h)) * HTB)
#define PG8_STAGE(bufoff, gbase, voff) do { _Pragma("unroll") for (int _i = 0; _i < 2; ++_i) \
        __builtin_amdgcn_global_load_lds((const unsigned*)((const char*)(gbase) + (voff)[_i]), (LAS unsigned*)(lds + (bufoff) + ldsw + _i * 8192), 16, 0, 0); } while (0)
#define PG8_LDA(dst, b, h) do { _Pragma("unroll") for (int m = 0; m < 4; ++m) _Pragma("unroll") for (int k = 0; k < 2; ++k) dst[m][k] = *(const LAS bf16x8*)(lds + PG8_SA(b, h) + aoff + m * 2048 + k * 1024); } while (0)
#define PG8_LDB(dst, b, h) do { _Pragma("unroll") for (int n = 0; n < 2; ++n) _Pragma("unroll") for (int k = 0; k < 2; ++k) dst[n][k] = *(const LAS bf16x8*)(lds + PG8_SB(b, h) + boff + n * 2048 + k * 1024); } while (0)
#define PG8_MMA(ai, bj, At, Bt) do { __builtin_amdgcn_s_setprio(1); _Pragma("unroll") for (int m = 0; m < 4; ++m) _Pragma("unroll") for (int n = 0; n < 2; ++n) _Pragma("unroll") for (int k = 0; k < 2; ++k) \
        acc[ai][bj][m][n] = __builtin_amdgcn_mfma_f32_16x16x32_bf16(Bt[n][k], At[m][k], acc[ai][bj][m][n], 0, 0, 0); __builtin_amdgcn_s_setprio(0); } while (0)
#define PG8_WAIT_V(n) asm volatile("s_waitcnt vmcnt(" #n ")" ::: "memory")
#define PG8_WAIT_L(n) asm volatile("s_waitcnt lgkmcnt(" #n ")" ::: "memory")
#define PG8_BAR __builtin_amdgcn_s_barrier()
#define PG8_SCHED __builtin_amdgcn_sched_barrier(0)
    Unit cur, nxt; int ui = 0;
    if (!S.next(0, cur)) return;
    if (g.skew > 0) { const unsigned long long t0 = __builtin_amdgcn_s_memrealtime(), dt = (unsigned long long)((blockIdx.x & 7u) * (unsigned)g.skew);
        while (__builtin_amdgcn_s_memrealtime() - t0 < dt) __builtin_amdgcn_s_sleep(8); }
    f32x4 acc[2][2][4][2];
    E.init(acc, cur, wr, wc, fr, fq);
    bf16x8 At[4][2], B0[2][2], B1[2][2];
    const char* cA = (const char*)g.A + (size_t)cur.pm * tstepA; const char* cB = (const char*)g.Bt + (size_t)cur.pn * tstepB;
#if PG8_SP2
    PG8_STAGE(PG8_SB(0, 0), cB, voffB); PG8_STAGE(PG8_SB(0, 1), cB + hstepB, voffB); PG8_STAGE(PG8_SA(0, 0), cA, voffA); PG8_STAGE(PG8_SA(0, 1), cA + hstepA, voffA);
    if (wr == 1) PG8_BAR;
    PG8_WAIT_V(2); PG8_BAR;
    PG8_STAGE(PG8_SB(1, 0), cB + kstep, voffB); PG8_STAGE(PG8_SA(1, 0), cA + kstep, voffA); PG8_STAGE(PG8_SB(1, 1), cB + hstepB + kstep, voffB);
    PG8_WAIT_V(6); PG8_BAR;
#else
    PG8_STAGE(PG8_SB(0, 0), cB, voffB); PG8_STAGE(PG8_SA(0, 0), cA, voffA); PG8_STAGE(PG8_SB(0, 1), cB + hstepB, voffB); PG8_STAGE(PG8_SA(0, 1), cA + hstepA, voffA);
    if (wr == 1) PG8_BAR;
    PG8_WAIT_V(4); PG8_BAR;
    PG8_STAGE(PG8_SB(1, 0), cB + kstep, voffB); PG8_STAGE(PG8_SA(1, 0), cA + kstep, voffA); PG8_STAGE(PG8_SB(1, 1), cB + hstepB + kstep, voffB);
    PG8_WAIT_V(6); PG8_BAR;
#endif
    for (;;) {
        const bool has_next = S.next(ui + 1, nxt);
        const char* nA = has_next ? (const char*)g.A + (size_t)nxt.pm * tstepA : cA; const char* nB = has_next ? (const char*)g.Bt + (size_t)nxt.pn * tstepB : cB;
        for (int t = 0; t < nt; t += 2) {
            const bool last = (t == nt - 2);
            const char* a1 = cA + (size_t)(t + 1) * kstep;
            const char* a2 = last ? nA : cA + (size_t)(t + 2) * kstep; const char* b2 = last ? nB : cB + (size_t)(t + 2) * kstep;
            const char* a3 = a2 + kstep; const char* b3 = b2 + kstep;
#if PG8_SP2
            PG8_LDB(B0, 0, 0); PG8_LDB(B1, 0, 1); PG8_SCHED; PG8_LDA(At, 0, 0); PG8_STAGE(PG8_SA(1, 1), a1 + hstepA, voffA);
            PG8_WAIT_V(8); PG8_WAIT_L(0); PG8_BAR; PG8_MMA(0, 0, At, B0); PG8_MMA(0, 1, At, B1); PG8_BAR; PG8_SCHED;
            PG8_LDA(At, 0, 1); PG8_STAGE(PG8_SB(0, 0), b2, voffB); PG8_STAGE(PG8_SB(0, 1), b2 + hstepB, voffB); PG8_STAGE(PG8_SA(0, 0), a2, voffA);
            PG8_WAIT_V(8); PG8_WAIT_L(0); PG8_BAR; PG8_MMA(1, 0, At, B0); PG8_MMA(1, 1, At, B1); PG8_BAR; PG8_SCHED;
            PG8_LDB(B0, 1, 0); PG8_LDB(B1, 1, 1); PG8_SCHED; PG8_LDA(At, 1, 0); PG8_STAGE(PG8_SA(0, 1), a2 + hstepA, voffA);
            PG8_WAIT_V(8); PG8_WAIT_L(0); PG8_BAR; PG8_MMA(0, 0, At, B0); PG8_MMA(0, 1, At, B1); PG8_BAR; PG8_SCHED;
            PG8_LDA(At, 1, 1); PG8_STAGE(PG8_SB(1, 0), b3, voffB); PG8_STAGE(PG8_SB(1, 1), b3 + hstepB, voffB); PG8_STAGE(PG8_SA(1, 0), a3, voffA);
            PG8_WAIT_V(8); PG8_WAIT_L(0); PG8_BAR; PG8_MMA(1, 0, At, B0); PG8_MMA(1, 1, At, B1); PG8_BAR; PG8_SCHED;
#else
            PG8_LDB(B0, 0, 0); PG8_SCHED; PG8_LDA(At, 0, 0); PG8_STAGE(PG8_SA(1, 1), a1 + hstepA, voffA);
            PG8_WAIT_L(8); PG8_BAR; PG8_WAIT_L(0); PG8_MMA(0, 0, At, B0); PG8_BAR; PG8_SCHED;
            PG8_LDB(B1, 0, 1); PG8_STAGE(PG8_SB(0, 0), b2, voffB);
            PG8_BAR; PG8_WAIT_L(0); PG8_MMA(0, 1, At, B1); PG8_BAR;
            PG8_LDA(At, 0, 1); PG8_STAGE(PG8_SA(0, 0), a2, voffA);
            PG8_BAR; PG8_WAIT_L(0); PG8_MMA(1, 0, At, B0); PG8_BAR; PG8_SCHED;
            PG8_STAGE(PG8_SB(0, 1), b2 + hstepB, voffB);
            PG8_WAIT_V(6); PG8_BAR; PG8_MMA(1, 1, At, B1); PG8_BAR;
            PG8_LDB(B0, 1, 0); PG8_SCHED; PG8_LDA(At, 1, 0); PG8_STAGE(PG8_SA(0, 1), a2 + hstepA, voffA);
            PG8_WAIT_L(8); PG8_BAR; PG8_WAIT_L(0); PG8_MMA(0, 0, At, B0); PG8_BAR; PG8_SCHED;
            PG8_LDB(B1, 1, 1); PG8_STAGE(PG8_SB(1, 0), b3, voffB);
            PG8_BAR; PG8_WAIT_L(0); PG8_MMA(0, 1, At, B1); PG8_BAR;
            PG8_LDA(At, 1, 1); PG8_STAGE(PG8_SA(1, 0), a3, voffA);
            PG8_BAR; PG8_WAIT_L(0); PG8_MMA(1, 0, At, B0); PG8_BAR; PG8_SCHED;
            PG8_STAGE(PG8_SB(1, 1), b3 + hstepB, voffB);
            PG8_WAIT_V(6); PG8_BAR; PG8_MMA(1, 1, At, B1); PG8_BAR;
#endif
        }
#if PG8_ALIGN
        if (wr == 0) PG8_BAR;
#endif
        E(acc, cur, wr, wc, fr, fq);
        if (!has_next) break;
        cur = nxt; cA = nA; cB = nB; ++ui;
        E.init(acc, cur, wr, wc, fr, fq);
#if PG8_ALIGN
        if (wr == 1) PG8_BAR;
#endif
    }
    PG8_WAIT_V(0);
#if !PG8_ALIGN
    if (wr == 0) PG8_BAR;
#endif
    PG8_BAR;
#undef PG8_SA
#undef PG8_SB
#undef PG8_STAGE
#undef PG8_LDA
#undef PG8_LDB
#undef PG8_MMA
#undef PG8_WAIT_V
#undef PG8_WAIT_L
#undef PG8_BAR
#undef PG8_SCHED
}
}

__device__ __forceinline__ void p0_transpose_item(const float* W, int ldw, int k0, int ncol0, bf16_t* WT, int ldt, int drow0, int dk0, LAS float* scr, int lane, int mode = 0) {
#pragma unroll 8
    for (int i = 0; i < 32; ++i) { const int kk = 2 * i + (lane >> 5); scr[kk * 33 + (lane & 31)] = W[(size_t)(k0 + kk) * ldw + ncol0 + (lane & 31)]; }
    asm volatile("s_waitcnt lgkmcnt(0)" ::: "memory");
    const int c = lane & 7;
#pragma unroll
    for (int j = 0; j < 4; ++j) { const int n = (lane >> 3) + 8 * j; const LAS float* s = scr + (8 * c) * 33 + n;
        u32x4 o; o.x = cvt_pk_bf16(s[0 * 33], s[1 * 33]); o.y = cvt_pk_bf16(s[2 * 33], s[3 * 33]); o.z = cvt_pk_bf16(s[4 * 33], s[5 * 33]); o.w = cvt_pk_bf16(s[6 * 33], s[7 * 33]);
        int drow = drow0 + n;
        if (mode) { const int ch = drow0 + n; drow = 1024 + 256 * (ch >> 7) + 128 * ((ch >> 6) & 1) + 32 * ((ch >> 4) & 3) + 8 * ((ch >> 2) & 3) + 4 * (mode - 1) + (ch & 3); }
        *(u32x4*)(WT + (size_t)drow * ldt + dk0 + 8 * c) = o; }
    asm volatile("s_waitcnt lgkmcnt(0)" ::: "memory");
}

__device__ __forceinline__ void phase0(const Args& a, LAS unsigned char* lds, int wave, int lane) {
    LAS float* scr = (LAS float*)(lds + wave * 16384);
    const int gw = blockIdx.x * 8 + wave, NGW = gridDim.x * 8;
    bf16_t* win_t = (bf16_t*)(a.ws + WS_WIN); bf16_t* wout_t = (bf16_t*)(a.ws + WS_WOUT); bf16_t* wg = (bf16_t*)(a.ws + WS_WG);
    constexpr int I_IN = 16 * 192, I_OUT = 32 * 32, I_G = 64;
    for (int it = gw; it < I_IN + I_OUT + I_G; it += NGW) {
        int r = it;
        if (r < I_IN) { const int kb = r / 192, nb = r % 192; const int og = nb / 32;
            if (og == 1 || og == 2) p0_transpose_item(a.in[I_WIN], NPROJ, kb * 64, nb * 32, win_t, DM, (nb % 32) * 32, kb * 64, scr, lane, og);
            else { const int nbase = (og == 0) ? 0 : (og == 4 ? 3072 : (og == 3 ? 4096 : 5120));
                p0_transpose_item(a.in[I_WIN], NPROJ, kb * 64, nb * 32, win_t, DM, nbase + (nb % 32) * 32, kb * 64, scr, lane, 0); }
            continue; }
        r -= I_IN;
        if (r < I_OUT) { const int kb = r / 32, nb = r % 32; p0_transpose_item(a.in[I_WOUT], DM, kb * 64, nb * 32, wout_t, DMIX, nb * 32, kb * 64, scr, lane); continue; }
        r -= I_OUT;
        { const int mat = r / 32, h = (r % 32) / 2, nb = r & 1; const float* W = (mat ? a.in[I_WI] : a.in[I_WA]) + h * 4096;
          p0_transpose_item(W, 64, 0, nb * 32, wg + mat * 65536 + h * 4096, 64, nb * 32, 0, scr, lane); }
    }
    const float* x = a.in[I_X]; bf16_t* xn = (bf16_t*)(a.ws + WS_XN);
    f32x4 gv[4];
#pragma unroll
    for (int j = 0; j < 4; ++j) gv[j] = ((const f32x4*)a.in[I_LNG])[lane + 64 * j];
    for (int m = gw; m < T_TOK; m += NGW) {
        const f32x4* xr = (const f32x4*)(x + (size_t)m * DM) + lane;
        f32x4 v[4]; float s = 0.f;
#pragma unroll
        for (int j = 0; j < 4; ++j) { v[j] = xr[64 * j]; s += (v[j].x * v[j].x + v[j].y * v[j].y) + (v[j].z * v[j].z + v[j].w * v[j].w); }
        const float rstd = 1.0f / sqrtf(wave_sum(s) * (1.f / DM) + RMS_EPS);
        u32x2* o8 = (u32x2*)(xn + (size_t)m * DM) + lane;
#pragma unroll
        for (int j = 0; j < 4; ++j) { u32x2 w; w.x = cvt_pk_bf16(v[j].x * rstd * gv[j].x, v[j].y * rstd * gv[j].y); w.y = cvt_pk_bf16(v[j].z * rstd * gv[j].z, v[j].w * rstd * gv[j].w); o8[64 * j] = w; }
    }
}

#define DPP_ADD(v, ctrl) ((v) + __uint_as_float(__builtin_amdgcn_update_dpp(0, __float_as_uint(v), (ctrl), 0xF, 0xF, false)))
__device__ __forceinline__ void conv_item(const Args& a, bf16_t* proj, bf16_t* projg, bf16_t* obase, int ostride, int item, int wave, int lane) {
    const int q = lane >> 4, c8 = lane & 15, ch0 = wave * 128 + c8 * 8;
    float w0[8], w1[8], w2[8], gn[8];
    { const float* cw = a.in[I_CONVW] + ch0; const float* cg_ = a.in[I_CG] + ch0;
#pragma unroll
      for (int j = 0; j < 8; ++j) { w0[j] = cw[j]; w1[j] = cw[1024 + j]; w2[j] = cw[2048 + j]; gn[j] = cg_[j]; } }
    const int tok0 = item * (4 * CONV_R) + q * CONV_R;
    bf16_t* base = proj + (size_t)tok0 * LDPA + ch0; const bf16_t* gbase = projg + (size_t)tok0 * LDPG + ch0;
    float p2[8], p1[8];
    if ((tok0 & (SEQ - 1)) == 0) {
#pragma unroll
        for (int j = 0; j < 8; ++j) { p2[j] = 0.f; p1[j] = 0.f; }
    } else {
        const u32x4 c2 = *(const u32x4*)(base - 2 * LDPA + COL_CX), c1 = *(const u32x4*)(base - 1 * LDPA + COL_CX);
        unpack8(c2, p2); unpack8(c1, p1);
    }
    u32x4 nb[2], nc[2], ng[2];
#pragma unroll
    for (int k = 0; k < 2; ++k) { const bf16_t* rp = base + (size_t)k * LDPA; nb[k] = *(const u32x4*)(rp + COL_B); nc[k] = *(const u32x4*)(rp + COL_CX); ng[k] = *(const u32x4*)(gbase + (size_t)k * LDPG); }
    for (int i = 0; i < CONV_R; i += 2) {
        u32x4 vb[2], vc[2], vg[2];
#pragma unroll
        for (int k = 0; k < 2; ++k) { vb[k] = nb[k]; vc[k] = nc[k]; vg[k] = ng[k]; }
        if (i + 2 < CONV_R) {
#pragma unroll
            for (int k = 0; k < 2; ++k) { const bf16_t* rp = base + (size_t)(i + 2 + k) * LDPA; nb[k] = *(const u32x4*)(rp + COL_B); nc[k] = *(const u32x4*)(rp + COL_CX); ng[k] = *(const u32x4*)(gbase + (size_t)(i + 2 + k) * LDPG); }
        }
#pragma unroll
        for (int k = 0; k < 2; ++k) {
            float fb[8], cx[8], fg[8], y[8];
            unpack8(vb[k], fb); unpack8(vc[k], cx); unpack8(vg[k], fg);
            float ss = 0.f;
#pragma unroll
            for (int j = 0; j < 8; ++j) { const float cv = w0[j] * p2[j] + w1[j] * p1[j] + w2[j] * cx[j]; y[j] = fb[j] * cv; ss += y[j] * y[j]; p2[j] = p1[j]; p1[j] = cx[j]; }
            ss = DPP_ADD(ss, 0xB1); ss = DPP_ADD(ss, 0x4E); ss = DPP_ADD(ss, 0x141); ss = DPP_ADD(ss, 0x140);
            const float rstd = __builtin_amdgcn_rsqf(ss * (1.f / 128.f) + RMS_EPS);
            float o[8];
#pragma unroll
            for (int j = 0; j < 8; ++j) o[j] = y[j] * rstd * gn[j] * fg[j];
            u32x4 w; w.x = cvt_pk_bf16(o[0], o[1]); w.y = cvt_pk_bf16(o[2], o[3]); w.z = cvt_pk_bf16(o[4], o[5]); w.w = cvt_pk_bf16(o[6], o[7]);
            *(u32x4*)(obase + (size_t)(tok0 + i + k) * ostride + ch0) = w;
        }
    }
}

constexpr int L_GW = 0;
constexpr int L_CW = 18432;
constexpr int L_AGG = 20992;
constexpr int L_WT = 29184;
constexpr int WT_BYTES = 8704;
static_assert(L_WT + 8 * WT_BYTES <= 131072, "lds");
typedef float f32x2 __attribute__((ext_vector_type(2)));

__device__ __forceinline__ void lru_item(const Args& a, bf16_t* proj, bf16_t* projg, bf16_t* obase, int ostride, LAS unsigned char* lds, int chain, int part, int nsplit, int tid, int wave, int lane) {
    const int b = chain >> 4, h = chain & 15;
    {
        const bf16_t* wg = (const bf16_t*)(a.ws + WS_WG);
        for (int i = tid; i < 1024; i += NTHREADS) { const int mat = i >> 9, e = (i >> 3) & 63, c = i & 7;
            const u32x4 v = *(const u32x4*)(wg + mat * 65536 + h * 4096 + e * 64 + c * 8);
            *(LAS u32x4*)(lds + L_GW + mat * 9216 + e * 144 + c * 16) = v; }
        LAS float* cw = (LAS float*)(lds + L_CW);
        if (tid < 256) cw[tid] = a.in[I_LCW][(tid >> 6) * 1024 + h * 64 + (tid & 63)];
        else if (tid < 320) { const int c = tid - 256, gc = h * 64 + c;
            cw[256 + c] = a.in[I_LCB][gc]; cw[320 + c] = a.in[I_BA][gc]; cw[384 + c] = a.in[I_BI][gc];
            const float lam = a.in[I_LAM][gc];
            const float logsig = (lam >= 0.f) ? -log1pf(expf(-lam)) : (lam - log1pf(expf(lam)));
            cw[448 + c] = 8.0f * logsig * 1.44269504f;
            cw[512 + c] = a.in[I_LG][gc]; }
    }
    __syncthreads();
    const int r = lane & 31, hh = lane >> 5;
    LAS unsigned char* wt = lds + L_WT + wave * WT_BYTES;
    LAS const float* cw = (LAS const float*)(lds + L_CW);
    bf16x8 I0, I1;
    {
        u32x4 t0 = (u32x4){0u, 0u, 0u, 0u}, t1 = t0;
        const int j0 = r - 8 * hh, j1 = r - 16 - 8 * hh;
#pragma unroll
        for (int d = 0; d < 4; ++d) {
            t0[d] = (j0 == 2 * d) ? 0x00003F80u : ((j0 == 2 * d + 1) ? 0x3F800000u : 0u);
            t1[d] = (j1 == 2 * d) ? 0x00003F80u : ((j1 == 2 * d + 1) ? 0x3F800000u : 0u);
        }
        I0 = __builtin_bit_cast(bf16x8, t0); I1 = __builtin_bit_cast(bf16x8, t1);
    }
    float ba[2], bi[2], cf[2];
#pragma unroll
    for (int n = 0; n < 2; ++n) { ba[n] = cw[320 + 32 * n + r]; bi[n] = cw[384 + 32 * n + r]; cf[n] = cw[448 + 32 * n + r]; }
    float carry[2] = {0.f, 0.f};
    unsigned* flags = (unsigned*)(a.ws + WS_CTL + 4096) + chain * 32;
    unsigned long long* aggg = (unsigned long long*)(a.ws + WS_AGG) + (size_t)chain * 16 * 64;

    const bf16_t* xl_base = proj + (size_t)b * SEQ * LDPA + COL_XL + h * 64;
    const bf16_t* gl_base = projg + (size_t)b * SEQ * LDPG + 1024 + h * 64;
    u32x4 xr[5];
#define LOAD_X(seg_) do { const int s0_ = (seg_) * 256 + wave * 32; _Pragma("unroll") for (int i = 0; i < 5; ++i) { const int idx = lane + 64 * i, row = idx >> 3, c = idx & 7; const int s = s0_ - 3 + row; \
        xr[i] = (u32x4){0u, 0u, 0u, 0u}; if (idx < 280 && s >= 0) xr[i] = *(const u32x4*)(xl_base + (size_t)s * LDPA + c * 8); } } while (0)
    LOAD_X(part);
    for (int seg = part; seg < 16; seg += nsplit) {
        const int s0 = seg * 256 + wave * 32;
#pragma unroll
        for (int i = 0; i < 5; ++i) { const int idx = lane + 64 * i, row = idx >> 3, c = idx & 7; if (idx < 280) *(LAS u32x4*)(wt + row * 144 + c * 16) = xr[i]; }
        if (seg + nsplit < 16) LOAD_X(seg + nsplit);
        u32x4 gl[4];
#define LOAD_GL() do { _Pragma("unroll") for (int i = 0; i < 4; ++i) { const int tok = (lane >> 3) + 8 * i, c = lane & 7; gl[i] = *(const u32x4*)(gl_base + (size_t)(s0 + tok) * LDPG + c * 8); } } while (0)
#if GL_EARLY
        LOAD_GL();
#endif
        asm volatile("s_waitcnt lgkmcnt(0)" ::: "memory");
        bf16x8 Af[4];
#pragma unroll
        for (int s = 0; s < 4; ++s) {
            const int c0 = 16 * s + 8 * hh;
            float u8[8];
            { const f32x4 b0 = *(LAS const f32x4*)(cw + 256 + c0), b1 = *(LAS const f32x4*)(cw + 256 + c0 + 4);
              u8[0] = b0[0]; u8[1] = b0[1]; u8[2] = b0[2]; u8[3] = b0[3]; u8[4] = b1[0]; u8[5] = b1[1]; u8[6] = b1[2]; u8[7] = b1[3]; }
#pragma unroll
            for (int k = 0; k < 4; ++k) {
                const u32x4 xv = *(LAS const u32x4*)(wt + (r + k) * 144 + c0 * 2);
                const f32x4 wv0 = *(LAS const f32x4*)(cw + k * 64 + c0), wv1 = *(LAS const f32x4*)(cw + k * 64 + c0 + 4);
                float fx[8]; unpack8(xv, fx);
                u8[0] += wv0[0] * fx[0]; u8[1] += wv0[1] * fx[1]; u8[2] += wv0[2] * fx[2]; u8[3] += wv0[3] * fx[3];
                u8[4] += wv1[0] * fx[4]; u8[5] += wv1[1] * fx[5]; u8[6] += wv1[2] * fx[6]; u8[7] += wv1[3] * fx[7];
            }
            u32x4 pk; pk.x = cvt_pk_bf16(u8[0], u8[1]); pk.y = cvt_pk_bf16(u8[2], u8[3]); pk.z = cvt_pk_bf16(u8[4], u8[5]); pk.w = cvt_pk_bf16(u8[6], u8[7]);
            Af[s] = __builtin_bit_cast(bf16x8, pk);
        }
#pragma unroll
        for (int n = 0; n < 2; ++n) {
            float hl[16], pc[16];
            f32x16 accR, accI, accU;
#pragma unroll
            for (int j = 0; j < 16; ++j) { accR[j] = 0.f; accI[j] = 0.f; accU[j] = 0.f; }
#pragma unroll
            for (int s = 0; s < 4; ++s) {
                const bf16x8 Ba = *(LAS const bf16x8*)(lds + L_GW + (32 * n + r) * 144 + (16 * s + 8 * hh) * 2);
                const bf16x8 Bi = *(LAS const bf16x8*)(lds + L_GW + 9216 + (32 * n + r) * 144 + (16 * s + 8 * hh) * 2);
                accR = __builtin_amdgcn_mfma_f32_32x32x16_bf16(Af[s], Ba, accR, 0, 0, 0);
                accI = __builtin_amdgcn_mfma_f32_32x32x16_bf16(Af[s], Bi, accI, 0, 0, 0);
            }
            accU = __builtin_amdgcn_mfma_f32_32x32x16_bf16(Af[2 * n], I0, accU, 0, 0, 0);
            accU = __builtin_amdgcn_mfma_f32_32x32x16_bf16(Af[2 * n + 1], I1, accU, 0, 0, 0);
            float gP[4], gH[4];
#pragma unroll
            for (int g = 0; g < 4; ++g) {
                float P = 1.f, H = 0.f;
#pragma unroll
                for (int i = 0; i < 4; ++i) { const int j = 4 * g + i;
                    const float rr = sigmoid_fast(accR[j] + ba[n]);
                    const float ii = sigmoid_fast(accI[j] + bi[n]);
                    const float l2 = rr * cf[n];
                    const float aa = __builtin_amdgcn_exp2f(l2);
                    const float t = l2 * 1.38629436f;
                    const float em_small = -t * (1.0f + t * (0.5f + t * (0.16666667f + t * 0.041666667f)));
                    const float one_m = (t > -0.0625f) ? em_small : (1.0f - aa * aa);
                    const float dd = __builtin_amdgcn_sqrtf(one_m) * ii * accU[j];
                    H = aa * H + dd; P = P * aa; hl[j] = H; pc[j] = P; }
                gP[g] = P; gH[g] = H;
            }
            float cp = 1.f, ch = 0.f;
#pragma unroll
            for (int g = 0; g < 4; ++g) {
                const auto sp = __builtin_amdgcn_permlane32_swap(__float_as_uint(gP[g]), __float_as_uint(gP[g]), false, false);
                const auto sh = __builtin_amdgcn_permlane32_swap(__float_as_uint(gH[g]), __float_as_uint(gH[g]), false, false);
                const float oP = __uint_as_float(hh ? sp[0] : sp[1]), oH = __uint_as_float(hh ? sh[0] : sh[1]);
                const float P = gP[g], H = gH[g];
                const float A1 = hh ? oP : P, H1 = hh ? oH : H, A2 = hh ? P : oP, H2 = hh ? H : oH;
                const float cp1 = cp * A1, ch1 = A1 * ch + H1;
                const float inP = hh ? cp1 : cp, inH = hh ? ch1 : ch;
#pragma unroll
                for (int i = 0; i < 4; ++i) { const int j = 4 * g + i; hl[j] += pc[j] * inH; pc[j] *= inP; }
                cp = cp1 * A2; ch = A2 * ch1 + H2;
            }
            if (hh == 0) *(LAS f32x2*)(lds + L_AGG + ((n * 8 + wave) * 64 + 32 * n + r) * 8) = (f32x2){cp, ch};
#if !GL_EARLY
            if (n == 1) LOAD_GL();
#endif
            if (nsplit > 1 && seg > 0 && wave == 0) {
                unsigned spins = 0;
                while (__builtin_amdgcn_readfirstlane(__hip_atomic_load(flags + (seg - 1) * 2 + n, __ATOMIC_RELAXED, __HIP_MEMORY_SCOPE_AGENT)) == 0u) { __builtin_amdgcn_s_sleep(2); if (++spins > (1u << 22)) break; }
                asm volatile("" ::: "memory");
            }
            __syncthreads();
            float c = carry[n];
            if (nsplit > 1 && seg > 0) {
                const unsigned long long pw = __hip_atomic_load(aggg + (size_t)(seg - 1) * 64 + n * 32 + r, __ATOMIC_RELAXED, __HIP_MEMORY_SCOPE_AGENT);
                c = __uint_as_float((unsigned)pw) * c + __uint_as_float((unsigned)(pw >> 32));
            }
            float cin = 0.f, iP = 1.f, iH = 0.f;
#pragma unroll
            for (int w = 0; w < 8; ++w) {
                const f32x2 ag = *(LAS const f32x2*)(lds + L_AGG + ((n * 8 + w) * 64 + 32 * n + r) * 8);
                cin = (w == wave) ? c : cin; c = ag.x * c + ag.y; iH = ag.x * iH + ag.y; iP *= ag.x; }
            carry[n] = c;
            if (nsplit > 1 && wave == 0) {
                if (hh == 0) __hip_atomic_store(aggg + (size_t)seg * 64 + n * 32 + r, ((unsigned long long)__float_as_uint(iH) << 32) | __float_as_uint(iP), __ATOMIC_RELAXED, __HIP_MEMORY_SCOPE_AGENT);
                asm volatile("s_waitcnt vmcnt(0)" ::: "memory");
                if (lane == 0) __hip_atomic_store(flags + seg * 2 + n, 1u, __ATOMIC_RELAXED, __HIP_MEMORY_SCOPE_AGENT);
            }
#pragma unroll
            for (int j = 0; j < 16; ++j) { const int row = (j & 3) + 8 * (j >> 2) + 4 * hh;
                *(LAS float*)(wt + row * 272 + (32 * n + r) * 4) = hl[j] + pc[j] * cin; }
        }
        asm volatile("s_waitcnt lgkmcnt(0)" ::: "memory");
#pragma unroll
        for (int i = 0; i < 4; ++i) {
            const int tok = (lane >> 3) + 8 * i, c = lane & 7;
            const f32x4 h0 = *(LAS const f32x4*)(wt + tok * 272 + c * 32), h1 = *(LAS const f32x4*)(wt + tok * 272 + c * 32 + 16);
            const f32x4 g0 = *(LAS const f32x4*)(cw + 512 + c * 8), g1 = *(LAS const f32x4*)(cw + 512 + c * 8 + 4);
            float ss = (h0[0] * h0[0] + h0[1] * h0[1]) + (h0[2] * h0[2] + h0[3] * h0[3]) + (h1[0] * h1[0] + h1[1] * h1[1]) + (h1[2] * h1[2] + h1[3] * h1[3]);
            ss = DPP_ADD(ss, 0xB1); ss = DPP_ADD(ss, 0x4E); ss = DPP_ADD(ss, 0x141);
            const float rstd = __builtin_amdgcn_rsqf(ss * (1.f / 64.f) + RMS_EPS);
            float fg[8]; unpack8(gl[i], fg);
            float o[8];
            o[0] = h0[0] * rstd * g0[0]; o[1] = h0[1] * rstd * g0[1]; o[2] = h0[2] * rstd * g0[2]; o[3] = h0[3] * rstd * g0[3];
            o[4] = h1[0] * rstd * g1[0]; o[5] = h1[1] * rstd * g1[1]; o[6] = h1[2] * rstd * g1[2]; o[7] = h1[3] * rstd * g1[3];
#pragma unroll
            for (int j = 0; j < 8; ++j) o[j] *= fg[j];
            u32x4 w; w.x = cvt_pk_bf16(o[0], o[1]); w.y = cvt_pk_bf16(o[2], o[3]); w.z = cvt_pk_bf16(o[4], o[5]); w.w = cvt_pk_bf16(o[6], o[7]);
            *(u32x4*)(obase + (size_t)(b * SEQ + s0 + tok) * ostride + h * 64 + c * 8) = w;
        }
        asm volatile("s_waitcnt lgkmcnt(0)" ::: "memory");
    }
#undef LOAD_X
    __syncthreads();
}

__global__ void __launch_bounds__(NTHREADS, 2) hymba_fwd(Args a) {
    extern __shared__ __attribute__((aligned(16))) unsigned char lds_raw[];
    LAS unsigned char* lds = (LAS unsigned char*)lds_raw;
    cg::grid_group grid = cg::this_grid();
    if (gridDim.y == 0x7fffu) grid.sync();
    volatile LAS unsigned* bst = (volatile LAS unsigned*)(lds + 131072 + 64);
    if (threadIdx.x == 0) { bst[0] = 0u; bst[1] = 0u; }
    __syncthreads();
    const XcdBarrier bar = xcd_barrier_post((unsigned*)(a.ws + WS_CTL + 32768), bst);
    const int tid = threadIdx.x, lane = tid & 63, wave = __builtin_amdgcn_readfirstlane(tid >> 6);
    bf16_t* proj = (bf16_t*)(a.ws + WS_PROJ); bf16_t* projg = (bf16_t*)(a.ws + WS_PROJG);

#pragma unroll
    for (int rep = 0; rep < REP0; ++rep) {
#ifndef SKIP_P0
    phase0(a, lds, wave, lane);
#endif

    xcd_barrier(bar); }
#pragma unroll
    for (int rep = 0; rep < REP1; ++rep) {
        pg8::Gemm g{(const bf16_t*)(a.ws + WS_XN), (const bf16_t*)(a.ws + WS_WIN), T_TOK, NPROJ, DM, DM, SKEW1};
        pg8::StaticOrder S; S.init(T_TOK, NPROJ, (int)gridDim.x, (int)blockIdx.x);
        pg8::EpiBf16 E{proj, LDPA, projg, LDPG};
#ifndef SKIP_G1
        pg8::gemm_phase<pg8::EpiBf16>(lds, g, S, E);
#endif
    xcd_barrier(bar); }
    {
#ifndef SKIP_LRU
        if (gridDim.x >= 256) { if (blockIdx.x < 256) lru_item(a, proj, projg, projg + 1024, LDPG, lds, (int)blockIdx.x >> 1, (int)blockIdx.x & 1, 2, tid, wave, lane); }
        else for (int it = blockIdx.x; it < 128; it += gridDim.x) lru_item(a, proj, projg, projg + 1024, LDPG, lds, it, 0, 1, tid, wave, lane);
#endif
        LAS unsigned* qs = (LAS unsigned*)(lds + 131072);
        unsigned* qctr = (unsigned*)(a.ws + WS_CTL);
        for (;;) {
            if (tid == 0) qs[0] = atomicAdd(qctr, 1u);
            __syncthreads();
            const unsigned it = qs[0];
            __syncthreads();
            if (it >= (unsigned)(T_TOK / (4 * CONV_R))) break;
#ifndef SKIP_CONV
            conv_item(a, proj, projg, projg, LDPG, (int)it, wave, lane);
#endif
        }
    }
    xcd_barrier(bar);
#pragma unroll
    for (int rep = 0; rep < REP3; ++rep) {
        pg8::Gemm g{projg, (const bf16_t*)(a.ws + WS_WOUT), T_TOK, DM, DMIX, LDPG, SKEW3};
        pg8::StaticOrder S; S.init(T_TOK, DM, (int)gridDim.x, (int)blockIdx.x);
        pg8::EpiResidNorm E{a.in[I_X], a.out, (unsigned*)(a.ws + WS_SS), (unsigned*)(a.ws + WS_CTL + 65536), a.in[I_FG]};
#ifndef SKIP_G2
        pg8::gemm_phase<pg8::EpiResidNorm>(lds, g, S, E);
#endif
    }
}

extern "C" void kernel_launch(void* const* d_in, const int* in_sizes, int n_in, void* d_out, int out_size, void* d_ws, size_t ws_size, hipStream_t stream) {
    static int grid = 0;
    if (grid == 0) {
        if (n_in != 15 || out_size != T_TOK * DM || ws_size < WS_END) { fprintf(stderr, "kernel_launch: unexpected shapes (n_in %d out %d ws %zu)\n", n_in, out_size, ws_size); grid = -1; return; }
        int dev = 0, cus = 0, per_cu = 0;
        hipGetDevice(&dev);
        hipDeviceGetAttribute(&cus, hipDeviceAttributeMultiprocessorCount, dev);
        if (hipFuncSetAttribute((const void*)hymba_fwd, hipFuncAttributeMaxDynamicSharedMemorySize, LDS_BYTES) != hipSuccess) { fprintf(stderr, "kernel_launch: hipFuncSetAttribute failed\n"); grid = -1; return; }
        if (hipOccupancyMaxActiveBlocksPerMultiprocessor(&per_cu, (const void*)hymba_fwd, NTHREADS, LDS_BYTES) != hipSuccess || per_cu < 1) { fprintf(stderr, "kernel_launch: occupancy query says %d\n", per_cu); per_cu = 1; }
        (void)hipGetLastError();
        grid = cus;
        if (grid != 256) { fprintf(stderr, "kernel_launch: built for a 256-CU device (got %d)\n", cus); grid = -1; return; }
    }
    if (grid < 0) return;
    hipMemsetAsync((char*)d_ws + WS_CTL, 0, CTL_BYTES, stream);
    Args a{};
    for (int i = 0; i < 15; ++i) a.in[i] = (const float*)d_in[i];
    a.out = (float*)d_out; a.ws = (unsigned char*)d_ws;
    void* args[] = {&a};
    hipError_t e = hipLaunchCooperativeKernel((const void*)hymba_fwd, dim3(grid), dim3(NTHREADS), args, LDS_BYTES, stream);
    if (e != hipSuccess) fprintf(stderr, "kernel_launch: cooperative launch failed: %s (grid %d)\n", hipGetErrorString(e), grid);
}
```

```cpp
#include <hip/hip_runtime.h>
#include <hip/hip_cooperative_groups.h>
#include <cstdio>
namespace cg = cooperative_groups;

#define LAS __attribute__((address_space(3)))
typedef unsigned short bf16_t;
typedef short bf16x8 __attribute__((ext_vector_type(8)));
typedef float f32x4 __attribute__((ext_vector_type(4)));
typedef float f32x16 __attribute__((ext_vector_type(16)));
typedef unsigned u32x4 __attribute__((ext_vector_type(4)));
typedef unsigned u32x2 __attribute__((ext_vector_type(2)));

constexpr int T_TOK = 32768, SEQ = 4096, DM = 1024, NPROJ = 6144, DMIX = 2048;
constexpr float RMS_EPS = 1e-6f;
constexpr int COL_B = 0, COL_CX = 1024, COL_XL = 2048;
constexpr size_t MiB = 1u << 20;
constexpr size_t WS_CTL = 0, CTL_BYTES = 131072;
constexpr size_t WS_WIN = 2 * MiB;
constexpr size_t WS_WOUT = 14 * MiB;
constexpr size_t WS_WG = 18 * MiB;
constexpr size_t WS_SS = 20 * MiB;
constexpr size_t WS_AGG = 22 * MiB;
constexpr size_t WS_XN = 32 * MiB;
constexpr size_t WS_PROJ = 96 * MiB;
constexpr int LDPA = 3072, LDPG = 2048;
constexpr size_t WS_PROJG = WS_PROJ + (size_t)T_TOK * LDPA * 2;
constexpr size_t WS_END = WS_PROJG + (size_t)T_TOK * LDPG * 2;
static_assert(WS_END <= 480 * MiB, "ws");
constexpr int LDS_BYTES = 147456;
constexpr int NTHREADS = 512;
#ifndef REP0
#define REP0 1
#endif
#ifndef REP1
#define REP1 1
#endif
#ifndef REP3
#define REP3 1
#endif
#ifndef CONV_R
#define CONV_R 8
#endif
#ifndef PG8_SP2
#define PG8_SP2 1
#endif
#ifndef PG8_ALIGN
#define PG8_ALIGN 1
#endif
#ifndef SKEW1
#define SKEW1 0
#endif
#ifndef SKEW3
#define SKEW3 0
#endif
#ifndef GL_EARLY
#define GL_EARLY 1
#endif
#ifndef REPLRU
#define REPLRU 1
#endif
#ifndef REPCONV
#define REPCONV 1
#endif

struct Args { const float* in[15]; float* out; unsigned char* ws; };
enum { I_X = 0, I_LNG, I_WIN, I_CONVW, I_LCW, I_LCB, I_WA, I_BA, I_WI, I_BI, I_LAM, I_CG, I_LG, I_WOUT, I_FG };

__device__ __forceinline__ unsigned cvt_pk_bf16(float lo, float hi) { unsigned r; asm volatile("v_cvt_pk_bf16_f32 %0, %1, %2" : "=v"(r) : "v"(lo), "v"(hi)); return r; }
__device__ __forceinline__ float bf_lo(unsigned w) { return __uint_as_float(w << 16); }
__device__ __forceinline__ float bf_hi(unsigned w) { return __uint_as_float(w & 0xffff0000u); }
__device__ __forceinline__ float wave_sum(float v) {
#pragma unroll
    for (int o = 1; o < 64; o <<= 1) v += __shfl_xor(v, o);
    return v;
}
__device__ __forceinline__ float sigmoid_fast(float x) { return __builtin_amdgcn_rcpf(1.0f + __builtin_amdgcn_exp2f(-1.44269504f * x)); }
__device__ __forceinline__ void unpack8(const u32x4 v, float (&f)[8]) {
    f[0] = bf_lo(v.x); f[1] = bf_hi(v.x); f[2] = bf_lo(v.y); f[3] = bf_hi(v.y); f[4] = bf_lo(v.z); f[5] = bf_hi(v.z); f[6] = bf_lo(v.w); f[7] = bf_hi(v.w);
}


#define XB_TMO      128
#define XB_XCNT(j)  (256  + 64 * (j))
#define XB_XSUB(j)  (1280 + 64 * (j))
#define XB_XGEN(j)  (2304 + 64 * (j))
#define XB_TOP      3328
#define XB_TOPGEN   3392
#define XCD_BAR_WORDS 3456
#define XB_SPIN_CAP (1u << 20)
__device__ __forceinline__ unsigned xb_ld(unsigned* p)              { return __hip_atomic_load(p, __ATOMIC_RELAXED, __HIP_MEMORY_SCOPE_AGENT); }
__device__ __forceinline__ unsigned xb_add(unsigned* p, unsigned v) { return __hip_atomic_fetch_add(p, v, __ATOMIC_RELAXED, __HIP_MEMORY_SCOPE_AGENT); }
__device__ __forceinline__ unsigned xb_xcc_id() { return (unsigned)__builtin_amdgcn_s_getreg((3 << 11) | 20) & 0xFu; }
#define XB_SPIN(cond, bar) do { unsigned _sp = 0; while (cond) { __builtin_amdgcn_s_sleep(1); \
    if ((++_sp & 255u) == 0u) { if (xb_ld(&(bar)[XB_TMO])) break; if (_sp > XB_SPIN_CAP) { atomicAdd(&(bar)[XB_TMO], 1u); break; } } } } while (0)
struct XcdBarrier { unsigned* bar; unsigned x; volatile LAS unsigned* st; };
__device__ __forceinline__ XcdBarrier xcd_barrier_post(unsigned* bar, volatile LAS unsigned* st) {
    XcdBarrier b; b.bar = bar; b.x = xb_xcc_id(); b.st = st;
    if (threadIdx.x == 0) (void)xb_add(&bar[XB_XCNT(b.x)], 1u);
    return b;
}
__device__ __forceinline__ void xcd_barrier_complete(unsigned* bar, unsigned x, unsigned& nloc, unsigned& nx) {
    const unsigned G = gridDim.x * gridDim.y * gridDim.z;
    unsigned sum, cnt, mine, sp = 0u;
    for (;;) {
        sum = 0u; cnt = 0u; mine = 0u;
#pragma unroll
        for (unsigned j = 0; j < 16; ++j) { const unsigned c = xb_ld(&bar[XB_XCNT(j)]); sum += c; cnt += (c > 0u) ? 1u : 0u; mine = (j == x) ? c : mine; }
        if (sum == G) break;
        __builtin_amdgcn_s_sleep(1);
        if ((++sp & 255u) == 0u) { if (xb_ld(&bar[XB_TMO])) break; if (sp > XB_SPIN_CAP) { atomicAdd(&bar[XB_TMO], 1u); break; } }
    }
    nloc = mine > 0u ? mine : 1u; nx = cnt > 0u ? cnt : 1u;
}
__device__ __forceinline__ void xcd_barrier(const XcdBarrier& b) {
    asm volatile("s_waitcnt vmcnt(0)" ::: "memory");
    __syncthreads();
    if (threadIdx.x == 0) {
        unsigned* bar = b.bar;
        __builtin_amdgcn_s_waitcnt(0);
        unsigned nloc = b.st[0], nx = b.st[1];
        if (nloc == 0u) { xcd_barrier_complete(bar, b.x, nloc, nx); b.st[0] = nloc; b.st[1] = nx; }
        const unsigned old = xb_add(&bar[XB_XSUB(b.x)], 1u);
        const unsigned gen = old / nloc;
        if (old + 1u == (gen + 1u) * nloc) {
            __builtin_amdgcn_fence(__ATOMIC_RELEASE, "agent");
            asm volatile("s_waitcnt vmcnt(0)" ::: "memory");
            const unsigned og = xb_add(&bar[XB_TOP], 1u);
            const unsigned tg = og / nx;
            if (og + 1u == (tg + 1u) * nx) xb_add(&bar[XB_TOPGEN], 1u);
            else XB_SPIN(xb_ld(&bar[XB_TOPGEN]) == tg, bar);
            __builtin_amdgcn_fence(__ATOMIC_ACQUIRE, "agent");
            xb_add(&bar[XB_XGEN(b.x)], 1u);
            asm volatile("s_waitcnt vmcnt(0)" ::: "memory");
        } else {
            XB_SPIN(xb_ld(&bar[XB_XGEN(b.x)]) == gen, bar);
            __builtin_amdgcn_fence(__ATOMIC_ACQUIRE, "agent");
            asm volatile("s_waitcnt vmcnt(0)" ::: "memory");
        }
    }
    __syncthreads();
}

namespace pg8 {
constexpr int BM = 256, BK = 64, HALF = 128, HTB = HALF * BK * 2, STAGE_BYTES = 8 * HTB, NXCD = 8, WGM = 8;
__host__ __device__ __forceinline__ int lds_byte(int r, int c) { const int st = (r >> 4) * 2 + (c >> 5), rr = r & 15, cc = c & 31, ob = rr * 64 + cc * 2; return st * 1024 + (ob ^ (((ob >> 9) & 1) << 5)); }
__host__ __device__ __forceinline__ void stage_rc(int b, int& R, int& C) { const int st = b / 1024, sb = b % 1024, swz = sb ^ (((sb >> 9) & 1) << 5); R = (st >> 1) * 16 + swz / 64; C = (st & 1) * 32 + (swz % 64) / 2; }
__host__ __device__ __forceinline__ int perm32(int rho) { const int n = rho >> 4, i = rho & 15; return 8 * (i >> 2) + 4 * n + (i & 3); }

struct Unit { int pm, pn; };
struct Gemm { const bf16_t* A; const bf16_t* Bt; int M, N, K, lda; int skew; };

struct StaticOrder {
    int nM, nN, nwg, G, c;
    __device__ void init(int M, int N, int G_, int c_) { nM = M / BM; nN = N / BM; nwg = nM * nN; G = G_; c = c_; }
    __device__ bool next(int i, Unit& u) const {
        const long L = (long)i * G + c; if (L >= nwg) return false;
        int wgid = (int)L; { const int q = nwg / NXCD, r = nwg % NXCD, xcd = wgid % NXCD, off = wgid / NXCD; wgid = (xcd < r ? xcd * (q + 1) : r * (q + 1) + (xcd - r) * q) + off; }
        const int nig = WGM * nN, gid = wgid / nig, fm = gid * WGM, gsz = (nM - fm) < WGM ? (nM - fm) : WGM;
        u.pm = fm + ((wgid % nig) % gsz); u.pn = (wgid % nig) / gsz; return true;
    }
};

struct EpiBf16 {
    static constexpr bool PERM = true;
    bf16_t* O; int ldc; bf16_t* O2; int ldc2;
    __device__ __forceinline__ void init(f32x4 (&acc)[2][2][4][2], const Unit&, int, int, int, int) const {
#pragma unroll
        for (int a = 0; a < 2; ++a)
#pragma unroll
            for (int b = 0; b < 2; ++b)
#pragma unroll
                for (int m = 0; m < 4; ++m)
#pragma unroll
                    for (int n = 0; n < 2; ++n) acc[a][b][m][n] = (f32x4){0.f, 0.f, 0.f, 0.f};
    }
    __device__ __forceinline__ void operator()(f32x4 (&acc)[2][2][4][2], const Unit& u, int wr, int wc, int fr, int fq) const {
        const int row0 = u.pm * BM + wr * 64 + fr; const int pn = u.pn;
        if (pn >= 4 && pn < 12) {
            const int colb = 1024 + 128 * (pn - 4) + 16 * wc + 4 * fq;
#pragma unroll
            for (int ai = 0; ai < 2; ++ai)
#pragma unroll
                for (int m = 0; m < 4; ++m) { bf16_t* rowp = O + (size_t)(row0 + ai * HALF + m * 16) * ldc + colb;
#pragma unroll
                    for (int bj = 0; bj < 2; ++bj) { const f32x4 p = acc[ai][bj][m][0] * acc[ai][bj][m][1];
                        u32x2 w; w.x = cvt_pk_bf16(p[0], p[1]); w.y = cvt_pk_bf16(p[2], p[3]);
                        *(u32x2*)(rowp + bj * 64) = w; } }
        } else {
            const bool second = pn >= 16;
            const int col0 = (second ? (pn - 16) * BM : (pn >= 12 ? 2048 + (pn - 12) * BM : pn * BM)) + wc * 32 + 8 * fq;
            bf16_t* Ob = second ? O2 : O; const int ld = second ? ldc2 : ldc;
#pragma unroll
            for (int ai = 0; ai < 2; ++ai)
#pragma unroll
                for (int m = 0; m < 4; ++m) { bf16_t* rowp = Ob + (size_t)(row0 + ai * HALF + m * 16) * ld + col0;
#pragma unroll
                    for (int bj = 0; bj < 2; ++bj) { f32x4 v0 = acc[ai][bj][m][0], v1 = acc[ai][bj][m][1];
                        if (second) {
#pragma unroll
                            for (int i = 0; i < 4; ++i) { v0[i] = v0[i] * sigmoid_fast(v0[i]); v1[i] = v1[i] * sigmoid_fast(v1[i]); } }
                        u32x4 w; w.x = cvt_pk_bf16(v0[0], v0[1]); w.y = cvt_pk_bf16(v0[2], v0[3]); w.z = cvt_pk_bf16(v1[0], v1[1]); w.w = cvt_pk_bf16(v1[2], v1[3]);
                        *(u32x4*)(rowp + bj * HALF) = w; } }
        }
    }
};
struct EpiResidNorm {
    static constexpr bool PERM = false;
    const float* x; float* out; unsigned* ss; unsigned* cnt; const float* fg;
    __device__ __forceinline__ void init(f32x4 (&acc)[2][2][4][2], const Unit& u, int wr, int wc, int fr, int fq) const {
        const int row0 = u.pm * BM + wr * 64 + fr, col0 = u.pn * BM + wc * 32 + 4 * fq;
#pragma unroll
        for (int ai = 0; ai < 2; ++ai)
#pragma unroll
            for (int m = 0; m < 4; ++m) { const size_t off = (size_t)(row0 + ai * HALF + m * 16) * DM + col0;
#pragma unroll
                for (int bj = 0; bj < 2; ++bj)
#pragma unroll
                    for (int n = 0; n < 2; ++n) acc[ai][bj][m][n] = *(const f32x4*)(x + off + bj * HALF + n * 16); }
    }
    __device__ __forceinline__ void operator()(f32x4 (&acc)[2][2][4][2], const Unit& u, int wr, int wc, int fr, int fq) const {
        const int row0 = u.pm * BM + wr * 64 + fr, col0 = u.pn * BM + wc * 32 + 4 * fq;
#pragma unroll
        for (int ai = 0; ai < 2; ++ai)
#pragma unroll
            for (int m = 0; m < 4; ++m) { const int row = row0 + ai * HALF + m * 16; const size_t off = (size_t)row * DM + col0; float s = 0.f;
#pragma unroll
                for (int bj = 0; bj < 2; ++bj)
#pragma unroll
                    for (int n = 0; n < 2; ++n) { const f32x4 o = acc[ai][bj][m][n]; s += (o[0] * o[0] + o[1] * o[1]) + (o[2] * o[2] + o[3] * o[3]); }
                s += __shfl_xor(s, 16); s += __shfl_xor(s, 32);
                if (fq == 0) __hip_atomic_store(ss + (size_t)row * 16 + u.pn * 4 + wc, __float_as_uint(s), __ATOMIC_RELAXED, __HIP_MEMORY_SCOPE_AGENT); }
        asm volatile("s_waitcnt vmcnt(0)" ::: "memory");
        unsigned* c = cnt + (u.pm * 2 + wr) * 32;
        if ((threadIdx.x & 63) == 0) __hip_atomic_fetch_add(c, 1u, __ATOMIC_RELAXED, __HIP_MEMORY_SCOPE_AGENT);
        { unsigned spins = 0;
          while ((unsigned)__builtin_amdgcn_readfirstlane(__hip_atomic_load(c, __ATOMIC_RELAXED, __HIP_MEMORY_SCOPE_AGENT)) < 16u) { __builtin_amdgcn_s_sleep(2); if (++spins > (1u << 22)) break; } }
        asm volatile("" ::: "memory");
#pragma unroll
        for (int ai = 0; ai < 2; ++ai)
#pragma unroll
            for (int m = 0; m < 4; ++m) { const int row = row0 + ai * HALF + m * 16; const size_t off = (size_t)row * DM + col0;
                const unsigned long long* sp = (const unsigned long long*)(ss + (size_t)row * 16 + fq * 4);
                const unsigned long long p0 = __hip_atomic_load(sp, __ATOMIC_RELAXED, __HIP_MEMORY_SCOPE_AGENT), p1 = __hip_atomic_load(sp + 1, __ATOMIC_RELAXED, __HIP_MEMORY_SCOPE_AGENT);
                float t = (__uint_as_float((unsigned)p0) + __uint_as_float((unsigned)(p0 >> 32))) + (__uint_as_float((unsigned)p1) + __uint_as_float((unsigned)(p1 >> 32)));
                t += __shfl_xor(t, 16); t += __shfl_xor(t, 32);
                const float rstd = 1.0f / sqrtf(t * (1.f / DM) + RMS_EPS);
#pragma unroll
                for (int bj = 0; bj < 2; ++bj)
#pragma unroll
                    for (int n = 0; n < 2; ++n) { const f32x4 gv = *(const f32x4*)(fg + col0 + bj * HALF + n * 16);
                        *(f32x4*)(out + off + bj * HALF + n * 16) = acc[ai][bj][m][n] * rstd * gv; } }
    }
};

template <class Epi>
__device__ __forceinline__ void gemm_phase(LAS unsigned char* lds, const Gemm g, const StaticOrder& S, const Epi& E) {
    const int tid = threadIdx.x, wid = __builtin_amdgcn_readfirstlane(tid >> 6), lane = tid & 63, wr = wid >> 2, wc = wid & 3, fr = lane & 15, fq = lane >> 4;
    const int K = g.K, nt = K / BK, lda = g.lda;
    unsigned voffA[2], voffB[2];
#pragma unroll
    for (int i = 0; i < 2; ++i) { int R, C; stage_rc(tid * 16 + i * 8192, R, C); const int Rb = Epi::PERM ? ((R & ~31) + perm32(R & 31)) : R;
        voffA[i] = (unsigned)(R * lda + C) * 2u; voffB[i] = (unsigned)(Rb * K + C) * 2u; }
    const size_t kstep = (size_t)(BK * 2);
    const size_t hstepA = (size_t)HALF * lda * 2, hstepB = (size_t)HALF * K * 2;
    const size_t tstepA = 2 * hstepA, tstepB = 2 * hstepB;
    const unsigned ldsw = (unsigned)wid * 1024u;
    const int aoff = lds_byte(wr * 64 + fr, fq * 8), boff = lds_byte(wc * 32 + fr, fq * 8);
#define PG8_SA(b, h) (((b) * 2 + (h)) * HTB)
#define PG8_SB(b, h) ((4 + (b) * 2 + (h)) * HTB)
#define PG8_STAGE(bufoff, gbase, voff) do { _Pragma("unroll") for (int _i = 0; _i < 2; ++_i) \
        __builtin_amdgcn_global_load_lds((const unsigned*)((const char*)(gbase) + (voff)[_i]), (LAS unsigned*)(lds + (bufoff) + ldsw + _i * 8192), 16, 0, 0); } while (0)
#define PG8_LDA(dst, b, h) do { _Pragma("unroll") for (int m = 0; m < 4; ++m) _Pragma("unroll") for (int k = 0; k < 2; ++k) dst[m][k] = *(const LAS bf16x8*)(lds + PG8_SA(b, h) + aoff + m * 2048 + k * 1024); } while (0)
#define PG8_LDB(dst, b, h) do { _Pragma("unroll") for (int n = 0; n < 2; ++n) _Pragma("unroll") for (int k = 0; k < 2; ++k) dst[n][k] = *(const LAS bf16x8*)(lds + PG8_SB(b, h) + boff + n * 2048 + k * 1024); } while (0)
#define PG8_MMA(ai, bj, At, Bt) do { __builtin_amdgcn_s_setprio(1); _Pragma("unroll") for (int m = 0; m < 4; ++m) _Pragma("unroll") for (int n = 0; n < 2; ++n) _Pragma("unroll") for (int k = 0; k < 2; ++k) \
        acc[ai][bj][m][n] = __builtin_amdgcn_mfma_f32_16x16x32_bf16(Bt[n][k], At[m][k], acc[ai][bj][m][n], 0, 0, 0); __builtin_amdgcn_s_setprio(0); } while (0)
#define PG8_WAIT_V(n) asm volatile("s_waitcnt vmcnt(" #n ")" ::: "memory")
#define PG8_WAIT_L(n) asm volatile("s_waitcnt lgkmcnt(" #n ")" ::: "memory")
#define PG8_BAR __builtin_amdgcn_s_barrier()
#define PG8_SCHED __builtin_amdgcn_sched_barrier(0)
    Unit cur, nxt; int ui = 0;
    if (!S.next(0, cur)) return;
    if (g.skew > 0) { const unsigned long long t0 = __builtin_amdgcn_s_memrealtime(), dt = (unsigned long long)((blockIdx.x & 7u) * (unsigned)g.skew);
        while (__builtin_amdgcn_s_memrealtime() - t0 < dt) __builtin_amdgcn_s_sleep(8); }
    f32x4 acc[2][2][4][2];
    E.init(acc, cur, wr, wc, fr, fq);
    bf16x8 At[4][2], B0[2][2], B1[2][2];
    const char* cA = (const char*)g.A + (size_t)cur.pm * tstepA; const char* cB = (const char*)g.Bt + (size_t)cur.pn * tstepB;
#if PG8_SP2
    PG8_STAGE(PG8_SB(0, 0), cB, voffB); PG8_STAGE(PG8_SB(0, 1), cB + hstepB, voffB); PG8_STAGE(PG8_SA(0, 0), cA, voffA); PG8_STAGE(PG8_SA(0, 1), cA + hstepA, voffA);
    if (wr == 1) PG8_BAR;
    PG8_WAIT_V(2); PG8_BAR;
    PG8_STAGE(PG8_SB(1, 0), cB + kstep, voffB); PG8_STAGE(PG8_SA(1, 0), cA + kstep, voffA); PG8_STAGE(PG8_SB(1, 1), cB + hstepB + kstep, voffB);
    PG8_WAIT_V(6); PG8_BAR;
#else
    PG8_STAGE(PG8_SB(0, 0), cB, voffB); PG8_STAGE(PG8_SA(0, 0), cA, voffA); PG8_STAGE(PG8_SB(0, 1), cB + hstepB, voffB); PG8_STAGE(PG8_SA(0, 1), cA + hstepA, voffA);
    if (wr == 1) PG8_BAR;
    PG8_WAIT_V(4); PG8_BAR;
    PG8_STAGE(PG8_SB(1, 0), cB + kstep, voffB); PG8_STAGE(PG8_SA(1, 0), cA + kstep, voffA); PG8_STAGE(PG8_SB(1, 1), cB + hstepB + kstep, voffB);
    PG8_WAIT_V(6); PG8_BAR;
#endif
    for (;;) {
        const bool has_next = S.next(ui + 1, nxt);
        const char* nA = has_next ? (const char*)g.A + (size_t)nxt.pm * tstepA : cA; const char* nB = has_next ? (const char*)g.Bt + (size_t)nxt.pn * tstepB : cB;
        for (int t = 0; t < nt; t += 2) {
            const bool last = (t == nt - 2);
            const char* a1 = cA + (size_t)(t + 1) * kstep;
            const char* a2 = last ? nA : cA + (size_t)(t + 2) * kstep; const char* b2 = last ? nB : cB + (size_t)(t + 2) * kstep;
            const char* a3 = a2 + kstep; const char* b3 = b2 + kstep;
#if PG8_SP2
            PG8_LDB(B0, 0, 0); PG8_LDB(B1, 0, 1); PG8_SCHED; PG8_LDA(At, 0, 0); PG8_STAGE(PG8_SA(1, 1), a1 + hstepA, voffA);
            PG8_WAIT_V(8); PG8_WAIT_L(0); PG8_BAR; PG8_MMA(0, 0, At, B0); PG8_MMA(0, 1, At, B1); PG8_BAR; PG8_SCHED;
            PG8_LDA(At, 0, 1); PG8_STAGE(PG8_SB(0, 0), b2, voffB); PG8_STAGE(PG8_SB(0, 1), b2 + hstepB, voffB); PG8_STAGE(PG8_SA(0, 0), a2, voffA);
            PG8_WAIT_V(8); PG8_WAIT_L(0); PG8_BAR; PG8_MMA(1, 0, At, B0); PG8_MMA(1, 1, At, B1); PG8_BAR; PG8_SCHED;
            PG8_LDB(B0, 1, 0); PG8_LDB(B1, 1, 1); PG8_SCHED; PG8_LDA(At, 1, 0); PG8_STAGE(PG8_SA(0, 1), a2 + hstepA, voffA);
            PG8_WAIT_V(8); PG8_WAIT_L(0); PG8_BAR; PG8_MMA(0, 0, At, B0); PG8_MMA(0, 1, At, B1); PG8_BAR; PG8_SCHED;
            PG8_LDA(At, 1, 1); PG8_STAGE(PG8_SB(1, 0), b3, voffB); PG8_STAGE(PG8_SB(1, 1), b3 + hstepB, voffB); PG8_STAGE(PG8_SA(1, 0), a3, voffA);
            PG8_WAIT_V(8); PG8_WAIT_L(0); PG8_BAR; PG8_MMA(1, 0, At, B0); PG8_MMA(1, 1, At, B1); PG8_BAR; PG8_SCHED;
#else
            PG8_LDB(B0, 0, 0); PG8_SCHED; PG8_LDA(At, 0, 0); PG8_STAGE(PG8_SA(1, 1), a1 + hstepA, voffA);
            PG8_WAIT_L(8); PG8_BAR; PG8_WAIT_L(0); PG8_MMA(0, 0, At, B0); PG8_BAR; PG8_SCHED;
            PG8_LDB(B1, 0, 1); PG8_STAGE(PG8_SB(0, 0), b2, voffB);
            PG8_BAR; PG8_WAIT_L(0); PG8_MMA(0, 1, At, B1); PG8_BAR;
            PG8_LDA(At, 0, 1); PG8_STAGE(PG8_SA(0, 0), a2, voffA);
            PG8_BAR; PG8_WAIT_L(0); PG8_MMA(1, 0, At, B0); PG8_BAR; PG8_SCHED;
            PG8_STAGE(PG8_SB(0, 1), b2 + hstepB, voffB);
            PG8_WAIT_V(6); PG8_BAR; PG8_MMA(1, 1, At, B1); PG8_BAR;
            PG8_LDB(B0, 1, 0); PG8_SCHED; PG8_LDA(At, 1, 0); PG8_STAGE(PG8_SA(0, 1), a2 + hstepA, voffA);
            PG8_WAIT_L(8); PG8_BAR; PG8_WAIT_L(0); PG8_MMA(0, 0, At, B0); PG8_BAR; PG8_SCHED;
            PG8_LDB(B1, 1, 1); PG8_STAGE(PG8_SB(1, 0), b3, voffB);
            PG8_BAR; PG8_WAIT_L(0); PG8_MMA(0, 1, At, B1); PG8_BAR;
            PG8_LDA(At, 1, 1); PG8_STAGE(PG8_SA(1, 0), a3, voffA);
            PG8_BAR; PG8_WAIT_L(0); PG8_MMA(1, 0, At, B0); PG8_BAR; PG8_SCHED;
            PG8_STAGE(PG8_SB(1, 1), b3 + hstepB, voffB);
            PG8_WAIT_V(6); PG8_BAR; PG8_MMA(1, 1, At, B1); PG8_BAR;
#endif
        }
#if PG8_ALIGN
        if (wr == 0) PG8_BAR;
#endif
        E(acc, cur, wr, wc, fr, fq);
        if (!has_next) break;
        cur = nxt; cA = nA; cB = nB; ++ui;
        E.init(acc, cur, wr, wc, fr, fq);
#if PG8_ALIGN
        if (wr == 1) PG8_BAR;
#endif
    }
    PG8_WAIT_V(0);
#if !PG8_ALIGN
    if (wr == 0) PG8_BAR;
#endif
    PG8_BAR;
#undef PG8_SA
#undef PG8_SB
#undef PG8_STAGE
#undef PG8_LDA
#undef PG8_LDB
#undef PG8_MMA
#undef PG8_WAIT_V
#undef PG8_WAIT_L
#undef PG8_BAR
#undef PG8_SCHED
}
}

__device__ __forceinline__ void p0_transpose_item(const float* W, int ldw, int k0, int ncol0, bf16_t* WT, int ldt, int drow0, int dk0, LAS float* scr, int lane, int mode = 0) {
#pragma unroll 8
    for (int i = 0; i < 32; ++i) { const int kk = 2 * i + (lane >> 5); scr[kk * 33 + (lane & 31)] = W[(size_t)(k0 + kk) * ldw + ncol0 + (lane & 31)]; }
    asm volatile("s_waitcnt lgkmcnt(0)" ::: "memory");
    const int c = lane & 7;
#pragma unroll
    for (int j = 0; j < 4; ++j) { const int n = (lane >> 3) + 8 * j; const LAS float* s = scr + (8 * c) * 33 + n;
        u32x4 o; o.x = cvt_pk_bf16(s[0 * 33], s[1 * 33]); o.y = cvt_pk_bf16(s[2 * 33], s[3 * 33]); o.z = cvt_pk_bf16(s[4 * 33], s[5 * 33]); o.w = cvt_pk_bf16(s[6 * 33], s[7 * 33]);
        int drow = drow0 + n;
        if (mode) { const int ch = drow0 + n; drow = 1024 + 256 * (ch >> 7) + 128 * ((ch >> 6) & 1) + 32 * ((ch >> 4) & 3) + 8 * ((ch >> 2) & 3) + 4 * (mode - 1) + (ch & 3); }
        *(u32x4*)(WT + (size_t)drow * ldt + dk0 + 8 * c) = o; }
    asm volatile("s_waitcnt lgkmcnt(0)" ::: "memory");
}

__device__ __forceinline__ void phase0(const Args& a, LAS unsigned char* lds, int wave, int lane) {
    LAS float* scr = (LAS float*)(lds + wave * 16384);
    const int gw = blockIdx.x * 8 + wave, NGW = gridDim.x * 8;
    bf16_t* win_t = (bf16_t*)(a.ws + WS_WIN); bf16_t* wout_t = (bf16_t*)(a.ws + WS_WOUT); bf16_t* wg = (bf16_t*)(a.ws + WS_WG);
    constexpr int I_IN = 16 * 192, I_OUT = 32 * 32, I_G = 64;
    for (int it = gw; it < I_IN + I_OUT + I_G; it += NGW) {
        int r = it;
        if (r < I_IN) { const int kb = r / 192, nb = r % 192; const int og = nb / 32;
            if (og == 1 || og == 2) p0_transpose_item(a.in[I_WIN], NPROJ, kb * 64, nb * 32, win_t, DM, (nb % 32) * 32, kb * 64, scr, lane, og);
            else { const int nbase = (og == 0) ? 0 : (og == 4 ? 3072 : (og == 3 ? 4096 : 5120));
                p0_transpose_item(a.in[I_WIN], NPROJ, kb * 64, nb * 32, win_t, DM, nbase + (nb % 32) * 32, kb * 64, scr, lane, 0); }
            continue; }
        r -= I_IN;
        if (r < I_OUT) { const int kb = r / 32, nb = r % 32; p0_transpose_item(a.in[I_WOUT], DM, kb * 64, nb * 32, wout_t, DMIX, nb * 32, kb * 64, scr, lane); continue; }
        r -= I_OUT;
        { const int mat = r / 32, h = (r % 32) / 2, nb = r & 1; const float* W = (mat ? a.in[I_WI] : a.in[I_WA]) + h * 4096;
          p0_transpose_item(W, 64, 0, nb * 32, wg + mat * 65536 + h * 4096, 64, nb * 32, 0, scr, lane); }
    }
    const float* x = a.in[I_X]; bf16_t* xn = (bf16_t*)(a.ws + WS_XN);
    f32x4 gv[4];
#pragma unroll
    for (int j = 0; j < 4; ++j) gv[j] = ((const f32x4*)a.in[I_LNG])[lane + 64 * j];
    for (int m = gw; m < T_TOK; m += NGW) {
        const f32x4* xr = (const f32x4*)(x + (size_t)m * DM) + lane;
        f32x4 v[4]; float s = 0.f;
#pragma unroll
        for (int j = 0; j < 4; ++j) { v[j] = xr[64 * j]; s += (v[j].x * v[j].x + v[j].y * v[j].y) + (v[j].z * v[j].z + v[j].w * v[j].w); }
        const float rstd = 1.0f / sqrtf(wave_sum(s) * (1.f / DM) + RMS_EPS);
        u32x2* o8 = (u32x2*)(xn + (size_t)m * DM) + lane;
#pragma unroll
        for (int j = 0; j < 4; ++j) { u32x2 w; w.x = cvt_pk_bf16(v[j].x * rstd * gv[j].x, v[j].y * rstd * gv[j].y); w.y = cvt_pk_bf16(v[j].z * rstd * gv[j].z, v[j].w * rstd * gv[j].w); o8[64 * j] = w; }
    }
}

#define DPP_ADD(v, ctrl) ((v) + __uint_as_float(__builtin_amdgcn_update_dpp(0, __float_as_uint(v), (ctrl), 0xF, 0xF, false)))
__device__ __forceinline__ void conv_item(const Args& a, bf16_t* proj, bf16_t* projg, bf16_t* obase, int ostride, int item, int wave, int lane) {
    const int q = lane >> 4, c8 = lane & 15, ch0 = wave * 128 + c8 * 8;
    float w0[8], w1[8], w2[8], gn[8];
    { const float* cw = a.in[I_CONVW] + ch0; const float* cg_ = a.in[I_CG] + ch0;
#pragma unroll
      for (int j = 0; j < 8; ++j) { w0[j] = cw[j]; w1[j] = cw[1024 + j]; w2[j] = cw[2048 + j]; gn[j] = cg_[j]; } }
    const int tok0 = item * (4 * CONV_R) + q * CONV_R;
    bf16_t* base = proj + (size_t)tok0 * LDPA + ch0; const bf16_t* gbase = projg + (size_t)tok0 * LDPG + ch0;
    float p2[8], p1[8];
    if ((tok0 & (SEQ - 1)) == 0) {
#pragma unroll
        for (int j = 0; j < 8; ++j) { p2[j] = 0.f; p1[j] = 0.f; }
    } else {
        const u32x4 c2 = *(const u32x4*)(base - 2 * LDPA + COL_CX), c1 = *(const u32x4*)(base - 1 * LDPA + COL_CX);
        unpack8(c2, p2); unpack8(c1, p1);
    }
    u32x4 nb[2], nc[2], ng[2];
#pragma unroll
    for (int k = 0; k < 2; ++k) { const bf16_t* rp = base + (size_t)k * LDPA; nb[k] = __builtin_nontemporal_load((const u32x4*)(rp + COL_B)); nc[k] = __builtin_nontemporal_load((const u32x4*)(rp + COL_CX)); ng[k] = __builtin_nontemporal_load((const u32x4*)(gbase + (size_t)k * LDPG)); }
    for (int i = 0; i < CONV_R; i += 2) {
        u32x4 vb[2], vc[2], vg[2];
#pragma unroll
        for (int k = 0; k < 2; ++k) { vb[k] = nb[k]; vc[k] = nc[k]; vg[k] = ng[k]; }
        if (i + 2 < CONV_R) {
#pragma unroll
            for (int k = 0; k < 2; ++k) { const bf16_t* rp = base + (size_t)(i + 2 + k) * LDPA; nb[k] = __builtin_nontemporal_load((const u32x4*)(rp + COL_B)); nc[k] = __builtin_nontemporal_load((const u32x4*)(rp + COL_CX)); ng[k] = __builtin_nontemporal_load((const u32x4*)(gbase + (size_t)(i + 2 + k) * LDPG)); }
        }
#pragma unroll
        for (int k = 0; k < 2; ++k) {
            float fb[8], cx[8], fg[8], y[8];
            unpack8(vb[k], fb); unpack8(vc[k], cx); unpack8(vg[k], fg);
            float ss = 0.f;
#pragma unroll
            for (int j = 0; j < 8; ++j) { const float cv = w0[j] * p2[j] + w1[j] * p1[j] + w2[j] * cx[j]; y[j] = fb[j] * cv; ss += y[j] * y[j]; p2[j] = p1[j]; p1[j] = cx[j]; }
            ss = DPP_ADD(ss, 0xB1); ss = DPP_ADD(ss, 0x4E); ss = DPP_ADD(ss, 0x141); ss = DPP_ADD(ss, 0x140);
            const float rstd = __builtin_amdgcn_rsqf(ss * (1.f / 128.f) + RMS_EPS);
            float o[8];
#pragma unroll
            for (int j = 0; j < 8; ++j) o[j] = y[j] * rstd * gn[j] * fg[j];
            u32x4 w; w.x = cvt_pk_bf16(o[0], o[1]); w.y = cvt_pk_bf16(o[2], o[3]); w.z = cvt_pk_bf16(o[4], o[5]); w.w = cvt_pk_bf16(o[6], o[7]);
            *(u32x4*)(obase + (size_t)(tok0 + i + k) * ostride + ch0) = w;
        }
    }
}

constexpr int L_GW = 0;
constexpr int L_CW = 18432;
constexpr int L_AGG = 20992;
constexpr int L_WT = 29184;
constexpr int WT_BYTES = 8704;
static_assert(L_WT + 8 * WT_BYTES <= 131072, "lds");
typedef float f32x2 __attribute__((ext_vector_type(2)));

__device__ __forceinline__ void lru_item(const Args& a, bf16_t* proj, bf16_t* projg, bf16_t* obase, int ostride, LAS unsigned char* lds, int chain, int part, int nsplit, int tid, int wave, int lane) {
    const int b = chain >> 4, h = chain & 15;
    {
        const bf16_t* wg = (const bf16_t*)(a.ws + WS_WG);
        for (int i = tid; i < 1024; i += NTHREADS) { const int mat = i >> 9, e = (i >> 3) & 63, c = i & 7;
            const u32x4 v = *(const u32x4*)(wg + mat * 65536 + h * 4096 + e * 64 + c * 8);
            *(LAS u32x4*)(lds + L_GW + mat * 9216 + e * 144 + c * 16) = v; }
        LAS float* cw = (LAS float*)(lds + L_CW);
        if (tid < 256) cw[tid] = a.in[I_LCW][(tid >> 6) * 1024 + h * 64 + (tid & 63)];
        else if (tid < 320) { const int c = tid - 256, gc = h * 64 + c;
            cw[256 + c] = a.in[I_LCB][gc]; cw[320 + c] = a.in[I_BA][gc]; cw[384 + c] = a.in[I_BI][gc];
            const float lam = a.in[I_LAM][gc];
            const float logsig = (lam >= 0.f) ? -log1pf(expf(-lam)) : (lam - log1pf(expf(lam)));
            cw[448 + c] = 8.0f * logsig * 1.44269504f;
            cw[512 + c] = a.in[I_LG][gc]; }
    }
    __syncthreads();
    const int r = lane & 31, hh = lane >> 5;
    LAS unsigned char* wt = lds + L_WT + wave * WT_BYTES;
    LAS const float* cw = (LAS const float*)(lds + L_CW);
    bf16x8 I0, I1;
    {
        u32x4 t0 = (u32x4){0u, 0u, 0u, 0u}, t1 = t0;
        const int j0 = r - 8 * hh, j1 = r - 16 - 8 * hh;
#pragma unroll
        for (int d = 0; d < 4; ++d) {
            t0[d] = (j0 == 2 * d) ? 0x00003F80u : ((j0 == 2 * d + 1) ? 0x3F800000u : 0u);
            t1[d] = (j1 == 2 * d) ? 0x00003F80u : ((j1 == 2 * d + 1) ? 0x3F800000u : 0u);
        }
        I0 = __builtin_bit_cast(bf16x8, t0); I1 = __builtin_bit_cast(bf16x8, t1);
    }
    float ba[2], bi[2], cf[2];
#pragma unroll
    for (int n = 0; n < 2; ++n) { ba[n] = cw[320 + 32 * n + r]; bi[n] = cw[384 + 32 * n + r]; cf[n] = cw[448 + 32 * n + r]; }
    float carry[2] = {0.f, 0.f};
    unsigned* flags = (unsigned*)(a.ws + WS_CTL + 4096) + chain * 32;
    unsigned long long* aggg = (unsigned long long*)(a.ws + WS_AGG) + (size_t)chain * 16 * 64;

    const bf16_t* xl_base = proj + (size_t)b * SEQ * LDPA + COL_XL + h * 64;
    const bf16_t* gl_base = projg + (size_t)b * SEQ * LDPG + 1024 + h * 64;
    u32x4 xr[5];
#define LOAD_X(seg_) do { const int s0_ = (seg_) * 256 + wave * 32; _Pragma("unroll") for (int i = 0; i < 5; ++i) { const int idx = lane + 64 * i, row = idx >> 3, c = idx & 7; const int s = s0_ - 3 + row; \
        xr[i] = (u32x4){0u, 0u, 0u, 0u}; if (idx < 280 && s >= 0) xr[i] = __builtin_nontemporal_load((const u32x4*)(xl_base + (size_t)s * LDPA + c * 8)); } } while (0)
    LOAD_X(part);
    for (int seg = part; seg < 16; seg += nsplit) {
        const int s0 = seg * 256 + wave * 32;
#pragma unroll
        for (int i = 0; i < 5; ++i) { const int idx = lane + 64 * i, row = idx >> 3, c = idx & 7; if (idx < 280) *(LAS u32x4*)(wt + row * 144 + c * 16) = xr[i]; }
        if (seg + nsplit < 16) LOAD_X(seg + nsplit);
        u32x4 gl[4];
#define LOAD_GL() do { _Pragma("unroll") for (int i = 0; i < 4; ++i) { const int tok = (lane >> 3) + 8 * i, c = lane & 7; gl[i] = __builtin_nontemporal_load((const u32x4*)(gl_base + (size_t)(s0 + tok) * LDPG + c * 8)); } } while (0)
#if GL_EARLY
        LOAD_GL();
#endif
        asm volatile("s_waitcnt lgkmcnt(0)" ::: "memory");
        bf16x8 Af[4];
#pragma unroll
        for (int s = 0; s < 4; ++s) {
            const int c0 = 16 * s + 8 * hh;
            float u8[8];
            { const f32x4 b0 = *(LAS const f32x4*)(cw + 256 + c0), b1 = *(LAS const f32x4*)(cw + 256 + c0 + 4);
              u8[0] = b0[0]; u8[1] = b0[1]; u8[2] = b0[2]; u8[3] = b0[3]; u8[4] = b1[0]; u8[5] = b1[1]; u8[6] = b1[2]; u8[7] = b1[3]; }
#pragma unroll
            for (int k = 0; k < 4; ++k) {
                const u32x4 xv = *(LAS const u32x4*)(wt + (r + k) * 144 + c0 * 2);
                const f32x4 wv0 = *(LAS const f32x4*)(cw + k * 64 + c0), wv1 = *(LAS const f32x4*)(cw + k * 64 + c0 + 4);
                float fx[8]; unpack8(xv, fx);
                u8[0] += wv0[0] * fx[0]; u8[1] += wv0[1] * fx[1]; u8[2] += wv0[2] * fx[2]; u8[3] += wv0[3] * fx[3];
                u8[4] += wv1[0] * fx[4]; u8[5] += wv1[1] * fx[5]; u8[6] += wv1[2] * fx[6]; u8[7] += wv1[3] * fx[7];
            }
            u32x4 pk; pk.x = cvt_pk_bf16(u8[0], u8[1]); pk.y = cvt_pk_bf16(u8[2], u8[3]); pk.z = cvt_pk_bf16(u8[4], u8[5]); pk.w = cvt_pk_bf16(u8[6], u8[7]);
            Af[s] = __builtin_bit_cast(bf16x8, pk);
        }
#pragma unroll
        for (int n = 0; n < 2; ++n) {
            float hl[16], pc[16];
            f32x16 accR, accI, accU;
#pragma unroll
            for (int j = 0; j < 16; ++j) { accR[j] = 0.f; accI[j] = 0.f; accU[j] = 0.f; }
#pragma unroll
            for (int s = 0; s < 4; ++s) {
                const bf16x8 Ba = *(LAS const bf16x8*)(lds + L_GW + (32 * n + r) * 144 + (16 * s + 8 * hh) * 2);
                const bf16x8 Bi = *(LAS const bf16x8*)(lds + L_GW + 9216 + (32 * n + r) * 144 + (16 * s + 8 * hh) * 2);
                accR = __builtin_amdgcn_mfma_f32_32x32x16_bf16(Af[s], Ba, accR, 0, 0, 0);
                accI = __builtin_amdgcn_mfma_f32_32x32x16_bf16(Af[s], Bi, accI, 0, 0, 0);
            }
            accU = __builtin_amdgcn_mfma_f32_32x32x16_bf16(Af[2 * n], I0, accU, 0, 0, 0);
            accU = __builtin_amdgcn_mfma_f32_32x32x16_bf16(Af[2 * n + 1], I1, accU, 0, 0, 0);
            float gP[4], gH[4];
#pragma unroll
            for (int g = 0; g < 4; ++g) {
                float P = 1.f, H = 0.f;
#pragma unroll
                for (int i = 0; i < 4; ++i) { const int j = 4 * g + i;
                    const float rr = sigmoid_fast(accR[j] + ba[n]);
                    const float ii = sigmoid_fast(accI[j] + bi[n]);
                    const float l2 = rr * cf[n];
                    const float aa = __builtin_amdgcn_exp2f(l2);
                    const float t = l2 * 1.38629436f;
                    const float em_small = -t * (1.0f + t * (0.5f + t * (0.16666667f + t * 0.041666667f)));
                    const float one_m = (t > -0.0625f) ? em_small : (1.0f - aa * aa);
                    const float dd = __builtin_amdgcn_sqrtf(one_m) * ii * accU[j];
                    H = aa * H + dd; P = P * aa; hl[j] = H; pc[j] = P; }
                gP[g] = P; gH[g] = H;
            }
            float cp = 1.f, ch = 0.f;
#pragma unroll
            for (int g = 0; g < 4; ++g) {
                const auto sp = __builtin_amdgcn_permlane32_swap(__float_as_uint(gP[g]), __float_as_uint(gP[g]), false, false);
                const auto sh = __builtin_amdgcn_permlane32_swap(__float_as_uint(gH[g]), __float_as_uint(gH[g]), false, false);
                const float oP = __uint_as_float(hh ? sp[0] : sp[1]), oH = __uint_as_float(hh ? sh[0] : sh[1]);
                const float P = gP[g], H = gH[g];
                const float A1 = hh ? oP : P, H1 = hh ? oH : H, A2 = hh ? P : oP, H2 = hh ? H : oH;
                const float cp1 = cp * A1, ch1 = A1 * ch + H1;
                const float inP = hh ? cp1 : cp, inH = hh ? ch1 : ch;
#pragma unroll
                for (int i = 0; i < 4; ++i) { const int j = 4 * g + i; hl[j] += pc[j] * inH; pc[j] *= inP; }
                cp = cp1 * A2; ch = A2 * ch1 + H2;
            }
            if (hh == 0) *(LAS f32x2*)(lds + L_AGG + ((n * 8 + wave) * 64 + 32 * n + r) * 8) = (f32x2){cp, ch};
#if !GL_EARLY
            if (n == 1) LOAD_GL();
#endif
            if (nsplit > 1 && seg > 0 && wave == 0) {
                unsigned spins = 0;
                while (__builtin_amdgcn_readfirstlane(__hip_atomic_load(flags + (seg - 1) * 2 + n, __ATOMIC_RELAXED, __HIP_MEMORY_SCOPE_AGENT)) == 0u) { __builtin_amdgcn_s_sleep(2); if (++spins > (1u << 22)) break; }
                asm volatile("" ::: "memory");
            }
            __syncthreads();
            float c = carry[n];
            if (nsplit > 1 && seg > 0) {
                const unsigned long long pw = __hip_atomic_load(aggg + (size_t)(seg - 1) * 64 + n * 32 + r, __ATOMIC_RELAXED, __HIP_MEMORY_SCOPE_AGENT);
                c = __uint_as_float((unsigned)pw) * c + __uint_as_float((unsigned)(pw >> 32));
            }
            float cin = 0.f, iP = 1.f, iH = 0.f;
#pragma unroll
            for (int w = 0; w < 8; ++w) {
                const f32x2 ag = *(LAS const f32x2*)(lds + L_AGG + ((n * 8 + w) * 64 + 32 * n + r) * 8);
                cin = (w == wave) ? c : cin; c = ag.x * c + ag.y; iH = ag.x * iH + ag.y; iP *= ag.x; }
            carry[n] = c;
            if (nsplit > 1 && wave == 0) {
                if (hh == 0) __hip_atomic_store(aggg + (size_t)seg * 64 + n * 32 + r, ((unsigned long long)__float_as_uint(iH) << 32) | __float_as_uint(iP), __ATOMIC_RELAXED, __HIP_MEMORY_SCOPE_AGENT);
                asm volatile("s_waitcnt vmcnt(0)" ::: "memory");
                if (lane == 0) __hip_atomic_store(flags + seg * 2 + n, 1u, __ATOMIC_RELAXED, __HIP_MEMORY_SCOPE_AGENT);
            }
#pragma unroll
            for (int j = 0; j < 16; ++j) { const int row = (j & 3) + 8 * (j >> 2) + 4 * hh;
                *(LAS float*)(wt + row * 272 + (32 * n + r) * 4) = hl[j] + pc[j] * cin; }
        }
        asm volatile("s_waitcnt lgkmcnt(0)" ::: "memory");
#pragma unroll
        for (int i = 0; i < 4; ++i) {
            const int tok = (lane >> 3) + 8 * i, c = lane & 7;
            const f32x4 h0 = *(LAS const f32x4*)(wt + tok * 272 + c * 32), h1 = *(LAS const f32x4*)(wt + tok * 272 + c * 32 + 16);
            const f32x4 g0 = *(LAS const f32x4*)(cw + 512 + c * 8), g1 = *(LAS const f32x4*)(cw + 512 + c * 8 + 4);
            float ss = (h0[0] * h0[0] + h0[1] * h0[1]) + (h0[2] * h0[2] + h0[3] * h0[3]) + (h1[0] * h1[0] + h1[1] * h1[1]) + (h1[2] * h1[2] + h1[3] * h1[3]);
            ss = DPP_ADD(ss, 0xB1); ss = DPP_ADD(ss, 0x4E); ss = DPP_ADD(ss, 0x141);
            const float rstd = __builtin_amdgcn_rsqf(ss * (1.f / 64.f) + RMS_EPS);
            float fg[8]; unpack8(gl[i], fg);
            float o[8];
            o[0] = h0[0] * rstd * g0[0]; o[1] = h0[1] * rstd * g0[1]; o[2] = h0[2] * rstd * g0[2]; o[3] = h0[3] * rstd * g0[3];
            o[4] = h1[0] * rstd * g1[0]; o[5] = h1[1] * rstd * g1[1]; o[6] = h1[2] * rstd * g1[2]; o[7] = h1[3] * rstd * g1[3];
#pragma unroll
            for (int j = 0; j < 8; ++j) o[j] *= fg[j];
            u32x4 w; w.x = cvt_pk_bf16(o[0], o[1]); w.y = cvt_pk_bf16(o[2], o[3]); w.z = cvt_pk_bf16(o[4], o[5]); w.w = cvt_pk_bf16(o[6], o[7]);
            *(u32x4*)(obase + (size_t)(b * SEQ + s0 + tok) * ostride + h * 64 + c * 8) = w;
        }
        asm volatile("s_waitcnt lgkmcnt(0)" ::: "memory");
    }
#undef LOAD_X
    __syncthreads();
}

__global__ void __launch_bounds__(NTHREADS, 2) hymba_fwd(Args a) {
    extern __shared__ __attribute__((aligned(16))) unsigned char lds_raw[];
    LAS unsigned char* lds = (LAS unsigned char*)lds_raw;
    cg::grid_group grid = cg::this_grid();
    if (gridDim.y == 0x7fffu) grid.sync();
    volatile LAS unsigned* bst = (volatile LAS unsigned*)(lds + 131072 + 64);
    if (threadIdx.x == 0) { bst[0] = 0u; bst[1] = 0u; }
    __syncthreads();
    const XcdBarrier bar = xcd_barrier_post((unsigned*)(a.ws + WS_CTL + 32768), bst);
    const int tid = threadIdx.x, lane = tid & 63, wave = __builtin_amdgcn_readfirstlane(tid >> 6);
    bf16_t* proj = (bf16_t*)(a.ws + WS_PROJ); bf16_t* projg = (bf16_t*)(a.ws + WS_PROJG);

#pragma unroll
    for (int rep = 0; rep < REP0; ++rep) {
#ifndef SKIP_P0
    phase0(a, lds, wave, lane);
#endif

    xcd_barrier(bar); }
#pragma unroll
    for (int rep = 0; rep < REP1; ++rep) {
        pg8::Gemm g{(const bf16_t*)(a.ws + WS_XN), (const bf16_t*)(a.ws + WS_WIN), T_TOK, NPROJ, DM, DM, SKEW1};
        pg8::StaticOrder S; S.init(T_TOK, NPROJ, (int)gridDim.x, (int)blockIdx.x);
        pg8::EpiBf16 E{proj, LDPA, projg, LDPG};
#ifndef SKIP_G1
        pg8::gemm_phase<pg8::EpiBf16>(lds, g, S, E);
#endif
    xcd_barrier(bar); }
    {
#ifndef SKIP_LRU
        if (gridDim.x >= 256) { if (blockIdx.x < 256) lru_item(a, proj, projg, projg + 1024, LDPG, lds, (int)blockIdx.x >> 1, (int)blockIdx.x & 1, 2, tid, wave, lane); }
        else for (int it = blockIdx.x; it < 128; it += gridDim.x) lru_item(a, proj, projg, projg + 1024, LDPG, lds, it, 0, 1, tid, wave, lane);
#endif
        LAS unsigned* qs = (LAS unsigned*)(lds + 131072);
        unsigned* qctr = (unsigned*)(a.ws + WS_CTL);
        for (;;) {
            if (tid == 0) qs[0] = atomicAdd(qctr, 1u);
            __syncthreads();
            const unsigned it = qs[0];
            __syncthreads();
            if (it >= (unsigned)(T_TOK / (4 * CONV_R))) break;
#ifndef SKIP_CONV
            conv_item(a, proj, projg, projg, LDPG, (int)it, wave, lane);
#endif
        }
    }
    xcd_barrier(bar);
#pragma unroll
    for (int rep = 0; rep < REP3; ++rep) {
        pg8::Gemm g{projg, (const bf16_t*)(a.ws + WS_WOUT), T_TOK, DM, DMIX, LDPG, SKEW3};
        pg8::StaticOrder S; S.init(T_TOK, DM, (int)gridDim.x, (int)blockIdx.x);
        pg8::EpiResidNorm E{a.in[I_X], a.out, (unsigned*)(a.ws + WS_SS), (unsigned*)(a.ws + WS_CTL + 65536), a.in[I_FG]};
#ifndef SKIP_G2
        pg8::gemm_phase<pg8::EpiResidNorm>(lds, g, S, E);
#endif
    }
}

extern "C" void kernel_launch(void* const* d_in, const int* in_sizes, int n_in, void* d_out, int out_size, void* d_ws, size_t ws_size, hipStream_t stream) {
    static int grid = 0;
    if (grid == 0) {
        if (n_in != 15 || out_size != T_TOK * DM || ws_size < WS_END) { fprintf(stderr, "kernel_launch: unexpected shapes (n_in %d out %d ws %zu)\n", n_in, out_size, ws_size); grid = -1; return; }
        int dev = 0, cus = 0, per_cu = 0;
        hipGetDevice(&dev);
        hipDeviceGetAttribute(&cus, hipDeviceAttributeMultiprocessorCount, dev);
        if (hipFuncSetAttribute((const void*)hymba_fwd, hipFuncAttributeMaxDynamicSharedMemorySize, LDS_BYTES) != hipSuccess) { fprintf(stderr, "kernel_launch: hipFuncSetAttribute failed\n"); grid = -1; return; }
        if (hipOccupancyMaxActiveBlocksPerMultiprocessor(&per_cu, (const void*)hymba_fwd, NTHREADS, LDS_BYTES) != hipSuccess || per_cu < 1) { fprintf(stderr, "kernel_launch: occupancy query says %d\n", per_cu); per_cu = 1; }
        (void)hipGetLastError();
        grid = cus;
        if (grid != 256) { fprintf(stderr, "kernel_launch: built for a 256-CU device (got %d)\n", cus); grid = -1; return; }
    }
    if (grid < 0) return;
    hipMemsetAsync((char*)d_ws + WS_CTL, 0, CTL_BYTES, stream);
    Args a{};
    for (int i = 0; i < 15; ++i) a.in[i] = (const float*)d_in[i];
    a.out = (float*)d_out; a.ws = (unsigned char*)d_ws;
    void* args[] = {&a};
    hipError_t e = hipLaunchCooperativeKernel((const void*)hymba_fwd, dim3(grid), dim3(NTHREADS), args, LDS_BYTES, stream);
    if (e != hipSuccess) fprintf(stderr, "kernel_launch: cooperative launch failed: %s (grid %d)\n", hipGetErrorString(e), grid);
}
```

```cpp
#include <hip/hip_runtime.h>
#include <hip/hip_cooperative_groups.h>
#include <cstdio>
namespace cg = cooperative_groups;

#define LAS __attribute__((address_space(3)))
typedef unsigned short bf16_t;
typedef short bf16x8 __attribute__((ext_vector_type(8)));
typedef float f32x4 __attribute__((ext_vector_type(4)));
typedef float f32x16 __attribute__((ext_vector_type(16)));
typedef unsigned u32x4 __attribute__((ext_vector_type(4)));
typedef unsigned u32x2 __attribute__((ext_vector_type(2)));

constexpr int T_TOK = 32768, SEQ = 4096, DM = 1024, NPROJ = 6144, DMIX = 2048;
constexpr float RMS_EPS = 1e-6f;
constexpr int COL_B = 0, COL_CX = 1024, COL_XL = 2048;
constexpr size_t MiB = 1u << 20;
constexpr size_t WS_CTL = 0, CTL_BYTES = 131072;
constexpr size_t WS_WIN = 2 * MiB;
constexpr size_t WS_WOUT = 14 * MiB;
constexpr size_t WS_WG = 18 * MiB;
constexpr size_t WS_SS = 20 * MiB;
constexpr size_t WS_AGG = 22 * MiB;
constexpr size_t WS_XN = 32 * MiB;
constexpr size_t WS_PROJ = 96 * MiB;
constexpr int LDPA = 3072, LDPG = 2048;
constexpr size_t WS_PROJG = WS_PROJ + (size_t)T_TOK * LDPA * 2;
constexpr size_t WS_END = WS_PROJG + (size_t)T_TOK * LDPG * 2;
static_assert(WS_END <= 480 * MiB, "ws");
constexpr int LDS_BYTES = 147456;
constexpr int NTHREADS = 512;
#ifndef REP0
#define REP0 1
#endif
#ifndef REP1
#define REP1 1
#endif
#ifndef REP3
#define REP3 1
#endif
#ifndef CONV_R
#define CONV_R 8
#endif
#ifndef PG8_SP2
#define PG8_SP2 1
#endif
#ifndef PG8_ALIGN
#define PG8_ALIGN 1
#endif
#ifndef SKEW1
#define SKEW1 0
#endif
#ifndef SKEW3
#define SKEW3 0
#endif
#ifndef GL_EARLY
#define GL_EARLY 1
#endif
#ifndef REPLRU
#define REPLRU 1
#endif
#ifndef REPCONV
#define REPCONV 1
#endif

struct Args { const float* in[15]; float* out; unsigned char* ws; };
enum { I_X = 0, I_LNG, I_WIN, I_CONVW, I_LCW, I_LCB, I_WA, I_BA, I_WI, I_BI, I_LAM, I_CG, I_LG, I_WOUT, I_FG };

__device__ __forceinline__ unsigned cvt_pk_bf16(float lo, float hi) { unsigned r; asm volatile("v_cvt_pk_bf16_f32 %0, %1, %2" : "=v"(r) : "v"(lo), "v"(hi)); return r; }
__device__ __forceinline__ float bf_lo(unsigned w) { return __uint_as_float(w << 16); }
__device__ __forceinline__ float bf_hi(unsigned w) { return __uint_as_float(w & 0xffff0000u); }
__device__ __forceinline__ float wave_sum(float v) {
#pragma unroll
    for (int o = 1; o < 64; o <<= 1) v += __shfl_xor(v, o);
    return v;
}
__device__ __forceinline__ float sigmoid_fast(float x) { return __builtin_amdgcn_rcpf(1.0f + __builtin_amdgcn_exp2f(-1.44269504f * x)); }
__device__ __forceinline__ void unpack8(const u32x4 v, float (&f)[8]) {
    f[0] = bf_lo(v.x); f[1] = bf_hi(v.x); f[2] = bf_lo(v.y); f[3] = bf_hi(v.y); f[4] = bf_lo(v.z); f[5] = bf_hi(v.z); f[6] = bf_lo(v.w); f[7] = bf_hi(v.w);
}


#define XB_TMO      128
#define XB_XCNT(j)  (256  + 64 * (j))
#define XB_XSUB(j)  (1280 + 64 * (j))
#define XB_XGEN(j)  (2304 + 64 * (j))
#define XB_TOP      3328
#define XB_TOPGEN   3392
#define XCD_BAR_WORDS 3456
#define XB_SPIN_CAP (1u << 20)
__device__ __forceinline__ unsigned xb_ld(unsigned* p)              { return __hip_atomic_load(p, __ATOMIC_RELAXED, __HIP_MEMORY_SCOPE_AGENT); }
__device__ __forceinline__ unsigned xb_add(unsigned* p, unsigned v) { return __hip_atomic_fetch_add(p, v, __ATOMIC_RELAXED, __HIP_MEMORY_SCOPE_AGENT); }
__device__ __forceinline__ unsigned xb_xcc_id() { return (unsigned)__builtin_amdgcn_s_getreg((3 << 11) | 20) & 0xFu; }
#define XB_SPIN(cond, bar) do { unsigned _sp = 0; while (cond) { __builtin_amdgcn_s_sleep(1); \
    if ((++_sp & 255u) == 0u) { if (xb_ld(&(bar)[XB_TMO])) break; if (_sp > XB_SPIN_CAP) { atomicAdd(&(bar)[XB_TMO], 1u); break; } } } } while (0)
struct XcdBarrier { unsigned* bar; unsigned x; volatile LAS unsigned* st; };
__device__ __forceinline__ XcdBarrier xcd_barrier_post(unsigned* bar, volatile LAS unsigned* st) {
    XcdBarrier b; b.bar = bar; b.x = xb_xcc_id(); b.st = st;
    if (threadIdx.x == 0) (void)xb_add(&bar[XB_XCNT(b.x)], 1u);
    return b;
}
__device__ __forceinline__ void xcd_barrier_complete(unsigned* bar, unsigned x, unsigned& nloc, unsigned& nx) {
    const unsigned G = gridDim.x * gridDim.y * gridDim.z;
    unsigned sum, cnt, mine, sp = 0u;
    for (;;) {
        sum = 0u; cnt = 0u; mine = 0u;
#pragma unroll
        for (unsigned j = 0; j < 16; ++j) { const unsigned c = xb_ld(&bar[XB_XCNT(j)]); sum += c; cnt += (c > 0u) ? 1u : 0u; mine = (j == x) ? c : mine; }
        if (sum == G) break;
        __builtin_amdgcn_s_sleep(1);
        if ((++sp & 255u) == 0u) { if (xb_ld(&bar[XB_TMO])) break; if (sp > XB_SPIN_CAP) { atomicAdd(&bar[XB_TMO], 1u); break; } }
    }
    nloc = mine > 0u ? mine : 1u; nx = cnt > 0u ? cnt : 1u;
}
__device__ __forceinline__ void xcd_barrier(const XcdBarrier& b) {
    asm volatile("s_waitcnt vmcnt(0)" ::: "memory");
    __syncthreads();
    if (threadIdx.x == 0) {
        unsigned* bar = b.bar;
        __builtin_amdgcn_s_waitcnt(0);
        unsigned nloc = b.st[0], nx = b.st[1];
        if (nloc == 0u) { xcd_barrier_complete(bar, b.x, nloc, nx); b.st[0] = nloc; b.st[1] = nx; }
        const unsigned old = xb_add(&bar[XB_XSUB(b.x)], 1u);
        const unsigned gen = old / nloc;
        if (old + 1u == (gen + 1u) * nloc) {
            __builtin_amdgcn_fence(__ATOMIC_RELEASE, "agent");
            asm volatile("s_waitcnt vmcnt(0)" ::: "memory");
            const unsigned og = xb_add(&bar[XB_TOP], 1u);
            const unsigned tg = og / nx;
            if (og + 1u == (tg + 1u) * nx) xb_add(&bar[XB_TOPGEN], 1u);
            else XB_SPIN(xb_ld(&bar[XB_TOPGEN]) == tg, bar);
            __builtin_amdgcn_fence(__ATOMIC_ACQUIRE, "agent");
            xb_add(&bar[XB_XGEN(b.x)], 1u);
            asm volatile("s_waitcnt vmcnt(0)" ::: "memory");
        } else {
            XB_SPIN(xb_ld(&bar[XB_XGEN(b.x)]) == gen, bar);
            __builtin_amdgcn_fence(__ATOMIC_ACQUIRE, "agent");
            asm volatile("s_waitcnt vmcnt(0)" ::: "memory");
        }
    }
    __syncthreads();
}

namespace pg8 {
constexpr int BM = 256, BK = 64, HALF = 128, HTB = HALF * BK * 2, STAGE_BYTES = 8 * HTB, NXCD = 8, WGM = 8;
__host__ __device__ __forceinline__ int lds_byte(int r, int c) { const int st = (r >> 4) * 2 + (c >> 5), rr = r & 15, cc = c & 31, ob = rr * 64 + cc * 2; return st * 1024 + (ob ^ (((ob >> 9) & 1) << 5)); }
__host__ __device__ __forceinline__ void stage_rc(int b, int& R, int& C) { const int st = b / 1024, sb = b % 1024, swz = sb ^ (((sb >> 9) & 1) << 5); R = (st >> 1) * 16 + swz / 64; C = (st & 1) * 32 + (swz % 64) / 2; }
__host__ __device__ __forceinline__ int perm32(int rho) { const int n = rho >> 4, i = rho & 15; return 8 * (i >> 2) + 4 * n + (i & 3); }

struct Unit { int pm, pn; };
struct Gemm { const bf16_t* A; const bf16_t* Bt; int M, N, K, lda; int skew; };

struct StaticOrder {
    int nM, nN, nwg, G, c;
    __device__ void init(int M, int N, int G_, int c_) { nM = M / BM; nN = N / BM; nwg = nM * nN; G = G_; c = c_; }
    __device__ bool next(int i, Unit& u) const {
        const long L = (long)i * G + c; if (L >= nwg) return false;
        int wgid = (int)L; { const int q = nwg / NXCD, r = nwg % NXCD, xcd = wgid % NXCD, off = wgid / NXCD; wgid = (xcd < r ? xcd * (q + 1) : r * (q + 1) + (xcd - r) * q) + off; }
        const int nig = WGM * nN, gid = wgid / nig, fm = gid * WGM, gsz = (nM - fm) < WGM ? (nM - fm) : WGM;
        u.pm = fm + ((wgid % nig) % gsz); u.pn = (wgid % nig) / gsz; return true;
    }
};

struct EpiBf16 {
    static constexpr bool PERM = true;
    bf16_t* O; int ldc; bf16_t* O2; int ldc2;
    __device__ __forceinline__ void init(f32x4 (&acc)[2][2][4][2], const Unit&, int, int, int, int) const {
#pragma unroll
        for (int a = 0; a < 2; ++a)
#pragma unroll
            for (int b = 0; b < 2; ++b)
#pragma unroll
                for (int m = 0; m < 4; ++m)
#pragma unroll
                    for (int n = 0; n < 2; ++n) acc[a][b][m][n] = (f32x4){0.f, 0.f, 0.f, 0.f};
    }
    __device__ __forceinline__ void operator()(f32x4 (&acc)[2][2][4][2], const Unit& u, int wr, int wc, int fr, int fq) const {
        const int row0 = u.pm * BM + wr * 64 + fr; const int pn = u.pn;
        if (pn >= 4 && pn < 12) {
            const int colb = 1024 + 128 * (pn - 4) + 16 * wc + 4 * fq;
#pragma unroll
            for (int ai = 0; ai < 2; ++ai)
#pragma unroll
                for (int m = 0; m < 4; ++m) { bf16_t* rowp = O + (size_t)(row0 + ai * HALF + m * 16) * ldc + colb;
#pragma unroll
                    for (int bj = 0; bj < 2; ++bj) { const f32x4 p = acc[ai][bj][m][0] * acc[ai][bj][m][1];
                        u32x2 w; w.x = cvt_pk_bf16(p[0], p[1]); w.y = cvt_pk_bf16(p[2], p[3]);
                        *(u32x2*)(rowp + bj * 64) = w; } }
        } else {
            const bool second = pn >= 16;
            const int col0 = (second ? (pn - 16) * BM : (pn >= 12 ? 2048 + (pn - 12) * BM : pn * BM)) + wc * 32 + 8 * fq;
            bf16_t* Ob = second ? O2 : O; const int ld = second ? ldc2 : ldc;
#pragma unroll
            for (int ai = 0; ai < 2; ++ai)
#pragma unroll
                for (int m = 0; m < 4; ++m) { bf16_t* rowp = Ob + (size_t)(row0 + ai * HALF + m * 16) * ld + col0;
#pragma unroll
                    for (int bj = 0; bj < 2; ++bj) { f32x4 v0 = acc[ai][bj][m][0], v1 = acc[ai][bj][m][1];
                        if (second) {
#pragma unroll
                            for (int i = 0; i < 4; ++i) { v0[i] = v0[i] * sigmoid_fast(v0[i]); v1[i] = v1[i] * sigmoid_fast(v1[i]); } }
                        u32x4 w; w.x = cvt_pk_bf16(v0[0], v0[1]); w.y = cvt_pk_bf16(v0[2], v0[3]); w.z = cvt_pk_bf16(v1[0], v1[1]); w.w = cvt_pk_bf16(v1[2], v1[3]);
                        *(u32x4*)(rowp + bj * HALF) = w; } }
        }
    }
};
struct EpiResidNorm {
    static constexpr bool PERM = false;
    const float* x; float* out; unsigned* ss; unsigned* cnt; const float* fg;
    __device__ __forceinline__ void init(f32x4 (&acc)[2][2][4][2], const Unit& u, int wr, int wc, int fr, int fq) const {
        const int row0 = u.pm * BM + wr * 64 + fr, col0 = u.pn * BM + wc * 32 + 4 * fq;
#pragma unroll
        for (int ai = 0; ai < 2; ++ai)
#pragma unroll
            for (int m = 0; m < 4; ++m) { const size_t off = (size_t)(row0 + ai * HALF + m * 16) * DM + col0;
#pragma unroll
                for (int bj = 0; bj < 2; ++bj)
#pragma unroll
                    for (int n = 0; n < 2; ++n) acc[ai][bj][m][n] = __builtin_nontemporal_load((const f32x4*)(x + off + bj * HALF + n * 16)); }
    }
    __device__ __forceinline__ void operator()(f32x4 (&acc)[2][2][4][2], const Unit& u, int wr, int wc, int fr, int fq) const {
        const int row0 = u.pm * BM + wr * 64 + fr, col0 = u.pn * BM + wc * 32 + 4 * fq;
#pragma unroll
        for (int ai = 0; ai < 2; ++ai)
#pragma unroll
            for (int m = 0; m < 4; ++m) { const int row = row0 + ai * HALF + m * 16; const size_t off = (size_t)row * DM + col0; float s = 0.f;
#pragma unroll
                for (int bj = 0; bj < 2; ++bj)
#pragma unroll
                    for (int n = 0; n < 2; ++n) { const f32x4 o = acc[ai][bj][m][n]; s += (o[0] * o[0] + o[1] * o[1]) + (o[2] * o[2] + o[3] * o[3]); }
                s += __shfl_xor(s, 16); s += __shfl_xor(s, 32);
                if (fq == 0) __hip_atomic_store(ss + (size_t)row * 16 + u.pn * 4 + wc, __float_as_uint(s), __ATOMIC_RELAXED, __HIP_MEMORY_SCOPE_AGENT); }
        asm volatile("s_waitcnt vmcnt(0)" ::: "memory");
        unsigned* c = cnt + (u.pm * 2 + wr) * 32;
        if ((threadIdx.x & 63) == 0) __hip_atomic_fetch_add(c, 1u, __ATOMIC_RELAXED, __HIP_MEMORY_SCOPE_AGENT);
        { unsigned spins = 0;
          while ((unsigned)__builtin_amdgcn_readfirstlane(__hip_atomic_load(c, __ATOMIC_RELAXED, __HIP_MEMORY_SCOPE_AGENT)) < 16u) { __builtin_amdgcn_s_sleep(2); if (++spins > (1u << 22)) break; } }
        asm volatile("" ::: "memory");
#pragma unroll
        for (int ai = 0; ai < 2; ++ai)
#pragma unroll
            for (int m = 0; m < 4; ++m) { const int row = row0 + ai * HALF + m * 16; const size_t off = (size_t)row * DM + col0;
                const unsigned long long* sp = (const unsigned long long*)(ss + (size_t)row * 16 + fq * 4);
                const unsigned long long p0 = __hip_atomic_load(sp, __ATOMIC_RELAXED, __HIP_MEMORY_SCOPE_AGENT), p1 = __hip_atomic_load(sp + 1, __ATOMIC_RELAXED, __HIP_MEMORY_SCOPE_AGENT);
                float t = (__uint_as_float((unsigned)p0) + __uint_as_float((unsigned)(p0 >> 32))) + (__uint_as_float((unsigned)p1) + __uint_as_float((unsigned)(p1 >> 32)));
                t += __shfl_xor(t, 16); t += __shfl_xor(t, 32);
                const float rstd = 1.0f / sqrtf(t * (1.f / DM) + RMS_EPS);
#pragma unroll
                for (int bj = 0; bj < 2; ++bj)
#pragma unroll
                    for (int n = 0; n < 2; ++n) { const f32x4 gv = *(const f32x4*)(fg + col0 + bj * HALF + n * 16);
                        *(f32x4*)(out + off + bj * HALF + n * 16) = acc[ai][bj][m][n] * rstd * gv; } }
    }
};

template <class Epi>
__device__ __forceinline__ void gemm_phase(LAS unsigned char* lds, const Gemm g, const StaticOrder& S, const Epi& E) {
    const int tid = threadIdx.x, wid = __builtin_amdgcn_readfirstlane(tid >> 6), lane = tid & 63, wr = wid >> 2, wc = wid & 3, fr = lane & 15, fq = lane >> 4;
    const int K = g.K, nt = K / BK, lda = g.lda;
    unsigned voffA[2], voffB[2];
#pragma unroll
    for (int i = 0; i < 2; ++i) { int R, C; stage_rc(tid * 16 + i * 8192, R, C); const int Rb = Epi::PERM ? ((R & ~31) + perm32(R & 31)) : R;
        voffA[i] = (unsigned)(R * lda + C) * 2u; voffB[i] = (unsigned)(Rb * K + C) * 2u; }
    const size_t kstep = (size_t)(BK * 2);
    const size_t hstepA = (size_t)HALF * lda * 2, hstepB = (size_t)HALF * K * 2;
    const size_t tstepA = 2 * hstepA, tstepB = 2 * hstepB;
    const unsigned ldsw = (unsigned)wid * 1024u;
    const int aoff = lds_byte(wr * 64 + fr, fq * 8), boff = lds_byte(wc * 32 + fr, fq * 8);
#define PG8_SA(b, h) (((b) * 2 + (h)) * HTB)
#define PG8_SB(b, h) ((4 + (b) * 2 + (h)) * HTB)
#define PG8_STAGE(bufoff, gbase, voff) do { _Pragma("unroll") for (int _i = 0; _i < 2; ++_i) \
        __builtin_amdgcn_global_load_lds((const unsigned*)((const char*)(gbase) + (voff)[_i]), (LAS unsigned*)(lds + (bufoff) + ldsw + _i * 8192), 16, 0, 0); } while (0)
#define PG8_LDA(dst, b, h) do { _Pragma("unroll") for (int m = 0; m < 4; ++m) _Pragma("unroll") for (int k = 0; k < 2; ++k) dst[m][k] = *(const LAS bf16x8*)(lds + PG8_SA(b, h) + aoff + m * 2048 + k * 1024); } while (0)
#define PG8_LDB(dst, b, h) do { _Pragma("unroll") for (int n = 0; n < 2; ++n) _Pragma("unroll") for (int k = 0; k < 2; ++k) dst[n][k] = *(const LAS bf16x8*)(lds + PG8_SB(b, h) + boff + n * 2048 + k * 1024); } while (0)
#define PG8_MMA(ai, bj, At, Bt) do { __builtin_amdgcn_s_setprio(1); _Pragma("unroll") for (int m = 0; m < 4; ++m) _Pragma("unroll") for (int n = 0; n < 2; ++n) _Pragma("unroll") for (int k = 0; k < 2; ++k) \
        acc[ai][bj][m][n] = __builtin_amdgcn_mfma_f32_16x16x32_bf16(Bt[n][k], At[m][k], acc[ai][bj][m][n], 0, 0, 0); __builtin_amdgcn_s_setprio(0); } while (0)
#define PG8_WAIT_V(n) asm volatile("s_waitcnt vmcnt(" #n ")" ::: "memory")
#define PG8_WAIT_L(n) asm volatile("s_waitcnt lgkmcnt(" #n ")" ::: "memory")
#define PG8_BAR __builtin_amdgcn_s_barrier()
#define PG8_SCHED __builtin_amdgcn_sched_barrier(0)
    Unit cur, nxt; int ui = 0;
    if (!S.next(0, cur)) return;
    if (g.skew > 0) { const unsigned long long t0 = __builtin_amdgcn_s_memrealtime(), dt = (unsigned long long)((blockIdx.x & 7u) * (unsigned)g.skew);
        while (__builtin_amdgcn_s_memrealtime() - t0 < dt) __builtin_amdgcn_s_sleep(8); }
    f32x4 acc[2][2][4][2];
    E.init(acc, cur, wr, wc, fr, fq);
    bf16x8 At[4][2], B0[2][2], B1[2][2];
    const char* cA = (const char*)g.A + (size_t)cur.pm * tstepA; const char* cB = (const char*)g.Bt + (size_t)cur.pn * tstepB;
#if PG8_SP2
    PG8_STAGE(PG8_SB(0, 0), cB, voffB); PG8_STAGE(PG8_SB(0, 1), cB + hstepB, voffB); PG8_STAGE(PG8_SA(0, 0), cA, voffA); PG8_STAGE(PG8_SA(0, 1), cA + hstepA, voffA);
    if (wr == 1) PG8_BAR;
    PG8_WAIT_V(2); PG8_BAR;
    PG8_STAGE(PG8_SB(1, 0), cB + kstep, voffB); PG8_STAGE(PG8_SA(1, 0), cA + kstep, voffA); PG8_STAGE(PG8_SB(1, 1), cB + hstepB + kstep, voffB);
    PG8_WAIT_V(6); PG8_BAR;
#else
    PG8_STAGE(PG8_SB(0, 0), cB, voffB); PG8_STAGE(PG8_SA(0, 0), cA, voffA); PG8_STAGE(PG8_SB(0, 1), cB + hstepB, voffB); PG8_STAGE(PG8_SA(0, 1), cA + hstepA, voffA);
    if (wr == 1) PG8_BAR;
    PG8_WAIT_V(4); PG8_BAR;
    PG8_STAGE(PG8_SB(1, 0), cB + kstep, voffB); PG8_STAGE(PG8_SA(1, 0), cA + kstep, voffA); PG8_STAGE(PG8_SB(1, 1), cB + hstepB + kstep, voffB);
    PG8_WAIT_V(6); PG8_BAR;
#endif
    for (;;) {
        const bool has_next = S.next(ui + 1, nxt);
        const char* nA = has_next ? (const char*)g.A + (size_t)nxt.pm * tstepA : cA; const char* nB = has_next ? (const char*)g.Bt + (size_t)nxt.pn * tstepB : cB;
        for (int t = 0; t < nt; t += 2) {
            const bool last = (t == nt - 2);
            const char* a1 = cA + (size_t)(t + 1) * kstep;
            const char* a2 = last ? nA : cA + (size_t)(t + 2) * kstep; const char* b2 = last ? nB : cB + (size_t)(t + 2) * kstep;
            const char* a3 = a2 + kstep; const char* b3 = b2 + kstep;
#if PG8_SP2
            PG8_LDB(B0, 0, 0); PG8_LDB(B1, 0, 1); PG8_SCHED; PG8_LDA(At, 0, 0); PG8_STAGE(PG8_SA(1, 1), a1 + hstepA, voffA);
            PG8_WAIT_V(8); PG8_WAIT_L(0); PG8_BAR; PG8_MMA(0, 0, At, B0); PG8_MMA(0, 1, At, B1); PG8_BAR; PG8_SCHED;
            PG8_LDA(At, 0, 1); PG8_STAGE(PG8_SB(0, 0), b2, voffB); PG8_STAGE(PG8_SB(0, 1), b2 + hstepB, voffB); PG8_STAGE(PG8_SA(0, 0), a2, voffA);
            PG8_WAIT_V(8); PG8_WAIT_L(0); PG8_BAR; PG8_MMA(1, 0, At, B0); PG8_MMA(1, 1, At, B1); PG8_BAR; PG8_SCHED;
            PG8_LDB(B0, 1, 0); PG8_LDB(B1, 1, 1); PG8_SCHED; PG8_LDA(At, 1, 0); PG8_STAGE(PG8_SA(0, 1), a2 + hstepA, voffA);
            PG8_WAIT_V(8); PG8_WAIT_L(0); PG8_BAR; PG8_MMA(0, 0, At, B0); PG8_MMA(0, 1, At, B1); PG8_BAR; PG8_SCHED;
            PG8_LDA(At, 1, 1); PG8_STAGE(PG8_SB(1, 0), b3, voffB); PG8_STAGE(PG8_SB(1, 1), b3 + hstepB, voffB); PG8_STAGE(PG8_SA(1, 0), a3, voffA);
            PG8_WAIT_V(8); PG8_WAIT_L(0); PG8_BAR; PG8_MMA(1, 0, At, B0); PG8_MMA(1, 1, At, B1); PG8_BAR; PG8_SCHED;
#else
            PG8_LDB(B0, 0, 0); PG8_SCHED; PG8_LDA(At, 0, 0); PG8_STAGE(PG8_SA(1, 1), a1 + hstepA, voffA);
            PG8_WAIT_L(8); PG8_BAR; PG8_WAIT_L(0); PG8_MMA(0, 0, At, B0); PG8_BAR; PG8_SCHED;
            PG8_LDB(B1, 0, 1); PG8_STAGE(PG8_SB(0, 0), b2, voffB);
            PG8_BAR; PG8_WAIT_L(0); PG8_MMA(0, 1, At, B1); PG8_BAR;
            PG8_LDA(At, 0, 1); PG8_STAGE(PG8_SA(0, 0), a2, voffA);
            PG8_BAR; PG8_WAIT_L(0); PG8_MMA(1, 0, At, B0); PG8_BAR; PG8_SCHED;
            PG8_STAGE(PG8_SB(0, 1), b2 + hstepB, voffB);
            PG8_WAIT_V(6); PG8_BAR; PG8_MMA(1, 1, At, B1); PG8_BAR;
            PG8_LDB(B0, 1, 0); PG8_SCHED; PG8_LDA(At, 1, 0); PG8_STAGE(PG8_SA(0, 1), a2 + hstepA, voffA);
            PG8_WAIT_L(8); PG8_BAR; PG8_WAIT_L(0); PG8_MMA(0, 0, At, B0); PG8_BAR; PG8_SCHED;
            PG8_LDB(B1, 1, 1); PG8_STAGE(PG8_SB(1, 0), b3, voffB);
            PG8_BAR; PG8_WAIT_L(0); PG8_MMA(0, 1, At, B1); PG8_BAR;
            PG8_LDA(At, 1, 1); PG8_STAGE(PG8_SA(1, 0), a3, voffA);
            PG8_BAR; PG8_WAIT_L(0); PG8_MMA(1, 0, At, B0); PG8_BAR; PG8_SCHED;
            PG8_STAGE(PG8_SB(1, 1), b3 + hstepB, voffB);
            PG8_WAIT_V(6); PG8_BAR; PG8_MMA(1, 1, At, B1); PG8_BAR;
#endif
        }
#if PG8_ALIGN
        if (wr == 0) PG8_BAR;
#endif
        E(acc, cur, wr, wc, fr, fq);
        if (!has_next) break;
        cur = nxt; cA = nA; cB = nB; ++ui;
        E.init(acc, cur, wr, wc, fr, fq);
#if PG8_ALIGN
        if (wr == 1) PG8_BAR;
#endif
    }
    PG8_WAIT_V(0);
#if !PG8_ALIGN
    if (wr == 0) PG8_BAR;
#endif
    PG8_BAR;
#undef PG8_SA
#undef PG8_SB
#undef PG8_STAGE
#undef PG8_LDA
#undef PG8_LDB
#undef PG8_MMA
#undef PG8_WAIT_V
#undef PG8_WAIT_L
#undef PG8_BAR
#undef PG8_SCHED
}
}

__device__ __forceinline__ void p0_transpose_item(const float* W, int ldw, int k0, int ncol0, bf16_t* WT, int ldt, int drow0, int dk0, LAS float* scr, int lane, int mode = 0) {
#pragma unroll 8
    for (int i = 0; i < 32; ++i) { const int kk = 2 * i + (lane >> 5); scr[kk * 33 + (lane & 31)] = __builtin_nontemporal_load(W + (size_t)(k0 + kk) * ldw + ncol0 + (lane & 31)); }
    asm volatile("s_waitcnt lgkmcnt(0)" ::: "memory");
    const int c = lane & 7;
#pragma unroll
    for (int j = 0; j < 4; ++j) { const int n = (lane >> 3) + 8 * j; const LAS float* s = scr + (8 * c) * 33 + n;
        u32x4 o; o.x = cvt_pk_bf16(s[0 * 33], s[1 * 33]); o.y = cvt_pk_bf16(s[2 * 33], s[3 * 33]); o.z = cvt_pk_bf16(s[4 * 33], s[5 * 33]); o.w = cvt_pk_bf16(s[6 * 33], s[7 * 33]);
        int drow = drow0 + n;
        if (mode) { const int ch = drow0 + n; drow = 1024 + 256 * (ch >> 7) + 128 * ((ch >> 6) & 1) + 32 * ((ch >> 4) & 3) + 8 * ((ch >> 2) & 3) + 4 * (mode - 1) + (ch & 3); }
        *(u32x4*)(WT + (size_t)drow * ldt + dk0 + 8 * c) = o; }
    asm volatile("s_waitcnt lgkmcnt(0)" ::: "memory");
}

__device__ __forceinline__ void phase0(const Args& a, LAS unsigned char* lds, int wave, int lane) {
    LAS float* scr = (LAS float*)(lds + wave * 16384);
    const int gw = blockIdx.x * 8 + wave, NGW = gridDim.x * 8;
    bf16_t* win_t = (bf16_t*)(a.ws + WS_WIN); bf16_t* wout_t = (bf16_t*)(a.ws + WS_WOUT); bf16_t* wg = (bf16_t*)(a.ws + WS_WG);
    constexpr int I_IN = 16 * 192, I_OUT = 32 * 32, I_G = 64;
    for (int it = gw; it < I_IN + I_OUT + I_G; it += NGW) {
        int r = it;
        if (r < I_IN) { const int kb = r / 192, nb = r % 192; const int og = nb / 32;
            if (og == 1 || og == 2) p0_transpose_item(a.in[I_WIN], NPROJ, kb * 64, nb * 32, win_t, DM, (nb % 32) * 32, kb * 64, scr, lane, og);
            else { const int nbase = (og == 0) ? 0 : (og == 4 ? 3072 : (og == 3 ? 4096 : 5120));
                p0_transpose_item(a.in[I_WIN], NPROJ, kb * 64, nb * 32, win_t, DM, nbase + (nb % 32) * 32, kb * 64, scr, lane, 0); }
            continue; }
        r -= I_IN;
        if (r < I_OUT) { const int kb = r / 32, nb = r % 32; p0_transpose_item(a.in[I_WOUT], DM, kb * 64, nb * 32, wout_t, DMIX, nb * 32, kb * 64, scr, lane); continue; }
        r -= I_OUT;
        { const int mat = r / 32, h = (r % 32) / 2, nb = r & 1; const float* W = (mat ? a.in[I_WI] : a.in[I_WA]) + h * 4096;
          p0_transpose_item(W, 64, 0, nb * 32, wg + mat * 65536 + h * 4096, 64, nb * 32, 0, scr, lane); }
    }
    const float* x = a.in[I_X]; bf16_t* xn = (bf16_t*)(a.ws + WS_XN);
    f32x4 gv[4];
#pragma unroll
    for (int j = 0; j < 4; ++j) gv[j] = ((const f32x4*)a.in[I_LNG])[lane + 64 * j];
    for (int m = gw; m < T_TOK; m += NGW) {
        const f32x4* xr = (const f32x4*)(x + (size_t)m * DM) + lane;
        f32x4 v[4]; float s = 0.f;
#pragma unroll
        for (int j = 0; j < 4; ++j) { v[j] = __builtin_nontemporal_load(xr + 64 * j); s += (v[j].x * v[j].x + v[j].y * v[j].y) + (v[j].z * v[j].z + v[j].w * v[j].w); }
        const float rstd = 1.0f / sqrtf(wave_sum(s) * (1.f / DM) + RMS_EPS);
        u32x2* o8 = (u32x2*)(xn + (size_t)m * DM) + lane;
#pragma unroll
        for (int j = 0; j < 4; ++j) { u32x2 w; w.x = cvt_pk_bf16(v[j].x * rstd * gv[j].x, v[j].y * rstd * gv[j].y); w.y = cvt_pk_bf16(v[j].z * rstd * gv[j].z, v[j].w * rstd * gv[j].w); o8[64 * j] = w; }
    }
}

#define DPP_ADD(v, ctrl) ((v) + __uint_as_float(__builtin_amdgcn_update_dpp(0, __float_as_uint(v), (ctrl), 0xF, 0xF, false)))
__device__ __forceinline__ void conv_item(const Args& a, bf16_t* proj, bf16_t* projg, bf16_t* obase, int ostride, int item, int wave, int lane) {
    const int q = lane >> 4, c8 = lane & 15, ch0 = wave * 128 + c8 * 8;
    float w0[8], w1[8], w2[8], gn[8];
    { const float* cw = a.in[I_CONVW] + ch0; const float* cg_ = a.in[I_CG] + ch0;
#pragma unroll
      for (int j = 0; j < 8; ++j) { w0[j] = cw[j]; w1[j] = cw[1024 + j]; w2[j] = cw[2048 + j]; gn[j] = cg_[j]; } }
    const int tok0 = item * (4 * CONV_R) + q * CONV_R;
    bf16_t* base = proj + (size_t)tok0 * LDPA + ch0; const bf16_t* gbase = projg + (size_t)tok0 * LDPG + ch0;
    float p2[8], p1[8];
    if ((tok0 & (SEQ - 1)) == 0) {
#pragma unroll
        for (int j = 0; j < 8; ++j) { p2[j] = 0.f; p1[j] = 0.f; }
    } else {
        const u32x4 c2 = *(const u32x4*)(base - 2 * LDPA + COL_CX), c1 = *(const u32x4*)(base - 1 * LDPA + COL_CX);
        unpack8(c2, p2); unpack8(c1, p1);
    }
    u32x4 nb[2], nc[2], ng[2];
#pragma unroll
    for (int k = 0; k < 2; ++k) { const bf16_t* rp = base + (size_t)k * LDPA; nb[k] = __builtin_nontemporal_load((const u32x4*)(rp + COL_B)); nc[k] = __builtin_nontemporal_load((const u32x4*)(rp + COL_CX)); ng[k] = __builtin_nontemporal_load((const u32x4*)(gbase + (size_t)k * LDPG)); }
    for (int i = 0; i < CONV_R; i += 2) {
        u32x4 vb[2], vc[2], vg[2];
#pragma unroll
        for (int k = 0; k < 2; ++k) { vb[k] = nb[k]; vc[k] = nc[k]; vg[k] = ng[k]; }
        if (i + 2 < CONV_R) {
#pragma unroll
            for (int k = 0; k < 2; ++k) { const bf16_t* rp = base + (size_t)(i + 2 + k) * LDPA; nb[k] = __builtin_nontemporal_load((const u32x4*)(rp + COL_B)); nc[k] = __builtin_nontemporal_load((const u32x4*)(rp + COL_CX)); ng[k] = __builtin_nontemporal_load((const u32x4*)(gbase + (size_t)(i + 2 + k) * LDPG)); }
        }
#pragma unroll
        for (int k = 0; k < 2; ++k) {
            float fb[8], cx[8], fg[8], y[8];
            unpack8(vb[k], fb); unpack8(vc[k], cx); unpack8(vg[k], fg);
            float ss = 0.f;
#pragma unroll
            for (int j = 0; j < 8; ++j) { const float cv = w0[j] * p2[j] + w1[j] * p1[j] + w2[j] * cx[j]; y[j] = fb[j] * cv; ss += y[j] * y[j]; p2[j] = p1[j]; p1[j] = cx[j]; }
            ss = DPP_ADD(ss, 0xB1); ss = DPP_ADD(ss, 0x4E); ss = DPP_ADD(ss, 0x141); ss = DPP_ADD(ss, 0x140);
            const float rstd = __builtin_amdgcn_rsqf(ss * (1.f / 128.f) + RMS_EPS);
            float o[8];
#pragma unroll
            for (int j = 0; j < 8; ++j) o[j] = y[j] * rstd * gn[j] * fg[j];
            u32x4 w; w.x = cvt_pk_bf16(o[0], o[1]); w.y = cvt_pk_bf16(o[2], o[3]); w.z = cvt_pk_bf16(o[4], o[5]); w.w = cvt_pk_bf16(o[6], o[7]);
            *(u32x4*)(obase + (size_t)(tok0 + i + k) * ostride + ch0) = w;
        }
    }
}

constexpr int L_GW = 0;
constexpr int L_CW = 18432;
constexpr int L_AGG = 20992;
constexpr int L_WT = 29184;
constexpr int WT_BYTES = 8704;
static_assert(L_WT + 8 * WT_BYTES <= 131072, "lds");
typedef float f32x2 __attribute__((ext_vector_type(2)));

__device__ __forceinline__ void lru_item(const Args& a, bf16_t* proj, bf16_t* projg, bf16_t* obase, int ostride, LAS unsigned char* lds, int chain, int part, int nsplit, int tid, int wave, int lane) {
    const int b = chain >> 4, h = chain & 15;
    {
        const bf16_t* wg = (const bf16_t*)(a.ws + WS_WG);
        for (int i = tid; i < 1024; i += NTHREADS) { const int mat = i >> 9, e = (i >> 3) & 63, c = i & 7;
            const u32x4 v = *(const u32x4*)(wg + mat * 65536 + h * 4096 + e * 64 + c * 8);
            *(LAS u32x4*)(lds + L_GW + mat * 9216 + e * 144 + c * 16) = v; }
        LAS float* cw = (LAS float*)(lds + L_CW);
        if (tid < 256) cw[tid] = a.in[I_LCW][(tid >> 6) * 1024 + h * 64 + (tid & 63)];
        else if (tid < 320) { const int c = tid - 256, gc = h * 64 + c;
            cw[256 + c] = a.in[I_LCB][gc]; cw[320 + c] = a.in[I_BA][gc]; cw[384 + c] = a.in[I_BI][gc];
            const float lam = a.in[I_LAM][gc];
            const float logsig = (lam >= 0.f) ? -log1pf(expf(-lam)) : (lam - log1pf(expf(lam)));
            cw[448 + c] = 8.0f * logsig * 1.44269504f;
            cw[512 + c] = a.in[I_LG][gc]; }
    }
    __syncthreads();
    const int r = lane & 31, hh = lane >> 5;
    LAS unsigned char* wt = lds + L_WT + wave * WT_BYTES;
    LAS const float* cw = (LAS const float*)(lds + L_CW);
    bf16x8 I0, I1;
    {
        u32x4 t0 = (u32x4){0u, 0u, 0u, 0u}, t1 = t0;
        const int j0 = r - 8 * hh, j1 = r - 16 - 8 * hh;
#pragma unroll
        for (int d = 0; d < 4; ++d) {
            t0[d] = (j0 == 2 * d) ? 0x00003F80u : ((j0 == 2 * d + 1) ? 0x3F800000u : 0u);
            t1[d] = (j1 == 2 * d) ? 0x00003F80u : ((j1 == 2 * d + 1) ? 0x3F800000u : 0u);
        }
        I0 = __builtin_bit_cast(bf16x8, t0); I1 = __builtin_bit_cast(bf16x8, t1);
    }
    float ba[2], bi[2], cf[2];
#pragma unroll
    for (int n = 0; n < 2; ++n) { ba[n] = cw[320 + 32 * n + r]; bi[n] = cw[384 + 32 * n + r]; cf[n] = cw[448 + 32 * n + r]; }
    float carry[2] = {0.f, 0.f};
    unsigned* flags = (unsigned*)(a.ws + WS_CTL + 4096) + chain * 32;
    unsigned long long* aggg = (unsigned long long*)(a.ws + WS_AGG) + (size_t)chain * 16 * 64;

    const bf16_t* xl_base = proj + (size_t)b * SEQ * LDPA + COL_XL + h * 64;
    const bf16_t* gl_base = projg + (size_t)b * SEQ * LDPG + 1024 + h * 64;
    u32x4 xr[5];
#define LOAD_X(seg_) do { const int s0_ = (seg_) * 256 + wave * 32; _Pragma("unroll") for (int i = 0; i < 5; ++i) { const int idx = lane + 64 * i, row = idx >> 3, c = idx & 7; const int s = s0_ - 3 + row; \
        xr[i] = (u32x4){0u, 0u, 0u, 0u}; if (idx < 280 && s >= 0) xr[i] = __builtin_nontemporal_load((const u32x4*)(xl_base + (size_t)s * LDPA + c * 8)); } } while (0)
    LOAD_X(part);
    for (int seg = part; seg < 16; seg += nsplit) {
        const int s0 = seg * 256 + wave * 32;
#pragma unroll
        for (int i = 0; i < 5; ++i) { const int idx = lane + 64 * i, row = idx >> 3, c = idx & 7; if (idx < 280) *(LAS u32x4*)(wt + row * 144 + c * 16) = xr[i]; }
        if (seg + nsplit < 16) LOAD_X(seg + nsplit);
        u32x4 gl[4];
#define LOAD_GL() do { _Pragma("unroll") for (int i = 0; i < 4; ++i) { const int tok = (lane >> 3) + 8 * i, c = lane & 7; gl[i] = __builtin_nontemporal_load((const u32x4*)(gl_base + (size_t)(s0 + tok) * LDPG + c * 8)); } } while (0)
#if GL_EARLY
        LOAD_GL();
#endif
        asm volatile("s_waitcnt lgkmcnt(0)" ::: "memory");
        bf16x8 Af[4];
#pragma unroll
        for (int s = 0; s < 4; ++s) {
            const int c0 = 16 * s + 8 * hh;
            float u8[8];
            { const f32x4 b0 = *(LAS const f32x4*)(cw + 256 + c0), b1 = *(LAS const f32x4*)(cw + 256 + c0 + 4);
              u8[0] = b0[0]; u8[1] = b0[1]; u8[2] = b0[2]; u8[3] = b0[3]; u8[4] = b1[0]; u8[5] = b1[1]; u8[6] = b1[2]; u8[7] = b1[3]; }
#pragma unroll
            for (int k = 0; k < 4; ++k) {
                const u32x4 xv = *(LAS const u32x4*)(wt + (r + k) * 144 + c0 * 2);
                const f32x4 wv0 = *(LAS const f32x4*)(cw + k * 64 + c0), wv1 = *(LAS const f32x4*)(cw + k * 64 + c0 + 4);
                float fx[8]; unpack8(xv, fx);
                u8[0] += wv0[0] * fx[0]; u8[1] += wv0[1] * fx[1]; u8[2] += wv0[2] * fx[2]; u8[3] += wv0[3] * fx[3];
                u8[4] += wv1[0] * fx[4]; u8[5] += wv1[1] * fx[5]; u8[6] += wv1[2] * fx[6]; u8[7] += wv1[3] * fx[7];
            }
            u32x4 pk; pk.x = cvt_pk_bf16(u8[0], u8[1]); pk.y = cvt_pk_bf16(u8[2], u8[3]); pk.z = cvt_pk_bf16(u8[4], u8[5]); pk.w = cvt_pk_bf16(u8[6], u8[7]);
            Af[s] = __builtin_bit_cast(bf16x8, pk);
        }
#pragma unroll
        for (int n = 0; n < 2; ++n) {
            float hl[16], pc[16];
            f32x16 accR, accI, accU;
#pragma unroll
            for (int j = 0; j < 16; ++j) { accR[j] = 0.f; accI[j] = 0.f; accU[j] = 0.f; }
#pragma unroll
            for (int s = 0; s < 4; ++s) {
                const bf16x8 Ba = *(LAS const bf16x8*)(lds + L_GW + (32 * n + r) * 144 + (16 * s + 8 * hh) * 2);
                const bf16x8 Bi = *(LAS const bf16x8*)(lds + L_GW + 9216 + (32 * n + r) * 144 + (16 * s + 8 * hh) * 2);
                accR = __builtin_amdgcn_mfma_f32_32x32x16_bf16(Af[s], Ba, accR, 0, 0, 0);
                accI = __builtin_amdgcn_mfma_f32_32x32x16_bf16(Af[s], Bi, accI, 0, 0, 0);
            }
            accU = __builtin_amdgcn_mfma_f32_32x32x16_bf16(Af[2 * n], I0, accU, 0, 0, 0);
            accU = __builtin_amdgcn_mfma_f32_32x32x16_bf16(Af[2 * n + 1], I1, accU, 0, 0, 0);
            float gP[4], gH[4];
#pragma unroll
            for (int g = 0; g < 4; ++g) {
                float P = 1.f, H = 0.f;
#pragma unroll
                for (int i = 0; i < 4; ++i) { const int j = 4 * g + i;
                    const float rr = sigmoid_fast(accR[j] + ba[n]);
                    const float ii = sigmoid_fast(accI[j] + bi[n]);
                    const float l2 = rr * cf[n];
                    const float aa = __builtin_amdgcn_exp2f(l2);
                    const float t = l2 * 1.38629436f;
                    const float em_small = -t * (1.0f + t * (0.5f + t * (0.16666667f + t * 0.041666667f)));
                    const float one_m = (t > -0.0625f) ? em_small : (1.0f - aa * aa);
                    const float dd = __builtin_amdgcn_sqrtf(one_m) * ii * accU[j];
                    H = aa * H + dd; P = P * aa; hl[j] = H; pc[j] = P; }
                gP[g] = P; gH[g] = H;
            }
            float cp = 1.f, ch = 0.f;
#pragma unroll
            for (int g = 0; g < 4; ++g) {
                const auto sp = __builtin_amdgcn_permlane32_swap(__float_as_uint(gP[g]), __float_as_uint(gP[g]), false, false);
                const auto sh = __builtin_amdgcn_permlane32_swap(__float_as_uint(gH[g]), __float_as_uint(gH[g]), false, false);
                const float oP = __uint_as_float(hh ? sp[0] : sp[1]), oH = __uint_as_float(hh ? sh[0] : sh[1]);
                const float P = gP[g], H = gH[g];
                const float A1 = hh ? oP : P, H1 = hh ? oH : H, A2 = hh ? P : oP, H2 = hh ? H : oH;
                const float cp1 = cp * A1, ch1 = A1 * ch + H1;
                const float inP = hh ? cp1 : cp, inH = hh ? ch1 : ch;
#pragma unroll
                for (int i = 0; i < 4; ++i) { const int j = 4 * g + i; hl[j] += pc[j] * inH; pc[j] *= inP; }
                cp = cp1 * A2; ch = A2 * ch1 + H2;
            }
            if (hh == 0) *(LAS f32x2*)(lds + L_AGG + ((n * 8 + wave) * 64 + 32 * n + r) * 8) = (f32x2){cp, ch};
#if !GL_EARLY
            if (n == 1) LOAD_GL();
#endif
            if (nsplit > 1 && seg > 0 && wave == 0) {
                unsigned spins = 0;
                while (__builtin_amdgcn_readfirstlane(__hip_atomic_load(flags + (seg - 1) * 2 + n, __ATOMIC_RELAXED, __HIP_MEMORY_SCOPE_AGENT)) == 0u) { __builtin_amdgcn_s_sleep(2); if (++spins > (1u << 22)) break; }
                asm volatile("" ::: "memory");
            }
            __syncthreads();
            float c = carry[n];
            if (nsplit > 1 && seg > 0) {
                const unsigned long long pw = __hip_atomic_load(aggg + (size_t)(seg - 1) * 64 + n * 32 + r, __ATOMIC_RELAXED, __HIP_MEMORY_SCOPE_AGENT);
                c = __uint_as_float((unsigned)pw) * c + __uint_as_float((unsigned)(pw >> 32));
            }
            float cin = 0.f, iP = 1.f, iH = 0.f;
#pragma unroll
            for (int w = 0; w < 8; ++w) {
                const f32x2 ag = *(LAS const f32x2*)(lds + L_AGG + ((n * 8 + w) * 64 + 32 * n + r) * 8);
                cin = (w == wave) ? c : cin; c = ag.x * c + ag.y; iH = ag.x * iH + ag.y; iP *= ag.x; }
            carry[n] = c;
            if (nsplit > 1 && wave == 0) {
                if (hh == 0) __hip_atomic_store(aggg + (size_t)seg * 64 + n * 32 + r, ((unsigned long long)__float_as_uint(iH) << 32) | __float_as_uint(iP), __ATOMIC_RELAXED, __HIP_MEMORY_SCOPE_AGENT);
                asm volatile("s_waitcnt vmcnt(0)" ::: "memory");
                if (lane == 0) __hip_atomic_store(flags + seg * 2 + n, 1u, __ATOMIC_RELAXED, __HIP_MEMORY_SCOPE_AGENT);
            }
#pragma unroll
            for (int j = 0; j < 16; ++j) { const int row = (j & 3) + 8 * (j >> 2) + 4 * hh;
                *(LAS float*)(wt + row * 272 + (32 * n + r) * 4) = hl[j] + pc[j] * cin; }
        }
        asm volatile("s_waitcnt lgkmcnt(0)" ::: "memory");
#pragma unroll
        for (int i = 0; i < 4; ++i) {
            const int tok = (lane >> 3) + 8 * i, c = lane & 7;
            const f32x4 h0 = *(LAS const f32x4*)(wt + tok * 272 + c * 32), h1 = *(LAS const f32x4*)(wt + tok * 272 + c * 32 + 16);
            const f32x4 g0 = *(LAS const f32x4*)(cw + 512 + c * 8), g1 = *(LAS const f32x4*)(cw + 512 + c * 8 + 4);
            float ss = (h0[0] * h0[0] + h0[1] * h0[1]) + (h0[2] * h0[2] + h0[3] * h0[3]) + (h1[0] * h1[0] + h1[1] * h1[1]) + (h1[2] * h1[2] + h1[3] * h1[3]);
            ss = DPP_ADD(ss, 0xB1); ss = DPP_ADD(ss, 0x4E); ss = DPP_ADD(ss, 0x141);
            const float rstd = __builtin_amdgcn_rsqf(ss * (1.f / 64.f) + RMS_EPS);
            float fg[8]; unpack8(gl[i], fg);
            float o[8];
            o[0] = h0[0] * rstd * g0[0]; o[1] = h0[1] * rstd * g0[1]; o[2] = h0[2] * rstd * g0[2]; o[3] = h0[3] * rstd * g0[3];
            o[4] = h1[0] * rstd * g1[0]; o[5] = h1[1] * rstd * g1[1]; o[6] = h1[2] * rstd * g1[2]; o[7] = h1[3] * rstd * g1[3];
#pragma unroll
            for (int j = 0; j < 8; ++j) o[j] *= fg[j];
            u32x4 w; w.x = cvt_pk_bf16(o[0], o[1]); w.y = cvt_pk_bf16(o[2], o[3]); w.z = cvt_pk_bf16(o[4], o[5]); w.w = cvt_pk_bf16(o[6], o[7]);
            *(u32x4*)(obase + (size_t)(b * SEQ + s0 + tok) * ostride + h * 64 + c * 8) = w;
        }
        asm volatile("s_waitcnt lgkmcnt(0)" ::: "memory");
    }
#undef LOAD_X
    __syncthreads();
}

__global__ void __launch_bounds__(NTHREADS, 2) hymba_fwd(Args a) {
    extern __shared__ __attribute__((aligned(16))) unsigned char lds_raw[];
    LAS unsigned char* lds = (LAS unsigned char*)lds_raw;
    cg::grid_group grid = cg::this_grid();
    if (gridDim.y == 0x7fffu) grid.sync();
    volatile LAS unsigned* bst = (volatile LAS unsigned*)(lds + 131072 + 64);
    if (threadIdx.x == 0) { bst[0] = 0u; bst[1] = 0u; }
    __syncthreads();
    const XcdBarrier bar = xcd_barrier_post((unsigned*)(a.ws + WS_CTL + 32768), bst);
    const int tid = threadIdx.x, lane = tid & 63, wave = __builtin_amdgcn_readfirstlane(tid >> 6);
    bf16_t* proj = (bf16_t*)(a.ws + WS_PROJ); bf16_t* projg = (bf16_t*)(a.ws + WS_PROJG);

#pragma unroll
    for (int rep = 0; rep < REP0; ++rep) {
#ifndef SKIP_P0
    phase0(a, lds, wave, lane);
#endif

    xcd_barrier(bar); }
#pragma unroll
    for (int rep = 0; rep < REP1; ++rep) {
        pg8::Gemm g{(const bf16_t*)(a.ws + WS_XN), (const bf16_t*)(a.ws + WS_WIN), T_TOK, NPROJ, DM, DM, SKEW1};
        pg8::StaticOrder S; S.init(T_TOK, NPROJ, (int)gridDim.x, (int)blockIdx.x);
        pg8::EpiBf16 E{proj, LDPA, projg, LDPG};
#ifndef SKIP_G1
        pg8::gemm_phase<pg8::EpiBf16>(lds, g, S, E);
#endif
    xcd_barrier(bar); }
    {
#ifndef SKIP_LRU
        if (gridDim.x >= 256) { if (blockIdx.x < 256) lru_item(a, proj, projg, projg + 1024, LDPG, lds, (int)blockIdx.x >> 1, (int)blockIdx.x & 1, 2, tid, wave, lane); }
        else for (int it = blockIdx.x; it < 128; it += gridDim.x) lru_item(a, proj, projg, projg + 1024, LDPG, lds, it, 0, 1, tid, wave, lane);
#endif
        LAS unsigned* qs = (LAS unsigned*)(lds + 131072);
        unsigned* qctr = (unsigned*)(a.ws + WS_CTL);
        for (;;) {
            if (tid == 0) qs[0] = atomicAdd(qctr, 1u);
            __syncthreads();
            const unsigned it = qs[0];
            __syncthreads();
            if (it >= (unsigned)(T_TOK / (4 * CONV_R))) break;
#ifndef SKIP_CONV
            conv_item(a, proj, projg, projg, LDPG, (int)it, wave, lane);
#endif
        }
    }
    xcd_barrier(bar);
#pragma unroll
    for (int rep = 0; rep < REP3; ++rep) {
        pg8::Gemm g{projg, (const bf16_t*)(a.ws + WS_WOUT), T_TOK, DM, DMIX, LDPG, SKEW3};
        pg8::StaticOrder S; S.init(T_TOK, DM, (int)gridDim.x, (int)blockIdx.x);
        pg8::EpiResidNorm E{a.in[I_X], a.out, (unsigned*)(a.ws + WS_SS), (unsigned*)(a.ws + WS_CTL + 65536), a.in[I_FG]};
#ifndef SKIP_G2
        pg8::gemm_phase<pg8::EpiResidNorm>(lds, g, S, E);
#endif
    }
}

extern "C" void kernel_launch(void* const* d_in, const int* in_sizes, int n_in, void* d_out, int out_size, void* d_ws, size_t ws_size, hipStream_t stream) {
    static int grid = 0;
    if (grid == 0) {
        if (n_in != 15 || out_size != T_TOK * DM || ws_size < WS_END) { fprintf(stderr, "kernel_launch: unexpected shapes (n_in %d out %d ws %zu)\n", n_in, out_size, ws_size); grid = -1; return; }
        int dev = 0, cus = 0, per_cu = 0;
        hipGetDevice(&dev);
        hipDeviceGetAttribute(&cus, hipDeviceAttributeMultiprocessorCount, dev);
        if (hipFuncSetAttribute((const void*)hymba_fwd, hipFuncAttributeMaxDynamicSharedMemorySize, LDS_BYTES) != hipSuccess) { fprintf(stderr, "kernel_launch: hipFuncSetAttribute failed\n"); grid = -1; return; }
        if (hipOccupancyMaxActiveBlocksPerMultiprocessor(&per_cu, (const void*)hymba_fwd, NTHREADS, LDS_BYTES) != hipSuccess || per_cu < 1) { fprintf(stderr, "kernel_launch: occupancy query says %d\n", per_cu); per_cu = 1; }
        (void)hipGetLastError();
        grid = cus;
        if (grid != 256) { fprintf(stderr, "kernel_launch: built for a 256-CU device (got %d)\n", cus); grid = -1; return; }
    }
    if (grid < 0) return;
    hipMemsetAsync((char*)d_ws + WS_CTL, 0, CTL_BYTES, stream);
    Args a{};
    for (int i = 0; i < 15; ++i) a.in[i] = (const float*)d_in[i];
    a.out = (float*)d_out; a.ws = (unsigned char*)d_ws;
    void* args[] = {&a};
    hipError_t e = hipLaunchCooperativeKernel((const void*)hymba_fwd, dim3(grid), dim3(NTHREADS), args, LDS_BYTES, stream);
    if (e != hipSuccess) fprintf(stderr, "kernel_launch: cooperative launch failed: %s (grid %d)\n", hipGetErrorString(e), grid);
}
```

```cpp
#include <hip/hip_runtime.h>
#include <hip/hip_cooperative_groups.h>
#include <cstdio>
namespace cg = cooperative_groups;

#define LAS __attribute__((address_space(3)))
typedef unsigned short bf16_t;
typedef short bf16x8 __attribute__((ext_vector_type(8)));
typedef float f32x4 __attribute__((ext_vector_type(4)));
typedef float f32x16 __attribute__((ext_vector_type(16)));
typedef unsigned u32x4 __attribute__((ext_vector_type(4)));
typedef unsigned u32x2 __attribute__((ext_vector_type(2)));

constexpr int T_TOK = 32768, SEQ = 4096, DM = 1024, NPROJ = 6144, DMIX = 2048;
constexpr float RMS_EPS = 1e-6f;
constexpr int COL_B = 0, COL_CX = 1024, COL_XL = 2048;
constexpr size_t MiB = 1u << 20;
constexpr size_t WS_CTL = 0, CTL_BYTES = 131072;
constexpr size_t WS_WIN = 2 * MiB;
constexpr size_t WS_WOUT = 14 * MiB;
constexpr size_t WS_WG = 18 * MiB;
constexpr size_t WS_SS = 20 * MiB;
constexpr size_t WS_AGG = 22 * MiB;
constexpr size_t WS_XN = 32 * MiB;
constexpr size_t WS_PROJ = 96 * MiB;
constexpr int LDPA = 3072, LDPG = 2048;
constexpr size_t WS_PROJG = WS_PROJ + (size_t)T_TOK * LDPA * 2;
constexpr size_t WS_END = WS_PROJG + (size_t)T_TOK * LDPG * 2;
static_assert(WS_END <= 480 * MiB, "ws");
constexpr int LDS_BYTES = 148480;
constexpr int LDS_EST = 131072, LDS_CTL = 147456;
constexpr int NTHREADS = 512;
#ifndef REP0
#define REP0 1
#endif
#ifndef REP1
#define REP1 1
#endif
#ifndef REP3
#define REP3 1
#endif
#ifndef CONV_R
#define CONV_R 8
#endif
#ifndef PG8_SP2
#define PG8_SP2 1
#endif
#ifndef PG8_ALIGN
#define PG8_ALIGN 1
#endif
#ifndef SKEW1
#define SKEW1 0
#endif
#ifndef SKEW3
#define SKEW3 0
#endif
#ifndef GL_EARLY
#define GL_EARLY 1
#endif
#ifndef REPLRU
#define REPLRU 1
#endif
#ifndef REPCONV
#define REPCONV 1
#endif

struct Args { const float* in[15]; float* out; unsigned char* ws; };
enum { I_X = 0, I_LNG, I_WIN, I_CONVW, I_LCW, I_LCB, I_WA, I_BA, I_WI, I_BI, I_LAM, I_CG, I_LG, I_WOUT, I_FG };

__device__ __forceinline__ unsigned cvt_pk_bf16(float lo, float hi) { unsigned r; asm volatile("v_cvt_pk_bf16_f32 %0, %1, %2" : "=v"(r) : "v"(lo), "v"(hi)); return r; }
__device__ __forceinline__ float bf_lo(unsigned w) { return __uint_as_float(w << 16); }
__device__ __forceinline__ float bf_hi(unsigned w) { return __uint_as_float(w & 0xffff0000u); }
__device__ __forceinline__ float wave_sum(float v) {
#pragma unroll
    for (int o = 1; o < 64; o <<= 1) v += __shfl_xor(v, o);
    return v;
}
__device__ __forceinline__ float sigmoid_fast(float x) { return __builtin_amdgcn_rcpf(1.0f + __builtin_amdgcn_exp2f(-1.44269504f * x)); }
__device__ __forceinline__ void unpack8(const u32x4 v, float (&f)[8]) {
    f[0] = bf_lo(v.x); f[1] = bf_hi(v.x); f[2] = bf_lo(v.y); f[3] = bf_hi(v.y); f[4] = bf_lo(v.z); f[5] = bf_hi(v.z); f[6] = bf_lo(v.w); f[7] = bf_hi(v.w);
}


#define XB_TMO      128
#define XB_XCNT(j)  (256  + 64 * (j))
#define XB_XSUB(j)  (1280 + 64 * (j))
#define XB_XGEN(j)  (2304 + 64 * (j))
#define XB_TOP      3328
#define XB_TOPGEN   3392
#define XCD_BAR_WORDS 3456
#define XB_SPIN_CAP (1u << 20)
__device__ __forceinline__ unsigned xb_ld(unsigned* p)              { return __hip_atomic_load(p, __ATOMIC_RELAXED, __HIP_MEMORY_SCOPE_AGENT); }
__device__ __forceinline__ unsigned xb_add(unsigned* p, unsigned v) { return __hip_atomic_fetch_add(p, v, __ATOMIC_RELAXED, __HIP_MEMORY_SCOPE_AGENT); }
__device__ __forceinline__ unsigned xb_xcc_id() { return (unsigned)__builtin_amdgcn_s_getreg((3 << 11) | 20) & 0xFu; }
#define XB_SPIN(cond, bar) do { unsigned _sp = 0; while (cond) { __builtin_amdgcn_s_sleep(1); \
    if ((++_sp & 255u) == 0u) { if (xb_ld(&(bar)[XB_TMO])) break; if (_sp > XB_SPIN_CAP) { atomicAdd(&(bar)[XB_TMO], 1u); break; } } } } while (0)
struct XcdBarrier { unsigned* bar; unsigned x; volatile LAS unsigned* st; };
__device__ __forceinline__ XcdBarrier xcd_barrier_post(unsigned* bar, volatile LAS unsigned* st) {
    XcdBarrier b; b.bar = bar; b.x = xb_xcc_id(); b.st = st;
    if (threadIdx.x == 0) (void)xb_add(&bar[XB_XCNT(b.x)], 1u);
    return b;
}
__device__ __forceinline__ void xcd_barrier_complete(unsigned* bar, unsigned x, unsigned& nloc, unsigned& nx) {
    const unsigned G = gridDim.x * gridDim.y * gridDim.z;
    unsigned sum, cnt, mine, sp = 0u;
    for (;;) {
        sum = 0u; cnt = 0u; mine = 0u;
#pragma unroll
        for (unsigned j = 0; j < 16; ++j) { const unsigned c = xb_ld(&bar[XB_XCNT(j)]); sum += c; cnt += (c > 0u) ? 1u : 0u; mine = (j == x) ? c : mine; }
        if (sum == G) break;
        __builtin_amdgcn_s_sleep(1);
        if ((++sp & 255u) == 0u) { if (xb_ld(&bar[XB_TMO])) break; if (sp > XB_SPIN_CAP) { atomicAdd(&bar[XB_TMO], 1u); break; } }
    }
    nloc = mine > 0u ? mine : 1u; nx = cnt > 0u ? cnt : 1u;
}
__device__ __forceinline__ void xcd_barrier(const XcdBarrier& b) {
    asm volatile("s_waitcnt vmcnt(0)" ::: "memory");
    __syncthreads();
    if (threadIdx.x == 0) {
        unsigned* bar = b.bar;
        __builtin_amdgcn_s_waitcnt(0);
        unsigned nloc = b.st[0], nx = b.st[1];
        if (nloc == 0u) { xcd_barrier_complete(bar, b.x, nloc, nx); b.st[0] = nloc; b.st[1] = nx; }
        const unsigned old = xb_add(&bar[XB_XSUB(b.x)], 1u);
        const unsigned gen = old / nloc;
        if (old + 1u == (gen + 1u) * nloc) {
            __builtin_amdgcn_fence(__ATOMIC_RELEASE, "agent");
            asm volatile("s_waitcnt vmcnt(0)" ::: "memory");
            const unsigned og = xb_add(&bar[XB_TOP], 1u);
            const unsigned tg = og / nx;
            if (og + 1u == (tg + 1u) * nx) xb_add(&bar[XB_TOPGEN], 1u);
            else XB_SPIN(xb_ld(&bar[XB_TOPGEN]) == tg, bar);
            __builtin_amdgcn_fence(__ATOMIC_ACQUIRE, "agent");
            xb_add(&bar[XB_XGEN(b.x)], 1u);
            asm volatile("s_waitcnt vmcnt(0)" ::: "memory");
        } else {
            XB_SPIN(xb_ld(&bar[XB_XGEN(b.x)]) == gen, bar);
            __builtin_amdgcn_fence(__ATOMIC_ACQUIRE, "agent");
            asm volatile("s_waitcnt vmcnt(0)" ::: "memory");
        }
    }
    __syncthreads();
}

namespace pg8 {
constexpr int BM = 256, BK = 64, HALF = 128, HTB = HALF * BK * 2, STAGE_BYTES = 8 * HTB, NXCD = 8, WGM = 8;
__host__ __device__ __forceinline__ int lds_byte(int r, int c) { const int st = (r >> 4) * 2 + (c >> 5), rr = r & 15, cc = c & 31, ob = rr * 64 + cc * 2; return st * 1024 + (ob ^ (((ob >> 9) & 1) << 5)); }
__host__ __device__ __forceinline__ void stage_rc(int b, int& R, int& C) { const int st = b / 1024, sb = b % 1024, swz = sb ^ (((sb >> 9) & 1) << 5); R = (st >> 1) * 16 + swz / 64; C = (st & 1) * 32 + (swz % 64) / 2; }
__host__ __device__ __forceinline__ int perm32(int rho) { const int n = rho >> 4, i = rho & 15; return 8 * (i >> 2) + 4 * n + (i & 3); }

struct Unit { int pm, pn; };
struct Gemm { const bf16_t* A; const bf16_t* Bt; int M, N, K, lda; int skew; };

struct StaticOrder {
    int nM, nN, nwg, G, c;
    __device__ void init(int M, int N, int G_, int c_) { nM = M / BM; nN = N / BM; nwg = nM * nN; G = G_; c = c_; }
    __device__ bool next(int i, Unit& u) const {
        const long L = (long)i * G + c; if (L >= nwg) return false;
        int wgid = (int)L; { const int q = nwg / NXCD, r = nwg % NXCD, xcd = wgid % NXCD, off = wgid / NXCD; wgid = (xcd < r ? xcd * (q + 1) : r * (q + 1) + (xcd - r) * q) + off; }
        const int nig = WGM * nN, gid = wgid / nig, fm = gid * WGM, gsz = (nM - fm) < WGM ? (nM - fm) : WGM;
        u.pm = fm + ((wgid % nig) % gsz); u.pn = (wgid % nig) / gsz; return true;
    }
};

struct EpiBf16 {
    static constexpr bool PERM = true;
    bf16_t* O; int ldc; bf16_t* O2; int ldc2;
    __device__ __forceinline__ void init(f32x4 (&acc)[2][2][4][2], const Unit&, int, int, int, int) const {
#pragma unroll
        for (int a = 0; a < 2; ++a)
#pragma unroll
            for (int b = 0; b < 2; ++b)
#pragma unroll
                for (int m = 0; m < 4; ++m)
#pragma unroll
                    for (int n = 0; n < 2; ++n) acc[a][b][m][n] = (f32x4){0.f, 0.f, 0.f, 0.f};
    }
    LAS unsigned char* est;
    __device__ __forceinline__ void operator()(f32x4 (&acc)[2][2][4][2], const Unit& u, int wr, int wc, int fr, int fq) const {
        const int lane = fq * 16 + fr; const int pn = u.pn;
        const int rbase = u.pm * BM + wr * 64;
        if (pn >= 4 && pn < 12) {
            const int rrow = lane >> 2, rch = lane & 3;
            bf16_t* gp = O + (size_t)(rbase + rrow) * ldc + 1024 + 128 * (pn - 4) + 32 * wc + rch * 8;
#pragma unroll
            for (int ai = 0; ai < 2; ++ai)
#pragma unroll
                for (int m = 0; m < 4; ++m) {
#pragma unroll
                    for (int bj = 0; bj < 2; ++bj) { const f32x4 p = acc[ai][bj][m][0] * acc[ai][bj][m][1];
                        u32x2 w; w.x = cvt_pk_bf16(p[0], p[1]); w.y = cvt_pk_bf16(p[2], p[3]);
                        const int chunk = 2 * bj + (fq >> 1);
                        *(LAS u32x2*)(est + fr * 64 + ((chunk ^ ((fr >> 1) & 3)) * 16) + (fq & 1) * 8) = w; }
                    const u32x4 v = *(LAS const u32x4*)(est + rrow * 64 + ((rch ^ ((rrow >> 1) & 3)) * 16));
                    *(u32x4*)(gp + (size_t)(ai * HALF + m * 16) * ldc) = v; }
        } else {
            const bool second = pn >= 16;
            const int colt = (second ? (pn - 16) * BM : (pn >= 12 ? 2048 + (pn - 12) * BM : pn * BM)) + wc * 64;
            bf16_t* Ob = second ? O2 : O; const int ld = second ? ldc2 : ldc;
            const int rrow = lane >> 3, rch = lane & 7;
            bf16_t* gp = Ob + (size_t)(rbase + rrow) * ld + colt + rch * 8;
#pragma unroll
            for (int ai = 0; ai < 2; ++ai)
#pragma unroll
                for (int m = 0; m < 4; ++m) {
#pragma unroll
                    for (int bj = 0; bj < 2; ++bj) { f32x4 v0 = acc[ai][bj][m][0], v1 = acc[ai][bj][m][1];
                        if (second) {
#pragma unroll
                            for (int i = 0; i < 4; ++i) { v0[i] = v0[i] * sigmoid_fast(v0[i]); v1[i] = v1[i] * sigmoid_fast(v1[i]); } }
                        u32x4 w; w.x = cvt_pk_bf16(v0[0], v0[1]); w.y = cvt_pk_bf16(v0[2], v0[3]); w.z = cvt_pk_bf16(v1[0], v1[1]); w.w = cvt_pk_bf16(v1[2], v1[3]);
                        *(LAS u32x4*)(est + fr * 128 + (((4 * bj + fq) ^ (fr & 7)) * 16)) = w; }
#pragma unroll
                    for (int p = 0; p < 2; ++p) { const int row = p * 8 + rrow;
                        const u32x4 v = *(LAS const u32x4*)(est + row * 128 + ((rch ^ (row & 7)) * 16));
                        *(u32x4*)(gp + (size_t)(ai * HALF + m * 16 + p * 8) * ld) = v; } }
        }
    }
};
struct EpiResidNorm {
    static constexpr bool PERM = false;
    const float* x; float* out; unsigned* ss; unsigned* cnt; const float* fg;
    __device__ __forceinline__ void init(f32x4 (&acc)[2][2][4][2], const Unit& u, int wr, int wc, int fr, int fq) const {
        const int row0 = u.pm * BM + wr * 64 + fr, col0 = u.pn * BM + wc * 32 + 4 * fq;
#pragma unroll
        for (int ai = 0; ai < 2; ++ai)
#pragma unroll
            for (int m = 0; m < 4; ++m) { const size_t off = (size_t)(row0 + ai * HALF + m * 16) * DM + col0;
#pragma unroll
                for (int bj = 0; bj < 2; ++bj)
#pragma unroll
                    for (int n = 0; n < 2; ++n) acc[ai][bj][m][n] = __builtin_nontemporal_load((const f32x4*)(x + off + bj * HALF + n * 16)); }
    }
    __device__ __forceinline__ void operator()(f32x4 (&acc)[2][2][4][2], const Unit& u, int wr, int wc, int fr, int fq) const {
        const int row0 = u.pm * BM + wr * 64 + fr, col0 = u.pn * BM + wc * 32 + 4 * fq;
#pragma unroll
        for (int ai = 0; ai < 2; ++ai)
#pragma unroll
            for (int m = 0; m < 4; ++m) { const int row = row0 + ai * HALF + m * 16; const size_t off = (size_t)row * DM + col0; float s = 0.f;
#pragma unroll
                for (int bj = 0; bj < 2; ++bj)
#pragma unroll
                    for (int n = 0; n < 2; ++n) { const f32x4 o = acc[ai][bj][m][n]; s += (o[0] * o[0] + o[1] * o[1]) + (o[2] * o[2] + o[3] * o[3]); }
                s += __shfl_xor(s, 16); s += __shfl_xor(s, 32);
                if (fq == 0) __hip_atomic_store(ss + (size_t)row * 16 + u.pn * 4 + wc, __float_as_uint(s), __ATOMIC_RELAXED, __HIP_MEMORY_SCOPE_AGENT); }
        asm volatile("s_waitcnt vmcnt(0)" ::: "memory");
        unsigned* c = cnt + (u.pm * 2 + wr) * 32;
        if ((threadIdx.x & 63) == 0) __hip_atomic_fetch_add(c, 1u, __ATOMIC_RELAXED, __HIP_MEMORY_SCOPE_AGENT);
        { unsigned spins = 0;
          while ((unsigned)__builtin_amdgcn_readfirstlane(__hip_atomic_load(c, __ATOMIC_RELAXED, __HIP_MEMORY_SCOPE_AGENT)) < 16u) { __builtin_amdgcn_s_sleep(2); if (++spins > (1u << 22)) break; } }
        asm volatile("" ::: "memory");
#pragma unroll
        for (int ai = 0; ai < 2; ++ai)
#pragma unroll
            for (int m = 0; m < 4; ++m) { const int row = row0 + ai * HALF + m * 16; const size_t off = (size_t)row * DM + col0;
                const unsigned long long* sp = (const unsigned long long*)(ss + (size_t)row * 16 + fq * 4);
                const unsigned long long p0 = __hip_atomic_load(sp, __ATOMIC_RELAXED, __HIP_MEMORY_SCOPE_AGENT), p1 = __hip_atomic_load(sp + 1, __ATOMIC_RELAXED, __HIP_MEMORY_SCOPE_AGENT);
                float t = (__uint_as_float((unsigned)p0) + __uint_as_float((unsigned)(p0 >> 32))) + (__uint_as_float((unsigned)p1) + __uint_as_float((unsigned)(p1 >> 32)));
                t += __shfl_xor(t, 16); t += __shfl_xor(t, 32);
                const float rstd = 1.0f / sqrtf(t * (1.f / DM) + RMS_EPS);
#pragma unroll
                for (int bj = 0; bj < 2; ++bj)
#pragma unroll
                    for (int n = 0; n < 2; ++n) { const f32x4 gv = *(const f32x4*)(fg + col0 + bj * HALF + n * 16);
                        *(f32x4*)(out + off + bj * HALF + n * 16) = acc[ai][bj][m][n] * rstd * gv; } }
    }
};

template <class Epi>
__device__ __forceinline__ void gemm_phase(LAS unsigned char* lds, const Gemm g, const StaticOrder& S, const Epi& E) {
    const int tid = threadIdx.x, wid = __builtin_amdgcn_readfirstlane(tid >> 6), lane = tid & 63, wr = wid >> 2, wc = wid & 3, fr = lane & 15, fq = lane >> 4;
    const int K = g.K, nt = K / BK, lda = g.lda;
    unsigned voffA[2], voffB[2];
#pragma unroll
    for (int i = 0; i < 2; ++i) { int R, C; stage_rc(tid * 16 + i * 8192, R, C); const int Rb = Epi::PERM ? ((R & ~31) + perm32(R & 31)) : R;
        voffA[i] = (unsigned)(R * lda + C) * 2u; voffB[i] = (unsigned)(Rb * K + C) * 2u; }
    const size_t kstep = (size_t)(BK * 2);
    const size_t hstepA = (size_t)HALF * lda * 2, hstepB = (size_t)HALF * K * 2;
    const size_t tstepA = 2 * hstepA, tstepB = 2 * hstepB;
    const unsigned ldsw = (unsigned)wid * 1024u;
    const int aoff = lds_byte(wr * 64 + fr, fq * 8), boff = lds_byte(wc * 32 + fr, fq * 8);
#define PG8_SA(b, h) (((b) * 2 + (h)) * HTB)
#define PG8_SB(b, h) ((4 + (b) * 2 + (h)) * HTB)
#define PG8_STAGE(bufoff, gbase, voff) do { _Pragma("unroll") for (int _i = 0; _i < 2; ++_i) \
        __builtin_amdgcn_global_load_lds((const unsigned*)((const char*)(gbase) + (voff)[_i]), (LAS unsigned*)(lds + (bufoff) + ldsw + _i * 8192), 16, 0, 0); } while (0)
#define PG8_LDA(dst, b, h) do { _Pragma("unroll") for (int m = 0; m < 4; ++m) _Pragma("unroll") for (int k = 0; k < 2; ++k) dst[m][k] = *(const LAS bf16x8*)(lds + PG8_SA(b, h) + aoff + m * 2048 + k * 1024); } while (0)
#define PG8_LDB(dst, b, h) do { _Pragma("unroll") for (int n = 0; n < 2; ++n) _Pragma("unroll") for (int k = 0; k < 2; ++k) dst[n][k] = *(const LAS bf16x8*)(lds + PG8_SB(b, h) + boff + n * 2048 + k * 1024); } while (0)
#define PG8_MMA(ai, bj, At, Bt) do { __builtin_amdgcn_s_setprio(1); _Pragma("unroll") for (int m = 0; m < 4; ++m) _Pragma("unroll") for (int n = 0; n < 2; ++n) _Pragma("unroll") for (int k = 0; k < 2; ++k) \
        acc[ai][bj][m][n] = __builtin_amdgcn_mfma_f32_16x16x32_bf16(Bt[n][k], At[m][k], acc[ai][bj][m][n], 0, 0, 0); __builtin_amdgcn_s_setprio(0); } while (0)
#define PG8_WAIT_V(n) asm volatile("s_waitcnt vmcnt(" #n ")" ::: "memory")
#define PG8_WAIT_L(n) asm volatile("s_waitcnt lgkmcnt(" #n ")" ::: "memory")
#define PG8_BAR __builtin_amdgcn_s_barrier()
#define PG8_SCHED __builtin_amdgcn_sched_barrier(0)
    Unit cur, nxt; int ui = 0;
    if (!S.next(0, cur)) return;
    if (g.skew > 0) { const unsigned long long t0 = __builtin_amdgcn_s_memrealtime(), dt = (unsigned long long)((blockIdx.x & 7u) * (unsigned)g.skew);
        while (__builtin_amdgcn_s_memrealtime() - t0 < dt) __builtin_amdgcn_s_sleep(8); }
    f32x4 acc[2][2][4][2];
    E.init(acc, cur, wr, wc, fr, fq);
    bf16x8 At[4][2], B0[2][2], B1[2][2];
    const char* cA = (const char*)g.A + (size_t)cur.pm * tstepA; const char* cB = (const char*)g.Bt + (size_t)cur.pn * tstepB;
#if PG8_SP2
    PG8_STAGE(PG8_SB(0, 0), cB, voffB); PG8_STAGE(PG8_SB(0, 1), cB + hstepB, voffB); PG8_STAGE(PG8_SA(0, 0), cA, voffA); PG8_STAGE(PG8_SA(0, 1), cA + hstepA, voffA);
    if (wr == 1) PG8_BAR;
    PG8_WAIT_V(2); PG8_BAR;
    PG8_STAGE(PG8_SB(1, 0), cB + kstep, voffB); PG8_STAGE(PG8_SA(1, 0), cA + kstep, voffA); PG8_STAGE(PG8_SB(1, 1), cB + hstepB + kstep, voffB);
    PG8_WAIT_V(6); PG8_BAR;
#else
    PG8_STAGE(PG8_SB(0, 0), cB, voffB); PG8_STAGE(PG8_SA(0, 0), cA, voffA); PG8_STAGE(PG8_SB(0, 1), cB + hstepB, voffB); PG8_STAGE(PG8_SA(0, 1), cA + hstepA, voffA);
    if (wr == 1) PG8_BAR;
    PG8_WAIT_V(4); PG8_BAR;
    PG8_STAGE(PG8_SB(1, 0), cB + kstep, voffB); PG8_STAGE(PG8_SA(1, 0), cA + kstep, voffA); PG8_STAGE(PG8_SB(1, 1), cB + hstepB + kstep, voffB);
    PG8_WAIT_V(6); PG8_BAR;
#endif
    for (;;) {
        const bool has_next = S.next(ui + 1, nxt);
        const char* nA = has_next ? (const char*)g.A + (size_t)nxt.pm * tstepA : cA; const char* nB = has_next ? (const char*)g.Bt + (size_t)nxt.pn * tstepB : cB;
        for (int t = 0; t < nt; t += 2) {
            const bool last = (t == nt - 2);
            const char* a1 = cA + (size_t)(t + 1) * kstep;
            const char* a2 = last ? nA : cA + (size_t)(t + 2) * kstep; const char* b2 = last ? nB : cB + (size_t)(t + 2) * kstep;
            const char* a3 = a2 + kstep; const char* b3 = b2 + kstep;
#if PG8_SP2
            PG8_LDB(B0, 0, 0); PG8_LDB(B1, 0, 1); PG8_SCHED; PG8_LDA(At, 0, 0); PG8_STAGE(PG8_SA(1, 1), a1 + hstepA, voffA);
            PG8_WAIT_V(8); PG8_WAIT_L(0); PG8_BAR; PG8_MMA(0, 0, At, B0); PG8_MMA(0, 1, At, B1); PG8_BAR; PG8_SCHED;
            PG8_LDA(At, 0, 1); PG8_STAGE(PG8_SB(0, 0), b2, voffB); PG8_STAGE(PG8_SB(0, 1), b2 + hstepB, voffB); PG8_STAGE(PG8_SA(0, 0), a2, voffA);
            PG8_WAIT_V(8); PG8_WAIT_L(0); PG8_BAR; PG8_MMA(1, 0, At, B0); PG8_MMA(1, 1, At, B1); PG8_BAR; PG8_SCHED;
            PG8_LDB(B0, 1, 0); PG8_LDB(B1, 1, 1); PG8_SCHED; PG8_LDA(At, 1, 0); PG8_STAGE(PG8_SA(0, 1), a2 + hstepA, voffA);
            PG8_WAIT_V(8); PG8_WAIT_L(0); PG8_BAR; PG8_MMA(0, 0, At, B0); PG8_MMA(0, 1, At, B1); PG8_BAR; PG8_SCHED;
            PG8_LDA(At, 1, 1); PG8_STAGE(PG8_SB(1, 0), b3, voffB); PG8_STAGE(PG8_SB(1, 1), b3 + hstepB, voffB); PG8_STAGE(PG8_SA(1, 0), a3, voffA);
            PG8_WAIT_V(8); PG8_WAIT_L(0); PG8_BAR; PG8_MMA(1, 0, At, B0); PG8_MMA(1, 1, At, B1); PG8_BAR; PG8_SCHED;
#else
            PG8_LDB(B0, 0, 0); PG8_SCHED; PG8_LDA(At, 0, 0); PG8_STAGE(PG8_SA(1, 1), a1 + hstepA, voffA);
            PG8_WAIT_L(8); PG8_BAR; PG8_WAIT_L(0); PG8_MMA(0, 0, At, B0); PG8_BAR; PG8_SCHED;
            PG8_LDB(B1, 0, 1); PG8_STAGE(PG8_SB(0, 0), b2, voffB);
            PG8_BAR; PG8_WAIT_L(0); PG8_MMA(0, 1, At, B1); PG8_BAR;
            PG8_LDA(At, 0, 1); PG8_STAGE(PG8_SA(0, 0), a2, voffA);
            PG8_BAR; PG8_WAIT_L(0); PG8_MMA(1, 0, At, B0); PG8_BAR; PG8_SCHED;
            PG8_STAGE(PG8_SB(0, 1), b2 + hstepB, voffB);
            PG8_WAIT_V(6); PG8_BAR; PG8_MMA(1, 1, At, B1); PG8_BAR;
            PG8_LDB(B0, 1, 0); PG8_SCHED; PG8_LDA(At, 1, 0); PG8_STAGE(PG8_SA(0, 1), a2 + hstepA, voffA);
            PG8_WAIT_L(8); PG8_BAR; PG8_WAIT_L(0); PG8_MMA(0, 0, At, B0); PG8_BAR; PG8_SCHED;
            PG8_LDB(B1, 1, 1); PG8_STAGE(PG8_SB(1, 0), b3, voffB);
            PG8_BAR; PG8_WAIT_L(0); PG8_MMA(0, 1, At, B1); PG8_BAR;
            PG8_LDA(At, 1, 1); PG8_STAGE(PG8_SA(1, 0), a3, voffA);
            PG8_BAR; PG8_WAIT_L(0); PG8_MMA(1, 0, At, B0); PG8_BAR; PG8_SCHED;
            PG8_STAGE(PG8_SB(1, 1), b3 + hstepB, voffB);
            PG8_WAIT_V(6); PG8_BAR; PG8_MMA(1, 1, At, B1); PG8_BAR;
#endif
        }
#if PG8_ALIGN
        if (wr == 0) PG8_BAR;
#endif
        E(acc, cur, wr, wc, fr, fq);
        if (!has_next) break;
        cur = nxt; cA = nA; cB = nB; ++ui;
        E.init(acc, cur, wr, wc, fr, fq);
#if PG8_ALIGN
        if (wr == 1) PG8_BAR;
#endif
    }
    PG8_WAIT_V(0);
#if !PG8_ALIGN
    if (wr == 0) PG8_BAR;
#endif
    PG8_BAR;
#undef PG8_SA
#undef PG8_SB
#undef PG8_STAGE
#undef PG8_LDA
#undef PG8_LDB
#undef PG8_MMA
#undef PG8_WAIT_V
#undef PG8_WAIT_L
#undef PG8_BAR
#undef PG8_SCHED
}
}

__device__ __forceinline__ void p0_transpose_item(const float* W, int ldw, int k0, int ncol0, bf16_t* WT, int ldt, int drow0, int dk0, LAS float* scr, int lane, int mode = 0) {
#pragma unroll 8
    for (int i = 0; i < 32; ++i) { const int kk = 2 * i + (lane >> 5); scr[kk * 33 + (lane & 31)] = __builtin_nontemporal_load(W + (size_t)(k0 + kk) * ldw + ncol0 + (lane & 31)); }
    asm volatile("s_waitcnt lgkmcnt(0)" ::: "memory");
    const int c = lane & 7;
#pragma unroll
    for (int j = 0; j < 4; ++j) { const int n = (lane >> 3) + 8 * j; const LAS float* s = scr + (8 * c) * 33 + n;
        u32x4 o; o.x = cvt_pk_bf16(s[0 * 33], s[1 * 33]); o.y = cvt_pk_bf16(s[2 * 33], s[3 * 33]); o.z = cvt_pk_bf16(s[4 * 33], s[5 * 33]); o.w = cvt_pk_bf16(s[6 * 33], s[7 * 33]);
        int drow = drow0 + n;
        if (mode) { const int ch = drow0 + n; drow = 1024 + 256 * (ch >> 7) + 128 * ((ch >> 4) & 1) + 32 * ((ch >> 5) & 3) + 8 * ((ch >> 2) & 3) + 4 * (mode - 1) + (ch & 3); }
        *(u32x4*)(WT + (size_t)drow * ldt + dk0 + 8 * c) = o; }
    asm volatile("s_waitcnt lgkmcnt(0)" ::: "memory");
}

__device__ __forceinline__ void phase0(const Args& a, LAS unsigned char* lds, int wave, int lane) {
    LAS float* scr = (LAS float*)(lds + wave * 16384);
    const int gw = blockIdx.x * 8 + wave, NGW = gridDim.x * 8;
    bf16_t* win_t = (bf16_t*)(a.ws + WS_WIN); bf16_t* wout_t = (bf16_t*)(a.ws + WS_WOUT); bf16_t* wg = (bf16_t*)(a.ws + WS_WG);
    constexpr int I_IN = 16 * 192, I_OUT = 32 * 32, I_G = 64;
    for (int it = gw; it < I_IN + I_OUT + I_G; it += NGW) {
        int r = it;
        if (r < I_IN) { const int kb = r / 192, nb = r % 192; const int og = nb / 32;
            if (og == 1 || og == 2) p0_transpose_item(a.in[I_WIN], NPROJ, kb * 64, nb * 32, win_t, DM, (nb % 32) * 32, kb * 64, scr, lane, og);
            else { const int nbase = (og == 0) ? 0 : (og == 4 ? 3072 : (og == 3 ? 4096 : 5120));
                const int q = nb % 32;
                p0_transpose_item(a.in[I_WIN], NPROJ, kb * 64, nb * 32, win_t, DM, nbase + 256 * (q >> 3) + 128 * (q & 1) + 32 * ((q & 7) >> 1), kb * 64, scr, lane, 0); }
            continue; }
        r -= I_IN;
        if (r < I_OUT) { const int kb = r / 32, nb = r % 32; p0_transpose_item(a.in[I_WOUT], DM, kb * 64, nb * 32, wout_t, DMIX, nb * 32, kb * 64, scr, lane); continue; }
        r -= I_OUT;
        { const int mat = r / 32, h = (r % 32) / 2, nb = r & 1; const float* W = (mat ? a.in[I_WI] : a.in[I_WA]) + h * 4096;
          p0_transpose_item(W, 64, 0, nb * 32, wg + mat * 65536 + h * 4096, 64, nb * 32, 0, scr, lane); }
    }
    const float* x = a.in[I_X]; bf16_t* xn = (bf16_t*)(a.ws + WS_XN);
    f32x4 gv[4];
#pragma unroll
    for (int j = 0; j < 4; ++j) gv[j] = ((const f32x4*)a.in[I_LNG])[lane + 64 * j];
    for (int m = gw; m < T_TOK; m += NGW) {
        const f32x4* xr = (const f32x4*)(x + (size_t)m * DM) + lane;
        f32x4 v[4]; float s = 0.f;
#pragma unroll
        for (int j = 0; j < 4; ++j) { v[j] = __builtin_nontemporal_load(xr + 64 * j); s += (v[j].x * v[j].x + v[j].y * v[j].y) + (v[j].z * v[j].z + v[j].w * v[j].w); }
        const float rstd = 1.0f / sqrtf(wave_sum(s) * (1.f / DM) + RMS_EPS);
        u32x2* o8 = (u32x2*)(xn + (size_t)m * DM) + lane;
#pragma unroll
        for (int j = 0; j < 4; ++j) { u32x2 w; w.x = cvt_pk_bf16(v[j].x * rstd * gv[j].x, v[j].y * rstd * gv[j].y); w.y = cvt_pk_bf16(v[j].z * rstd * gv[j].z, v[j].w * rstd * gv[j].w); o8[64 * j] = w; }
    }
}

#define DPP_ADD(v, ctrl) ((v) + __uint_as_float(__builtin_amdgcn_update_dpp(0, __float_as_uint(v), (ctrl), 0xF, 0xF, false)))
__device__ __forceinline__ void conv_item(const Args& a, bf16_t* proj, bf16_t* projg, bf16_t* obase, int ostride, int item, int wave, int lane) {
    const int q = lane >> 4, c8 = lane & 15, ch0 = wave * 128 + c8 * 8;
    float w0[8], w1[8], w2[8], gn[8];
    { const float* cw = a.in[I_CONVW] + ch0; const float* cg_ = a.in[I_CG] + ch0;
#pragma unroll
      for (int j = 0; j < 8; ++j) { w0[j] = cw[j]; w1[j] = cw[1024 + j]; w2[j] = cw[2048 + j]; gn[j] = cg_[j]; } }
    const int tok0 = item * (4 * CONV_R) + q * CONV_R;
    bf16_t* base = proj + (size_t)tok0 * LDPA + ch0; const bf16_t* gbase = projg + (size_t)tok0 * LDPG + ch0;
    float p2[8], p1[8];
    if ((tok0 & (SEQ - 1)) == 0) {
#pragma unroll
        for (int j = 0; j < 8; ++j) { p2[j] = 0.f; p1[j] = 0.f; }
    } else {
        const u32x4 c2 = *(const u32x4*)(base - 2 * LDPA + COL_CX), c1 = *(const u32x4*)(base - 1 * LDPA + COL_CX);
        unpack8(c2, p2); unpack8(c1, p1);
    }
    u32x4 nb[2], nc[2], ng[2];
#pragma unroll
    for (int k = 0; k < 2; ++k) { const bf16_t* rp = base + (size_t)k * LDPA; nb[k] = __builtin_nontemporal_load((const u32x4*)(rp + COL_B)); nc[k] = __builtin_nontemporal_load((const u32x4*)(rp + COL_CX)); ng[k] = __builtin_nontemporal_load((const u32x4*)(gbase + (size_t)k * LDPG)); }
    for (int i = 0; i < CONV_R; i += 2) {
        u32x4 vb[2], vc[2], vg[2];
#pragma unroll
        for (int k = 0; k < 2; ++k) { vb[k] = nb[k]; vc[k] = nc[k]; vg[k] = ng[k]; }
        if (i + 2 < CONV_R) {
#pragma unroll
            for (int k = 0; k < 2; ++k) { const bf16_t* rp = base + (size_t)(i + 2 + k) * LDPA; nb[k] = __builtin_nontemporal_load((const u32x4*)(rp + COL_B)); nc[k] = __builtin_nontemporal_load((const u32x4*)(rp + COL_CX)); ng[k] = __builtin_nontemporal_load((const u32x4*)(gbase + (size_t)(i + 2 + k) * LDPG)); }
        }
#pragma unroll
        for (int k = 0; k < 2; ++k) {
            float fb[8], cx[8], fg[8], y[8];
            unpack8(vb[k], fb); unpack8(vc[k], cx); unpack8(vg[k], fg);
            float ss = 0.f;
#pragma unroll
            for (int j = 0; j < 8; ++j) { const float cv = w0[j] * p2[j] + w1[j] * p1[j] + w2[j] * cx[j]; y[j] = fb[j] * cv; ss += y[j] * y[j]; p2[j] = p1[j]; p1[j] = cx[j]; }
            ss = DPP_ADD(ss, 0xB1); ss = DPP_ADD(ss, 0x4E); ss = DPP_ADD(ss, 0x141); ss = DPP_ADD(ss, 0x140);
            const float rstd = __builtin_amdgcn_rsqf(ss * (1.f / 128.f) + RMS_EPS);
            float o[8];
#pragma unroll
            for (int j = 0; j < 8; ++j) o[j] = y[j] * rstd * gn[j] * fg[j];
            u32x4 w; w.x = cvt_pk_bf16(o[0], o[1]); w.y = cvt_pk_bf16(o[2], o[3]); w.z = cvt_pk_bf16(o[4], o[5]); w.w = cvt_pk_bf16(o[6], o[7]);
            *(u32x4*)(obase + (size_t)(tok0 + i + k) * ostride + ch0) = w;
        }
    }
}

constexpr int L_GW = 0;
constexpr int L_CW = 18432;
constexpr int L_AGG = 20992;
constexpr int L_WT = 29184;
constexpr int WT_BYTES = 8704;
static_assert(L_WT + 8 * WT_BYTES <= 131072, "lds");
typedef float f32x2 __attribute__((ext_vector_type(2)));

__device__ __forceinline__ void lru_item(const Args& a, bf16_t* proj, bf16_t* projg, bf16_t* obase, int ostride, LAS unsigned char* lds, int chain, int part, int nsplit, int tid, int wave, int lane) {
    const int b = chain >> 4, h = chain & 15;
    {
        const bf16_t* wg = (const bf16_t*)(a.ws + WS_WG);
        for (int i = tid; i < 1024; i += NTHREADS) { const int mat = i >> 9, e = (i >> 3) & 63, c = i & 7;
            const u32x4 v = *(const u32x4*)(wg + mat * 65536 + h * 4096 + e * 64 + c * 8);
            *(LAS u32x4*)(lds + L_GW + mat * 9216 + e * 144 + c * 16) = v; }
        LAS float* cw = (LAS float*)(lds + L_CW);
        if (tid < 256) cw[tid] = a.in[I_LCW][(tid >> 6) * 1024 + h * 64 + (tid & 63)];
        else if (tid < 320) { const int c = tid - 256, gc = h * 64 + c;
            cw[256 + c] = a.in[I_LCB][gc]; cw[320 + c] = a.in[I_BA][gc]; cw[384 + c] = a.in[I_BI][gc];
            const float lam = a.in[I_LAM][gc];
            const float logsig = (lam >= 0.f) ? -log1pf(expf(-lam)) : (lam - log1pf(expf(lam)));
            cw[448 + c] = 8.0f * logsig * 1.44269504f;
            cw[512 + c] = a.in[I_LG][gc]; }
    }
    __syncthreads();
    const int r = lane & 31, hh = lane >> 5;
    LAS unsigned char* wt = lds + L_WT + wave * WT_BYTES;
    LAS const float* cw = (LAS const float*)(lds + L_CW);
    bf16x8 I0, I1;
    {
        u32x4 t0 = (u32x4){0u, 0u, 0u, 0u}, t1 = t0;
        const int j0 = r - 8 * hh, j1 = r - 16 - 8 * hh;
#pragma unroll
        for (int d = 0; d < 4; ++d) {
            t0[d] = (j0 == 2 * d) ? 0x00003F80u : ((j0 == 2 * d + 1) ? 0x3F800000u : 0u);
            t1[d] = (j1 == 2 * d) ? 0x00003F80u : ((j1 == 2 * d + 1) ? 0x3F800000u : 0u);
        }
        I0 = __builtin_bit_cast(bf16x8, t0); I1 = __builtin_bit_cast(bf16x8, t1);
    }
    float ba[2], bi[2], cf[2];
#pragma unroll
    for (int n = 0; n < 2; ++n) { ba[n] = cw[320 + 32 * n + r]; bi[n] = cw[384 + 32 * n + r]; cf[n] = cw[448 + 32 * n + r]; }
    float carry[2] = {0.f, 0.f};
    unsigned* flags = (unsigned*)(a.ws + WS_CTL + 4096) + chain * 32;
    unsigned long long* aggg = (unsigned long long*)(a.ws + WS_AGG) + (size_t)chain * 16 * 64;

    const bf16_t* xl_base = proj + (size_t)b * SEQ * LDPA + COL_XL + h * 64;
    const bf16_t* gl_base = projg + (size_t)b * SEQ * LDPG + 1024 + h * 64;
    u32x4 xr[5];
#define LOAD_X(seg_) do { const int s0_ = (seg_) * 256 + wave * 32; _Pragma("unroll") for (int i = 0; i < 5; ++i) { const int idx = lane + 64 * i, row = idx >> 3, c = idx & 7; const int s = s0_ - 3 + row; \
        xr[i] = (u32x4){0u, 0u, 0u, 0u}; if (idx < 280 && s >= 0) xr[i] = __builtin_nontemporal_load((const u32x4*)(xl_base + (size_t)s * LDPA + c * 8)); } } while (0)
    LOAD_X(part);
    for (int seg = part; seg < 16; seg += nsplit) {
        const int s0 = seg * 256 + wave * 32;
#pragma unroll
        for (int i = 0; i < 5; ++i) { const int idx = lane + 64 * i, row = idx >> 3, c = idx & 7; if (idx < 280) *(LAS u32x4*)(wt + row * 144 + c * 16) = xr[i]; }
        if (seg + nsplit < 16) LOAD_X(seg + nsplit);
        u32x4 gl[4];
#define LOAD_GL() do { _Pragma("unroll") for (int i = 0; i < 4; ++i) { const int tok = (lane >> 3) + 8 * i, c = lane & 7; gl[i] = __builtin_nontemporal_load((const u32x4*)(gl_base + (size_t)(s0 + tok) * LDPG + c * 8)); } } while (0)
#if GL_EARLY
        LOAD_GL();
#endif
        asm volatile("s_waitcnt lgkmcnt(0)" ::: "memory");
        bf16x8 Af[4];
#pragma unroll
        for (int s = 0; s < 4; ++s) {
            const int c0 = 16 * s + 8 * hh;
            float u8[8];
            { const f32x4 b0 = *(LAS const f32x4*)(cw + 256 + c0), b1 = *(LAS const f32x4*)(cw + 256 + c0 + 4);
              u8[0] = b0[0]; u8[1] = b0[1]; u8[2] = b0[2]; u8[3] = b0[3]; u8[4] = b1[0]; u8[5] = b1[1]; u8[6] = b1[2]; u8[7] = b1[3]; }
#pragma unroll
            for (int k = 0; k < 4; ++k) {
                const u32x4 xv = *(LAS const u32x4*)(wt + (r + k) * 144 + c0 * 2);
                const f32x4 wv0 = *(LAS const f32x4*)(cw + k * 64 + c0), wv1 = *(LAS const f32x4*)(cw + k * 64 + c0 + 4);
                float fx[8]; unpack8(xv, fx);
                u8[0] += wv0[0] * fx[0]; u8[1] += wv0[1] * fx[1]; u8[2] += wv0[2] * fx[2]; u8[3] += wv0[3] * fx[3];
                u8[4] += wv1[0] * fx[4]; u8[5] += wv1[1] * fx[5]; u8[6] += wv1[2] * fx[6]; u8[7] += wv1[3] * fx[7];
            }
            u32x4 pk; pk.x = cvt_pk_bf16(u8[0], u8[1]); pk.y = cvt_pk_bf16(u8[2], u8[3]); pk.z = cvt_pk_bf16(u8[4], u8[5]); pk.w = cvt_pk_bf16(u8[6], u8[7]);
            Af[s] = __builtin_bit_cast(bf16x8, pk);
        }
#pragma unroll
        for (int n = 0; n < 2; ++n) {
            float hl[16], pc[16];
            f32x16 accR, accI, accU;
#pragma unroll
            for (int j = 0; j < 16; ++j) { accR[j] = 0.f; accI[j] = 0.f; accU[j] = 0.f; }
#pragma unroll
            for (int s = 0; s < 4; ++s) {
                const bf16x8 Ba = *(LAS const bf16x8*)(lds + L_GW + (32 * n + r) * 144 + (16 * s + 8 * hh) * 2);
                const bf16x8 Bi = *(LAS const bf16x8*)(lds + L_GW + 9216 + (32 * n + r) * 144 + (16 * s + 8 * hh) * 2);
                accR = __builtin_amdgcn_mfma_f32_32x32x16_bf16(Af[s], Ba, accR, 0, 0, 0);
                accI = __builtin_amdgcn_mfma_f32_32x32x16_bf16(Af[s], Bi, accI, 0, 0, 0);
            }
            accU = __builtin_amdgcn_mfma_f32_32x32x16_bf16(Af[2 * n], I0, accU, 0, 0, 0);
            accU = __builtin_amdgcn_mfma_f32_32x32x16_bf16(Af[2 * n + 1], I1, accU, 0, 0, 0);
            float gP[4], gH[4];
#pragma unroll
            for (int g = 0; g < 4; ++g) {
                float P = 1.f, H = 0.f;
#pragma unroll
                for (int i = 0; i < 4; ++i) { const int j = 4 * g + i;
                    const float rr = sigmoid_fast(accR[j] + ba[n]);
                    const float ii = sigmoid_fast(accI[j] + bi[n]);
                    const float l2 = rr * cf[n];
                    const float aa = __builtin_amdgcn_exp2f(l2);
                    const float t = l2 * 1.38629436f;
                    const float em_small = -t * (1.0f + t * (0.5f + t * (0.16666667f + t * 0.041666667f)));
                    const float one_m = (t > -0.0625f) ? em_small : (1.0f - aa * aa);
                    const float dd = __builtin_amdgcn_sqrtf(one_m) * ii * accU[j];
                    H = aa * H + dd; P = P * aa; hl[j] = H; pc[j] = P; }
                gP[g] = P; gH[g] = H;
            }
            float cp = 1.f, ch = 0.f;
#pragma unroll
            for (int g = 0; g < 4; ++g) {
                const auto sp = __builtin_amdgcn_permlane32_swap(__float_as_uint(gP[g]), __float_as_uint(gP[g]), false, false);
                const auto sh = __builtin_amdgcn_permlane32_swap(__float_as_uint(gH[g]), __float_as_uint(gH[g]), false, false);
                const float oP = __uint_as_float(hh ? sp[0] : sp[1]), oH = __uint_as_float(hh ? sh[0] : sh[1]);
                const float P = gP[g], H = gH[g];
                const float A1 = hh ? oP : P, H1 = hh ? oH : H, A2 = hh ? P : oP, H2 = hh ? H : oH;
                const float cp1 = cp * A1, ch1 = A1 * ch + H1;
                const float inP = hh ? cp1 : cp, inH = hh ? ch1 : ch;
#pragma unroll
                for (int i = 0; i < 4; ++i) { const int j = 4 * g + i; hl[j] += pc[j] * inH; pc[j] *= inP; }
                cp = cp1 * A2; ch = A2 * ch1 + H2;
            }
            if (hh == 0) *(LAS f32x2*)(lds + L_AGG + ((n * 8 + wave) * 64 + 32 * n + r) * 8) = (f32x2){cp, ch};
#if !GL_EARLY
            if (n == 1) LOAD_GL();
#endif
            if (nsplit > 1 && seg > 0 && wave == 0) {
                unsigned spins = 0;
                while (__builtin_amdgcn_readfirstlane(__hip_atomic_load(flags + (seg - 1) * 2 + n, __ATOMIC_RELAXED, __HIP_MEMORY_SCOPE_AGENT)) == 0u) { __builtin_amdgcn_s_sleep(2); if (++spins > (1u << 22)) break; }
                asm volatile("" ::: "memory");
            }
            __syncthreads();
            float c = carry[n];
            if (nsplit > 1 && seg > 0) {
                const unsigned long long pw = __hip_atomic_load(aggg + (size_t)(seg - 1) * 64 + n * 32 + r, __ATOMIC_RELAXED, __HIP_MEMORY_SCOPE_AGENT);
                c = __uint_as_float((unsigned)pw) * c + __uint_as_float((unsigned)(pw >> 32));
            }
            float cin = 0.f, iP = 1.f, iH = 0.f;
#pragma unroll
            for (int w = 0; w < 8; ++w) {
                const f32x2 ag = *(LAS const f32x2*)(lds + L_AGG + ((n * 8 + w) * 64 + 32 * n + r) * 8);
                cin = (w == wave) ? c : cin; c = ag.x * c + ag.y; iH = ag.x * iH + ag.y; iP *= ag.x; }
            carry[n] = c;
            if (nsplit > 1 && wave == 0) {
                if (hh == 0) __hip_atomic_store(aggg + (size_t)seg * 64 + n * 32 + r, ((unsigned long long)__float_as_uint(iH) << 32) | __float_as_uint(iP), __ATOMIC_RELAXED, __HIP_MEMORY_SCOPE_AGENT);
                asm volatile("s_waitcnt vmcnt(0)" ::: "memory");
                if (lane == 0) __hip_atomic_store(flags + seg * 2 + n, 1u, __ATOMIC_RELAXED, __HIP_MEMORY_SCOPE_AGENT);
            }
#pragma unroll
            for (int j = 0; j < 16; ++j) { const int row = (j & 3) + 8 * (j >> 2) + 4 * hh;
                *(LAS float*)(wt + row * 272 + (32 * n + r) * 4) = hl[j] + pc[j] * cin; }
        }
        asm volatile("s_waitcnt lgkmcnt(0)" ::: "memory");
#pragma unroll
        for (int i = 0; i < 4; ++i) {
            const int tok = (lane >> 3) + 8 * i, c = lane & 7;
            const f32x4 h0 = *(LAS const f32x4*)(wt + tok * 272 + c * 32), h1 = *(LAS const f32x4*)(wt + tok * 272 + c * 32 + 16);
            const f32x4 g0 = *(LAS const f32x4*)(cw + 512 + c * 8), g1 = *(LAS const f32x4*)(cw + 512 + c * 8 + 4);
            float ss = (h0[0] * h0[0] + h0[1] * h0[1]) + (h0[2] * h0[2] + h0[3] * h0[3]) + (h1[0] * h1[0] + h1[1] * h1[1]) + (h1[2] * h1[2] + h1[3] * h1[3]);
            ss = DPP_ADD(ss, 0xB1); ss = DPP_ADD(ss, 0x4E); ss = DPP_ADD(ss, 0x141);
            const float rstd = __builtin_amdgcn_rsqf(ss * (1.f / 64.f) + RMS_EPS);
            float fg[8]; unpack8(gl[i], fg);
            float o[8];
            o[0] = h0[0] * rstd * g0[0]; o[1] = h0[1] * rstd * g0[1]; o[2] = h0[2] * rstd * g0[2]; o[3] = h0[3] * rstd * g0[3];
            o[4] = h1[0] * rstd * g1[0]; o[5] = h1[1] * rstd * g1[1]; o[6] = h1[2] * rstd * g1[2]; o[7] = h1[3] * rstd * g1[3];
#pragma unroll
            for (int j = 0; j < 8; ++j) o[j] *= fg[j];
            u32x4 w; w.x = cvt_pk_bf16(o[0], o[1]); w.y = cvt_pk_bf16(o[2], o[3]); w.z = cvt_pk_bf16(o[4], o[5]); w.w = cvt_pk_bf16(o[6], o[7]);
            *(u32x4*)(obase + (size_t)(b * SEQ + s0 + tok) * ostride + h * 64 + c * 8) = w;
        }
        asm volatile("s_waitcnt lgkmcnt(0)" ::: "memory");
    }
#undef LOAD_X
    __syncthreads();
}

__global__ void __launch_bounds__(NTHREADS, 2) hymba_fwd(Args a) {
    extern __shared__ __attribute__((aligned(16))) unsigned char lds_raw[];
    LAS unsigned char* lds = (LAS unsigned char*)lds_raw;
    cg::grid_group grid = cg::this_grid();
    if (gridDim.y == 0x7fffu) grid.sync();
    volatile LAS unsigned* bst = (volatile LAS unsigned*)(lds + LDS_CTL + 64);
    if (threadIdx.x == 0) { bst[0] = 0u; bst[1] = 0u; }
    __syncthreads();
    const XcdBarrier bar = xcd_barrier_post((unsigned*)(a.ws + WS_CTL + 32768), bst);
    const int tid = threadIdx.x, lane = tid & 63, wave = __builtin_amdgcn_readfirstlane(tid >> 6);
    bf16_t* proj = (bf16_t*)(a.ws + WS_PROJ); bf16_t* projg = (bf16_t*)(a.ws + WS_PROJG);

#pragma unroll
    for (int rep = 0; rep < REP0; ++rep) {
#ifndef SKIP_P0
    phase0(a, lds, wave, lane);
#endif

    xcd_barrier(bar); }
#pragma unroll
    for (int rep = 0; rep < REP1; ++rep) {
        pg8::Gemm g{(const bf16_t*)(a.ws + WS_XN), (const bf16_t*)(a.ws + WS_WIN), T_TOK, NPROJ, DM, DM, SKEW1};
        pg8::StaticOrder S; S.init(T_TOK, NPROJ, (int)gridDim.x, (int)blockIdx.x);
        pg8::EpiBf16 E{proj, LDPA, projg, LDPG, lds + LDS_EST + wave * 2048};
#ifndef SKIP_G1
        pg8::gemm_phase<pg8::EpiBf16>(lds, g, S, E);
#endif
    xcd_barrier(bar); }
    {
#ifndef SKIP_LRU
        if (gridDim.x >= 256) { if (blockIdx.x < 256) lru_item(a, proj, projg, projg + 1024, LDPG, lds, (int)blockIdx.x >> 1, (int)blockIdx.x & 1, 2, tid, wave, lane); }
        else for (int it = blockIdx.x; it < 128; it += gridDim.x) lru_item(a, proj, projg, projg + 1024, LDPG, lds, it, 0, 1, tid, wave, lane);
#endif
        LAS unsigned* qs = (LAS unsigned*)(lds + LDS_CTL);
        unsigned* qctr = (unsigned*)(a.ws + WS_CTL);
        for (;;) {
            if (tid == 0) qs[0] = atomicAdd(qctr, 1u);
            __syncthreads();
            const unsigned it = qs[0];
            __syncthreads();
            if (it >= (unsigned)(T_TOK / (4 * CONV_R))) break;
#ifndef SKIP_CONV
            conv_item(a, proj, projg, projg, LDPG, (int)it, wave, lane);
#endif
        }
    }
    xcd_barrier(bar);
#pragma unroll
    for (int rep = 0; rep < REP3; ++rep) {
        pg8::Gemm g{projg, (const bf16_t*)(a.ws + WS_WOUT), T_TOK, DM, DMIX, LDPG, SKEW3};
        pg8::StaticOrder S; S.init(T_TOK, DM, (int)gridDim.x, (int)blockIdx.x);
        pg8::EpiResidNorm E{a.in[I_X], a.out, (unsigned*)(a.ws + WS_SS), (unsigned*)(a.ws + WS_CTL + 65536), a.in[I_FG]};
#ifndef SKIP_G2
        pg8::gemm_phase<pg8::EpiResidNorm>(lds, g, S, E);
#endif
    }
}

extern "C" void kernel_launch(void* const* d_in, const int* in_sizes, int n_in, void* d_out, int out_size, void* d_ws, size_t ws_size, hipStream_t stream) {
    static int grid = 0;
    if (grid == 0) {
        if (n_in != 15 || out_size != T_TOK * DM || ws_size < WS_END) { fprintf(stderr, "kernel_launch: unexpected shapes (n_in %d out %d ws %zu)\n", n_in, out_size, ws_size); grid = -1; return; }
        int dev = 0, cus = 0, per_cu = 0;
        hipGetDevice(&dev);
        hipDeviceGetAttribute(&cus, hipDeviceAttributeMultiprocessorCount, dev);
        if (hipFuncSetAttribute((const void*)hymba_fwd, hipFuncAttributeMaxDynamicSharedMemorySize, LDS_BYTES) != hipSuccess) { fprintf(stderr, "kernel_launch: hipFuncSetAttribute failed\n"); grid = -1; return; }
        if (hipOccupancyMaxActiveBlocksPerMultiprocessor(&per_cu, (const void*)hymba_fwd, NTHREADS, LDS_BYTES) != hipSuccess || per_cu < 1) { fprintf(stderr, "kernel_launch: occupancy query says %d\n", per_cu); per_cu = 1; }
        (void)hipGetLastError();
        grid = cus;
        if (grid != 256) { fprintf(stderr, "kernel_launch: built for a 256-CU device (got %d)\n", cus); grid = -1; return; }
    }
    if (grid < 0) return;
    hipMemsetAsync((char*)d_ws + WS_CTL, 0, CTL_BYTES, stream);
    Args a{};
    for (int i = 0; i < 15; ++i) a.in[i] = (const float*)d_in[i];
    a.out = (float*)d_out; a.ws = (unsigned char*)d_ws;
    void* args[] = {&a};
    hipError_t e = hipLaunchCooperativeKernel((const void*)hymba_fwd, dim3(grid), dim3(NTHREADS), args, LDS_BYTES, stream);
    if (e != hipSuccess) fprintf(stderr, "kernel_launch: cooperative launch failed: %s (grid %d)\n", hipGetErrorString(e), grid);
}
```

```cpp
#include <hip/hip_runtime.h>
#include <hip/hip_cooperative_groups.h>
#include <cstdio>
namespace cg = cooperative_groups;

#define LAS __attribute__((address_space(3)))
typedef unsigned short bf16_t;
typedef short bf16x8 __attribute__((ext_vector_type(8)));
typedef float f32x4 __attribute__((ext_vector_type(4)));
typedef float f32x16 __attribute__((ext_vector_type(16)));
typedef unsigned u32x4 __attribute__((ext_vector_type(4)));
typedef unsigned u32x2 __attribute__((ext_vector_type(2)));

constexpr int T_TOK = 32768, SEQ = 4096, DM = 1024, NPROJ = 6144, DMIX = 2048;
constexpr float RMS_EPS = 1e-6f;
constexpr int COL_B = 0, COL_CX = 1024, COL_XL = 2048;
constexpr size_t MiB = 1u << 20;
constexpr size_t WS_CTL = 0, CTL_BYTES = 131072;
constexpr size_t WS_WIN = 2 * MiB;
constexpr size_t WS_WOUT = 14 * MiB;
constexpr size_t WS_WG = 18 * MiB;
constexpr size_t WS_SS = 20 * MiB;
constexpr size_t WS_AGG = 22 * MiB;
constexpr size_t WS_XN = 32 * MiB;
constexpr size_t WS_PROJ = 96 * MiB;
constexpr int LDPA = 3072, LDPG = 2048;
constexpr size_t WS_PROJG = WS_PROJ + (size_t)T_TOK * LDPA * 2;
constexpr size_t WS_END = WS_PROJG + (size_t)T_TOK * LDPG * 2;
static_assert(WS_END <= 480 * MiB, "ws");
constexpr int LDS_BYTES = 148480;
constexpr int LDS_EST = 131072, LDS_CTL = 147456;
constexpr int NTHREADS = 512;
#ifndef REP0
#define REP0 1
#endif
#ifndef REP1
#define REP1 1
#endif
#ifndef REP3
#define REP3 1
#endif
#ifndef CONV_R
#define CONV_R 8
#endif
#ifndef PG8_SP2
#define PG8_SP2 1
#endif
#ifndef PG8_ALIGN
#define PG8_ALIGN 1
#endif
#ifndef SKEW1
#define SKEW1 0
#endif
#ifndef SKEW3
#define SKEW3 0
#endif
#ifndef GL_EARLY
#define GL_EARLY 1
#endif
#ifndef REPLRU
#define REPLRU 1
#endif
#ifndef REPCONV
#define REPCONV 1
#endif

struct Args { const float* in[15]; float* out; unsigned char* ws; };
enum { I_X = 0, I_LNG, I_WIN, I_CONVW, I_LCW, I_LCB, I_WA, I_BA, I_WI, I_BI, I_LAM, I_CG, I_LG, I_WOUT, I_FG };

__device__ __forceinline__ unsigned cvt_pk_bf16(float lo, float hi) { unsigned r; asm volatile("v_cvt_pk_bf16_f32 %0, %1, %2" : "=v"(r) : "v"(lo), "v"(hi)); return r; }
__device__ __forceinline__ float bf_lo(unsigned w) { return __uint_as_float(w << 16); }
__device__ __forceinline__ float bf_hi(unsigned w) { return __uint_as_float(w & 0xffff0000u); }
__device__ __forceinline__ float wave_sum(float v) {
#pragma unroll
    for (int o = 1; o < 64; o <<= 1) v += __shfl_xor(v, o);
    return v;
}
__device__ __forceinline__ float sigmoid_fast(float x) { return __builtin_amdgcn_rcpf(1.0f + __builtin_amdgcn_exp2f(-1.44269504f * x)); }
__device__ __forceinline__ void unpack8(const u32x4 v, float (&f)[8]) {
    f[0] = bf_lo(v.x); f[1] = bf_hi(v.x); f[2] = bf_lo(v.y); f[3] = bf_hi(v.y); f[4] = bf_lo(v.z); f[5] = bf_hi(v.z); f[6] = bf_lo(v.w); f[7] = bf_hi(v.w);
}


#define XB_TMO      128
#define XB_XCNT(j)  (256  + 64 * (j))
#define XB_XSUB(j)  (1280 + 64 * (j))
#define XB_XGEN(j)  (2304 + 64 * (j))
#define XB_TOP      3328
#define XB_TOPGEN   3392
#define XCD_BAR_WORDS 3456
#define XB_SPIN_CAP (1u << 20)
__device__ __forceinline__ unsigned xb_ld(unsigned* p)              { return __hip_atomic_load(p, __ATOMIC_RELAXED, __HIP_MEMORY_SCOPE_AGENT); }
__device__ __forceinline__ unsigned xb_add(unsigned* p, unsigned v) { return __hip_atomic_fetch_add(p, v, __ATOMIC_RELAXED, __HIP_MEMORY_SCOPE_AGENT); }
__device__ __forceinline__ unsigned xb_xcc_id() { return (unsigned)__builtin_amdgcn_s_getreg((3 << 11) | 20) & 0xFu; }
#define XB_SPIN(cond, bar) do { unsigned _sp = 0; while (cond) { __builtin_amdgcn_s_sleep(1); \
    if ((++_sp & 255u) == 0u) { if (xb_ld(&(bar)[XB_TMO])) break; if (_sp > XB_SPIN_CAP) { atomicAdd(&(bar)[XB_TMO], 1u); break; } } } } while (0)
struct XcdBarrier { unsigned* bar; unsigned x; volatile LAS unsigned* st; };
__device__ __forceinline__ XcdBarrier xcd_barrier_post(unsigned* bar, volatile LAS unsigned* st) {
    XcdBarrier b; b.bar = bar; b.x = xb_xcc_id(); b.st = st;
    if (threadIdx.x == 0) (void)xb_add(&bar[XB_XCNT(b.x)], 1u);
    return b;
}
__device__ __forceinline__ void xcd_barrier_complete(unsigned* bar, unsigned x, unsigned& nloc, unsigned& nx) {
    const unsigned G = gridDim.x * gridDim.y * gridDim.z;
    unsigned sum, cnt, mine, sp = 0u;
    for (;;) {
        sum = 0u; cnt = 0u; mine = 0u;
#pragma unroll
        for (unsigned j = 0; j < 16; ++j) { const unsigned c = xb_ld(&bar[XB_XCNT(j)]); sum += c; cnt += (c > 0u) ? 1u : 0u; mine = (j == x) ? c : mine; }
        if (sum == G) break;
        __builtin_amdgcn_s_sleep(1);
        if ((++sp & 255u) == 0u) { if (xb_ld(&bar[XB_TMO])) break; if (sp > XB_SPIN_CAP) { atomicAdd(&bar[XB_TMO], 1u); break; } }
    }
    nloc = mine > 0u ? mine : 1u; nx = cnt > 0u ? cnt : 1u;
}
__device__ __forceinline__ void xcd_barrier(const XcdBarrier& b) {
    asm volatile("s_waitcnt vmcnt(0)" ::: "memory");
    __syncthreads();
    if (threadIdx.x == 0) {
        unsigned* bar = b.bar;
        __builtin_amdgcn_s_waitcnt(0);
        unsigned nloc = b.st[0], nx = b.st[1];
        if (nloc == 0u) { xcd_barrier_complete(bar, b.x, nloc, nx); b.st[0] = nloc; b.st[1] = nx; }
        const unsigned old = xb_add(&bar[XB_XSUB(b.x)], 1u);
        const unsigned gen = old / nloc;
        if (old + 1u == (gen + 1u) * nloc) {
            __builtin_amdgcn_fence(__ATOMIC_RELEASE, "agent");
            asm volatile("s_waitcnt vmcnt(0)" ::: "memory");
            const unsigned og = xb_add(&bar[XB_TOP], 1u);
            const unsigned tg = og / nx;
            if (og + 1u == (tg + 1u) * nx) xb_add(&bar[XB_TOPGEN], 1u);
            else XB_SPIN(xb_ld(&bar[XB_TOPGEN]) == tg, bar);
            __builtin_amdgcn_fence(__ATOMIC_ACQUIRE, "agent");
            xb_add(&bar[XB_XGEN(b.x)], 1u);
            asm volatile("s_waitcnt vmcnt(0)" ::: "memory");
        } else {
            XB_SPIN(xb_ld(&bar[XB_XGEN(b.x)]) == gen, bar);
            __builtin_amdgcn_fence(__ATOMIC_ACQUIRE, "agent");
            asm volatile("s_waitcnt vmcnt(0)" ::: "memory");
        }
    }
    __syncthreads();
}

namespace pg8 {
constexpr int BM = 256, BK = 64, HALF = 128, HTB = HALF * BK * 2, STAGE_BYTES = 8 * HTB, NXCD = 8, WGM = 8;
__host__ __device__ __forceinline__ int lds_byte(int r, int c) { const int st = (r >> 4) * 2 + (c >> 5), rr = r & 15, cc = c & 31, ob = rr * 64 + cc * 2; return st * 1024 + (ob ^ (((ob >> 9) & 1) << 5)); }
__host__ __device__ __forceinline__ void stage_rc(int b, int& R, int& C) { const int st = b / 1024, sb = b % 1024, swz = sb ^ (((sb >> 9) & 1) << 5); R = (st >> 1) * 16 + swz / 64; C = (st & 1) * 32 + (swz % 64) / 2; }
__host__ __device__ __forceinline__ int perm32(int rho) { const int n = rho >> 4, i = rho & 15; return 8 * (i >> 2) + 4 * n + (i & 3); }

struct Unit { int pm, pn; };
struct Gemm { const bf16_t* A; const bf16_t* Bt; int M, N, K, lda; int skew; };

struct StaticOrder {
    int nM, nN, nwg, G, c;
    __device__ void init(int M, int N, int G_, int c_) { nM = M / BM; nN = N / BM; nwg = nM * nN; G = G_; c = c_; }
    __device__ bool next(int i, Unit& u) const {
        const long L = (long)i * G + c; if (L >= nwg) return false;
        int wgid = (int)L; { const int q = nwg / NXCD, r = nwg % NXCD, xcd = wgid % NXCD, off = wgid / NXCD; wgid = (xcd < r ? xcd * (q + 1) : r * (q + 1) + (xcd - r) * q) + off; }
        const int nig = WGM * nN, gid = wgid / nig, fm = gid * WGM, gsz = (nM - fm) < WGM ? (nM - fm) : WGM;
        u.pm = fm + ((wgid % nig) % gsz); u.pn = (wgid % nig) / gsz; return true;
    }
};

struct EpiBf16 {
    static constexpr bool PERM = true;
    bf16_t* O; int ldc; bf16_t* O2; int ldc2;
    __device__ __forceinline__ void init(f32x4 (&acc)[2][2][4][2], const Unit&, int, int, int, int) const {
#pragma unroll
        for (int a = 0; a < 2; ++a)
#pragma unroll
            for (int b = 0; b < 2; ++b)
#pragma unroll
                for (int m = 0; m < 4; ++m)
#pragma unroll
                    for (int n = 0; n < 2; ++n) acc[a][b][m][n] = (f32x4){0.f, 0.f, 0.f, 0.f};
    }
    LAS unsigned char* est;
    __device__ __forceinline__ void operator()(f32x4 (&acc)[2][2][4][2], const Unit& u, int wr, int wc, int fr, int fq) const {
        const int lane = fq * 16 + fr; const int pn = u.pn;
        const int rbase = u.pm * BM + wr * 64;
        if (pn >= 4 && pn < 12) {
            const int rrow = lane >> 2, rch = lane & 3;
            bf16_t* gp = O + (size_t)(rbase + rrow) * ldc + 1024 + 128 * (pn - 4) + 32 * wc + rch * 8;
#pragma unroll
            for (int ai = 0; ai < 2; ++ai)
#pragma unroll
                for (int m = 0; m < 4; ++m) {
#pragma unroll
                    for (int bj = 0; bj < 2; ++bj) { const f32x4 p = acc[ai][bj][m][0] * acc[ai][bj][m][1];
                        u32x2 w; w.x = cvt_pk_bf16(p[0], p[1]); w.y = cvt_pk_bf16(p[2], p[3]);
                        const int chunk = 2 * bj + (fq >> 1);
                        *(LAS u32x2*)(est + fr * 64 + ((chunk ^ ((fr >> 1) & 3)) * 16) + (fq & 1) * 8) = w; }
                    const u32x4 v = *(LAS const u32x4*)(est + rrow * 64 + ((rch ^ ((rrow >> 1) & 3)) * 16));
                    *(u32x4*)(gp + (size_t)(ai * HALF + m * 16) * ldc) = v; }
        } else {
            const bool second = pn >= 16;
            const int colt = (second ? (pn - 16) * BM : (pn >= 12 ? 2048 + (pn - 12) * BM : pn * BM)) + wc * 64;
            bf16_t* Ob = second ? O2 : O; const int ld = second ? ldc2 : ldc;
            const int rrow = lane >> 3, rch = lane & 7;
            bf16_t* gp = Ob + (size_t)(rbase + rrow) * ld + colt + rch * 8;
#pragma unroll
            for (int ai = 0; ai < 2; ++ai)
#pragma unroll
                for (int m = 0; m < 4; ++m) {
#pragma unroll
                    for (int bj = 0; bj < 2; ++bj) { f32x4 v0 = acc[ai][bj][m][0], v1 = acc[ai][bj][m][1];
                        if (second) {
#pragma unroll
                            for (int i = 0; i < 4; ++i) { v0[i] = v0[i] * sigmoid_fast(v0[i]); v1[i] = v1[i] * sigmoid_fast(v1[i]); } }
                        u32x4 w; w.x = cvt_pk_bf16(v0[0], v0[1]); w.y = cvt_pk_bf16(v0[2], v0[3]); w.z = cvt_pk_bf16(v1[0], v1[1]); w.w = cvt_pk_bf16(v1[2], v1[3]);
                        *(LAS u32x4*)(est + fr * 128 + (((4 * bj + fq) ^ (fr & 7)) * 16)) = w; }
#pragma unroll
                    for (int p = 0; p < 2; ++p) { const int row = p * 8 + rrow;
                        const u32x4 v = *(LAS const u32x4*)(est + row * 128 + ((rch ^ (row & 7)) * 16));
                        *(u32x4*)(gp + (size_t)(ai * HALF + m * 16 + p * 8) * ld) = v; } }
        }
    }
};
struct EpiResidNorm {
    static constexpr bool PERM = false;
    const float* x; float* out; unsigned* ss; unsigned* cnt; const float* fg; LAS unsigned char* est;
    __device__ __forceinline__ void init(f32x4 (&acc)[2][2][4][2], const Unit& u, int wr, int wc, int fr, int fq) const {
        const int row0 = u.pm * BM + wr * 64 + fr, col0 = u.pn * BM + wc * 32 + 4 * fq;
#pragma unroll
        for (int ai = 0; ai < 2; ++ai)
#pragma unroll
            for (int m = 0; m < 4; ++m) { const size_t off = (size_t)(row0 + ai * HALF + m * 16) * DM + col0;
#pragma unroll
                for (int bj = 0; bj < 2; ++bj)
#pragma unroll
                    for (int n = 0; n < 2; ++n) acc[ai][bj][m][n] = __builtin_nontemporal_load((const f32x4*)(x + off + bj * HALF + n * 16)); }
    }
    __device__ __forceinline__ void operator()(f32x4 (&acc)[2][2][4][2], const Unit& u, int wr, int wc, int fr, int fq) const {
        const int row0 = u.pm * BM + wr * 64 + fr, col0 = u.pn * BM + wc * 32 + 4 * fq;
#pragma unroll
        for (int ai = 0; ai < 2; ++ai)
#pragma unroll
            for (int m = 0; m < 4; ++m) { const int row = row0 + ai * HALF + m * 16; const size_t off = (size_t)row * DM + col0; float s = 0.f;
#pragma unroll
                for (int bj = 0; bj < 2; ++bj)
#pragma unroll
                    for (int n = 0; n < 2; ++n) { const f32x4 o = acc[ai][bj][m][n]; s += (o[0] * o[0] + o[1] * o[1]) + (o[2] * o[2] + o[3] * o[3]); }
                s += __shfl_xor(s, 16); s += __shfl_xor(s, 32);
                if (fq == 0) __hip_atomic_store(ss + (size_t)row * 16 + u.pn * 4 + wc, __float_as_uint(s), __ATOMIC_RELAXED, __HIP_MEMORY_SCOPE_AGENT); }
        asm volatile("s_waitcnt vmcnt(0)" ::: "memory");
        unsigned* c = cnt + (u.pm * 2 + wr) * 32;
        if ((threadIdx.x & 63) == 0) __hip_atomic_fetch_add(c, 1u, __ATOMIC_RELAXED, __HIP_MEMORY_SCOPE_AGENT);
        { unsigned spins = 0;
          while ((unsigned)__builtin_amdgcn_readfirstlane(__hip_atomic_load(c, __ATOMIC_RELAXED, __HIP_MEMORY_SCOPE_AGENT)) < 16u) { __builtin_amdgcn_s_sleep(2); if (++spins > (1u << 22)) break; } }
        asm volatile("" ::: "memory");
#pragma unroll
        for (int ai = 0; ai < 2; ++ai)
#pragma unroll
            for (int m = 0; m < 4; ++m) { const int row = row0 + ai * HALF + m * 16; const size_t off = (size_t)row * DM + col0;
                const unsigned long long* sp = (const unsigned long long*)(ss + (size_t)row * 16 + fq * 4);
                const unsigned long long p0 = __hip_atomic_load(sp, __ATOMIC_RELAXED, __HIP_MEMORY_SCOPE_AGENT), p1 = __hip_atomic_load(sp + 1, __ATOMIC_RELAXED, __HIP_MEMORY_SCOPE_AGENT);
                float t = (__uint_as_float((unsigned)p0) + __uint_as_float((unsigned)(p0 >> 32))) + (__uint_as_float((unsigned)p1) + __uint_as_float((unsigned)(p1 >> 32)));
                t += __shfl_xor(t, 16); t += __shfl_xor(t, 32);
                const float rstd = 1.0f / sqrtf(t * (1.f / DM) + RMS_EPS);
                const int lane_ = fq * 16 + fr, rrow = lane_ >> 3, rch = lane_ & 7;
#pragma unroll
                for (int bj = 0; bj < 2; ++bj) {
#pragma unroll
                    for (int n = 0; n < 2; ++n) { const f32x4 gv = *(const f32x4*)(fg + col0 + bj * HALF + n * 16);
                        *(LAS f32x4*)(est + fr * 128 + (((4 * n + fq) ^ (fr & 7)) * 16)) = acc[ai][bj][m][n] * rstd * gv; }
#pragma unroll
                    for (int p = 0; p < 2; ++p) { const int rl = p * 8 + rrow;
                        const f32x4 v = *(LAS const f32x4*)(est + rl * 128 + ((rch ^ (rl & 7)) * 16));
                        *(f32x4*)(out + (size_t)(u.pm * BM + wr * 64 + ai * HALF + m * 16 + rl) * DM + u.pn * BM + bj * HALF + wc * 32 + rch * 4) = v; } } }
    }
};

template <class Epi>
__device__ __forceinline__ void gemm_phase(LAS unsigned char* lds, const Gemm g, const StaticOrder& S, const Epi& E) {
    const int tid = threadIdx.x, wid = __builtin_amdgcn_readfirstlane(tid >> 6), lane = tid & 63, wr = wid >> 2, wc = wid & 3, fr = lane & 15, fq = lane >> 4;
    const int K = g.K, nt = K / BK, lda = g.lda;
    unsigned voffA[2], voffB[2];
#pragma unroll
    for (int i = 0; i < 2; ++i) { int R, C; stage_rc(tid * 16 + i * 8192, R, C); const int Rb = Epi::PERM ? ((R & ~31) + perm32(R & 31)) : R;
        voffA[i] = (unsigned)(R * lda + C) * 2u; voffB[i] = (unsigned)(Rb * K + C) * 2u; }
    const size_t kstep = (size_t)(BK * 2);
    const size_t hstepA = (size_t)HALF * lda * 2, hstepB = (size_t)HALF * K * 2;
    const size_t tstepA = 2 * hstepA, tstepB = 2 * hstepB;
    const unsigned ldsw = (unsigned)wid * 1024u;
    const int aoff = lds_byte(wr * 64 + fr, fq * 8), boff = lds_byte(wc * 32 + fr, fq * 8);
#define PG8_SA(b, h) (((b) * 2 + (h)) * HTB)
#define PG8_SB(b, h) ((4 + (b) * 2 + (h)) * HTB)
#define PG8_STAGE(bufoff, gbase, voff) do { _Pragma("unroll") for (int _i = 0; _i < 2; ++_i) \
        __builtin_amdgcn_global_load_lds((const unsigned*)((const char*)(gbase) + (voff)[_i]), (LAS unsigned*)(lds + (bufoff) + ldsw + _i * 8192), 16, 0, 0); } while (0)
#define PG8_LDA(dst, b, h) do { _Pragma("unroll") for (int m = 0; m < 4; ++m) _Pragma("unroll") for (int k = 0; k < 2; ++k) dst[m][k] = *(const LAS bf16x8*)(lds + PG8_SA(b, h) + aoff + m * 2048 + k * 1024); } while (0)
#define PG8_LDB(dst, b, h) do { _Pragma("unroll") for (int n = 0; n < 2; ++n) _Pragma("unroll") for (int k = 0; k < 2; ++k) dst[n][k] = *(const LAS bf16x8*)(lds + PG8_SB(b, h) + boff + n * 2048 + k * 1024); } while (0)
#define PG8_MMA(ai, bj, At, Bt) do { __builtin_amdgcn_s_setprio(1); _Pragma("unroll") for (int m = 0; m < 4; ++m) _Pragma("unroll") for (int n = 0; n < 2; ++n) _Pragma("unroll") for (int k = 0; k < 2; ++k) \
        acc[ai][bj][m][n] = __builtin_amdgcn_mfma_f32_16x16x32_bf16(Bt[n][k], At[m][k], acc[ai][bj][m][n], 0, 0, 0); __builtin_amdgcn_s_setprio(0); } while (0)
#define PG8_WAIT_V(n) asm volatile("s_waitcnt vmcnt(" #n ")" ::: "memory")
#define PG8_WAIT_L(n) asm volatile("s_waitcnt lgkmcnt(" #n ")" ::: "memory")
#define PG8_BAR __builtin_amdgcn_s_barrier()
#define PG8_SCHED __builtin_amdgcn_sched_barrier(0)
    Unit cur, nxt; int ui = 0;
    if (!S.next(0, cur)) return;
    if (g.skew > 0) { const unsigned long long t0 = __builtin_amdgcn_s_memrealtime(), dt = (unsigned long long)((blockIdx.x & 7u) * (unsigned)g.skew);
        while (__builtin_amdgcn_s_memrealtime() - t0 < dt) __builtin_amdgcn_s_sleep(8); }
    f32x4 acc[2][2][4][2];
    E.init(acc, cur, wr, wc, fr, fq);
    bf16x8 At[4][2], B0[2][2], B1[2][2];
    const char* cA = (const char*)g.A + (size_t)cur.pm * tstepA; const char* cB = (const char*)g.Bt + (size_t)cur.pn * tstepB;
#if PG8_SP2
    PG8_STAGE(PG8_SB(0, 0), cB, voffB); PG8_STAGE(PG8_SB(0, 1), cB + hstepB, voffB); PG8_STAGE(PG8_SA(0, 0), cA, voffA); PG8_STAGE(PG8_SA(0, 1), cA + hstepA, voffA);
    if (wr == 1) PG8_BAR;
    PG8_WAIT_V(2); PG8_BAR;
    PG8_STAGE(PG8_SB(1, 0), cB + kstep, voffB); PG8_STAGE(PG8_SA(1, 0), cA + kstep, voffA); PG8_STAGE(PG8_SB(1, 1), cB + hstepB + kstep, voffB);
    PG8_WAIT_V(6); PG8_BAR;
#else
    PG8_STAGE(PG8_SB(0, 0), cB, voffB); PG8_STAGE(PG8_SA(0, 0), cA, voffA); PG8_STAGE(PG8_SB(0, 1), cB + hstepB, voffB); PG8_STAGE(PG8_SA(0, 1), cA + hstepA, voffA);
    if (wr == 1) PG8_BAR;
    PG8_WAIT_V(4); PG8_BAR;
    PG8_STAGE(PG8_SB(1, 0), cB + kstep, voffB); PG8_STAGE(PG8_SA(1, 0), cA + kstep, voffA); PG8_STAGE(PG8_SB(1, 1), cB + hstepB + kstep, voffB);
    PG8_WAIT_V(6); PG8_BAR;
#endif
    for (;;) {
        const bool has_next = S.next(ui + 1, nxt);
        const char* nA = has_next ? (const char*)g.A + (size_t)nxt.pm * tstepA : cA; const char* nB = has_next ? (const char*)g.Bt + (size_t)nxt.pn * tstepB : cB;
        for (int t = 0; t < nt; t += 2) {
            const bool last = (t == nt - 2);
            const char* a1 = cA + (size_t)(t + 1) * kstep;
            const char* a2 = last ? nA : cA + (size_t)(t + 2) * kstep; const char* b2 = last ? nB : cB + (size_t)(t + 2) * kstep;
            const char* a3 = a2 + kstep; const char* b3 = b2 + kstep;
#if PG8_SP2
            PG8_LDB(B0, 0, 0); PG8_LDB(B1, 0, 1); PG8_SCHED; PG8_LDA(At, 0, 0); PG8_STAGE(PG8_SA(1, 1), a1 + hstepA, voffA);
            PG8_WAIT_V(8); PG8_WAIT_L(0); PG8_BAR; PG8_MMA(0, 0, At, B0); PG8_MMA(0, 1, At, B1); PG8_BAR; PG8_SCHED;
            PG8_LDA(At, 0, 1); PG8_STAGE(PG8_SB(0, 0), b2, voffB); PG8_STAGE(PG8_SB(0, 1), b2 + hstepB, voffB); PG8_STAGE(PG8_SA(0, 0), a2, voffA);
            PG8_WAIT_V(8); PG8_WAIT_L(0); PG8_BAR; PG8_MMA(1, 0, At, B0); PG8_MMA(1, 1, At, B1); PG8_BAR; PG8_SCHED;
            PG8_LDB(B0, 1, 0); PG8_LDB(B1, 1, 1); PG8_SCHED; PG8_LDA(At, 1, 0); PG8_STAGE(PG8_SA(0, 1), a2 + hstepA, voffA);
            PG8_WAIT_V(8); PG8_WAIT_L(0); PG8_BAR; PG8_MMA(0, 0, At, B0); PG8_MMA(0, 1, At, B1); PG8_BAR; PG8_SCHED;
            PG8_LDA(At, 1, 1); PG8_STAGE(PG8_SB(1, 0), b3, voffB); PG8_STAGE(PG8_SB(1, 1), b3 + hstepB, voffB); PG8_STAGE(PG8_SA(1, 0), a3, voffA);
            PG8_WAIT_V(8); PG8_WAIT_L(0); PG8_BAR; PG8_MMA(1, 0, At, B0); PG8_MMA(1, 1, At, B1); PG8_BAR; PG8_SCHED;
#else
            PG8_LDB(B0, 0, 0); PG8_SCHED; PG8_LDA(At, 0, 0); PG8_STAGE(PG8_SA(1, 1), a1 + hstepA, voffA);
            PG8_WAIT_L(8); PG8_BAR; PG8_WAIT_L(0); PG8_MMA(0, 0, At, B0); PG8_BAR; PG8_SCHED;
            PG8_LDB(B1, 0, 1); PG8_STAGE(PG8_SB(0, 0), b2, voffB);
            PG8_BAR; PG8_WAIT_L(0); PG8_MMA(0, 1, At, B1); PG8_BAR;
            PG8_LDA(At, 0, 1); PG8_STAGE(PG8_SA(0, 0), a2, voffA);
            PG8_BAR; PG8_WAIT_L(0); PG8_MMA(1, 0, At, B0); PG8_BAR; PG8_SCHED;
            PG8_STAGE(PG8_SB(0, 1), b2 + hstepB, voffB);
            PG8_WAIT_V(6); PG8_BAR; PG8_MMA(1, 1, At, B1); PG8_BAR;
            PG8_LDB(B0, 1, 0); PG8_SCHED; PG8_LDA(At, 1, 0); PG8_STAGE(PG8_SA(0, 1), a2 + hstepA, voffA);
            PG8_WAIT_L(8); PG8_BAR; PG8_WAIT_L(0); PG8_MMA(0, 0, At, B0); PG8_BAR; PG8_SCHED;
            PG8_LDB(B1, 1, 1); PG8_STAGE(PG8_SB(1, 0), b3, voffB);
            PG8_BAR; PG8_WAIT_L(0); PG8_MMA(0, 1, At, B1); PG8_BAR;
            PG8_LDA(At, 1, 1); PG8_STAGE(PG8_SA(1, 0), a3, voffA);
            PG8_BAR; PG8_WAIT_L(0); PG8_MMA(1, 0, At, B0); PG8_BAR; PG8_SCHED;
            PG8_STAGE(PG8_SB(1, 1), b3 + hstepB, voffB);
            PG8_WAIT_V(6); PG8_BAR; PG8_MMA(1, 1, At, B1); PG8_BAR;
#endif
        }
#if PG8_ALIGN
        if (wr == 0) PG8_BAR;
#endif
        E(acc, cur, wr, wc, fr, fq);
        if (!has_next) break;
        cur = nxt; cA = nA; cB = nB; ++ui;
        E.init(acc, cur, wr, wc, fr, fq);
#if PG8_ALIGN
        if (wr == 1) PG8_BAR;
#endif
    }
    PG8_WAIT_V(0);
#if !PG8_ALIGN
    if (wr == 0) PG8_BAR;
#endif
    PG8_BAR;
#undef PG8_SA
#undef PG8_SB
#undef PG8_STAGE
#undef PG8_LDA
#undef PG8_LDB
#undef PG8_MMA
#undef PG8_WAIT_V
#undef PG8_WAIT_L
#undef PG8_BAR
#undef PG8_SCHED
}
}

__device__ __forceinline__ void p0_transpose_item(const float* W, int ldw, int k0, int ncol0, bf16_t* WT, int ldt, int drow0, int dk0, LAS float* scr, int lane, int mode = 0) {
#pragma unroll 8
    for (int i = 0; i < 32; ++i) { const int kk = 2 * i + (lane >> 5); scr[kk * 33 + (lane & 31)] = __builtin_nontemporal_load(W + (size_t)(k0 + kk) * ldw + ncol0 + (lane & 31)); }
    asm volatile("s_waitcnt lgkmcnt(0)" ::: "memory");
    const int c = lane & 7;
#pragma unroll
    for (int j = 0; j < 4; ++j) { const int n = (lane >> 3) + 8 * j; const LAS float* s = scr + (8 * c) * 33 + n;
        u32x4 o; o.x = cvt_pk_bf16(s[0 * 33], s[1 * 33]); o.y = cvt_pk_bf16(s[2 * 33], s[3 * 33]); o.z = cvt_pk_bf16(s[4 * 33], s[5 * 33]); o.w = cvt_pk_bf16(s[6 * 33], s[7 * 33]);
        int drow = drow0 + n;
        if (mode) { const int ch = drow0 + n; drow = 1024 + 256 * (ch >> 7) + 128 * ((ch >> 4) & 1) + 32 * ((ch >> 5) & 3) + 8 * ((ch >> 2) & 3) + 4 * (mode - 1) + (ch & 3); }
        *(u32x4*)(WT + (size_t)drow * ldt + dk0 + 8 * c) = o; }
    asm volatile("s_waitcnt lgkmcnt(0)" ::: "memory");
}

__device__ __forceinline__ void phase0(const Args& a, LAS unsigned char* lds, int wave, int lane) {
    LAS float* scr = (LAS float*)(lds + wave * 16384);
    const int gw = blockIdx.x * 8 + wave, NGW = gridDim.x * 8;
    bf16_t* win_t = (bf16_t*)(a.ws + WS_WIN); bf16_t* wout_t = (bf16_t*)(a.ws + WS_WOUT); bf16_t* wg = (bf16_t*)(a.ws + WS_WG);
    constexpr int I_IN = 16 * 192, I_OUT = 32 * 32, I_G = 64;
    for (int it = gw; it < I_IN + I_OUT + I_G; it += NGW) {
        int r = it;
        if (r < I_IN) { const int kb = r / 192, nb = r % 192; const int og = nb / 32;
            if (og == 1 || og == 2) p0_transpose_item(a.in[I_WIN], NPROJ, kb * 64, nb * 32, win_t, DM, (nb % 32) * 32, kb * 64, scr, lane, og);
            else { const int nbase = (og == 0) ? 0 : (og == 4 ? 3072 : (og == 3 ? 4096 : 5120));
                const int q = nb % 32;
                p0_transpose_item(a.in[I_WIN], NPROJ, kb * 64, nb * 32, win_t, DM, nbase + 256 * (q >> 3) + 128 * (q & 1) + 32 * ((q & 7) >> 1), kb * 64, scr, lane, 0); }
            continue; }
        r -= I_IN;
        if (r < I_OUT) { const int kb = r / 32, nb = r % 32; p0_transpose_item(a.in[I_WOUT], DM, kb * 64, nb * 32, wout_t, DMIX, nb * 32, kb * 64, scr, lane); continue; }
        r -= I_OUT;
        { const int mat = r / 32, h = (r % 32) / 2, nb = r & 1; const float* W = (mat ? a.in[I_WI] : a.in[I_WA]) + h * 4096;
          p0_transpose_item(W, 64, 0, nb * 32, wg + mat * 65536 + h * 4096, 64, nb * 32, 0, scr, lane); }
    }
    const float* x = a.in[I_X]; bf16_t* xn = (bf16_t*)(a.ws + WS_XN);
    f32x4 gv[4];
#pragma unroll
    for (int j = 0; j < 4; ++j) gv[j] = ((const f32x4*)a.in[I_LNG])[lane + 64 * j];
    for (int m = gw; m < T_TOK; m += NGW) {
        const f32x4* xr = (const f32x4*)(x + (size_t)m * DM) + lane;
        f32x4 v[4]; float s = 0.f;
#pragma unroll
        for (int j = 0; j < 4; ++j) { v[j] = __builtin_nontemporal_load(xr + 64 * j); s += (v[j].x * v[j].x + v[j].y * v[j].y) + (v[j].z * v[j].z + v[j].w * v[j].w); }
        const float rstd = 1.0f / sqrtf(wave_sum(s) * (1.f / DM) + RMS_EPS);
        u32x2* o8 = (u32x2*)(xn + (size_t)m * DM) + lane;
#pragma unroll
        for (int j = 0; j < 4; ++j) { u32x2 w; w.x = cvt_pk_bf16(v[j].x * rstd * gv[j].x, v[j].y * rstd * gv[j].y); w.y = cvt_pk_bf16(v[j].z * rstd * gv[j].z, v[j].w * rstd * gv[j].w); o8[64 * j] = w; }
    }
}

#define DPP_ADD(v, ctrl) ((v) + __uint_as_float(__builtin_amdgcn_update_dpp(0, __float_as_uint(v), (ctrl), 0xF, 0xF, false)))
__device__ __forceinline__ void conv_item(const Args& a, bf16_t* proj, bf16_t* projg, bf16_t* obase, int ostride, int item, int wave, int lane) {
    const int q = lane >> 4, c8 = lane & 15, ch0 = wave * 128 + c8 * 8;
    float w0[8], w1[8], w2[8], gn[8];
    { const float* cw = a.in[I_CONVW] + ch0; const float* cg_ = a.in[I_CG] + ch0;
#pragma unroll
      for (int j = 0; j < 8; ++j) { w0[j] = cw[j]; w1[j] = cw[1024 + j]; w2[j] = cw[2048 + j]; gn[j] = cg_[j]; } }
    const int tok0 = item * (4 * CONV_R) + q * CONV_R;
    bf16_t* base = proj + (size_t)tok0 * LDPA + ch0; const bf16_t* gbase = projg + (size_t)tok0 * LDPG + ch0;
    float p2[8], p1[8];
    if ((tok0 & (SEQ - 1)) == 0) {
#pragma unroll
        for (int j = 0; j < 8; ++j) { p2[j] = 0.f; p1[j] = 0.f; }
    } else {
        const u32x4 c2 = *(const u32x4*)(base - 2 * LDPA + COL_CX), c1 = *(const u32x4*)(base - 1 * LDPA + COL_CX);
        unpack8(c2, p2); unpack8(c1, p1);
    }
    u32x4 nb[2], nc[2], ng[2];
#pragma unroll
    for (int k = 0; k < 2; ++k) { const bf16_t* rp = base + (size_t)k * LDPA; nb[k] = __builtin_nontemporal_load((const u32x4*)(rp + COL_B)); nc[k] = __builtin_nontemporal_load((const u32x4*)(rp + COL_CX)); ng[k] = __builtin_nontemporal_load((const u32x4*)(gbase + (size_t)k * LDPG)); }
    for (int i = 0; i < CONV_R; i += 2) {
        u32x4 vb[2], vc[2], vg[2];
#pragma unroll
        for (int k = 0; k < 2; ++k) { vb[k] = nb[k]; vc[k] = nc[k]; vg[k] = ng[k]; }
        if (i + 2 < CONV_R) {
#pragma unroll
            for (int k = 0; k < 2; ++k) { const bf16_t* rp = base + (size_t)(i + 2 + k) * LDPA; nb[k] = __builtin_nontemporal_load((const u32x4*)(rp + COL_B)); nc[k] = __builtin_nontemporal_load((const u32x4*)(rp + COL_CX)); ng[k] = __builtin_nontemporal_load((const u32x4*)(gbase + (size_t)(i + 2 + k) * LDPG)); }
        }
#pragma unroll
        for (int k = 0; k < 2; ++k) {
            float fb[8], cx[8], fg[8], y[8];
            unpack8(vb[k], fb); unpack8(vc[k], cx); unpack8(vg[k], fg);
            float ss = 0.f;
#pragma unroll
            for (int j = 0; j < 8; ++j) { const float cv = w0[j] * p2[j] + w1[j] * p1[j] + w2[j] * cx[j]; y[j] = fb[j] * cv; ss += y[j] * y[j]; p2[j] = p1[j]; p1[j] = cx[j]; }
            ss = DPP_ADD(ss, 0xB1); ss = DPP_ADD(ss, 0x4E); ss = DPP_ADD(ss, 0x141); ss = DPP_ADD(ss, 0x140);
            const float rstd = __builtin_amdgcn_rsqf(ss * (1.f / 128.f) + RMS_EPS);
            float o[8];
#pragma unroll
            for (int j = 0; j < 8; ++j) o[j] = y[j] * rstd * gn[j] * fg[j];
            u32x4 w; w.x = cvt_pk_bf16(o[0], o[1]); w.y = cvt_pk_bf16(o[2], o[3]); w.z = cvt_pk_bf16(o[4], o[5]); w.w = cvt_pk_bf16(o[6], o[7]);
            *(u32x4*)(obase + (size_t)(tok0 + i + k) * ostride + ch0) = w;
        }
    }
}

constexpr int L_GW = 0;
constexpr int L_CW = 18432;
constexpr int L_AGG = 20992;
constexpr int L_WT = 29184;
constexpr int WT_BYTES = 8704;
static_assert(L_WT + 8 * WT_BYTES <= 131072, "lds");
typedef float f32x2 __attribute__((ext_vector_type(2)));

__device__ __forceinline__ void lru_item(const Args& a, bf16_t* proj, bf16_t* projg, bf16_t* obase, int ostride, LAS unsigned char* lds, int chain, int part, int nsplit, int tid, int wave, int lane) {
    const int b = chain >> 4, h = chain & 15;
    {
        const bf16_t* wg = (const bf16_t*)(a.ws + WS_WG);
        for (int i = tid; i < 1024; i += NTHREADS) { const int mat = i >> 9, e = (i >> 3) & 63, c = i & 7;
            const u32x4 v = *(const u32x4*)(wg + mat * 65536 + h * 4096 + e * 64 + c * 8);
            *(LAS u32x4*)(lds + L_GW + mat * 9216 + e * 144 + c * 16) = v; }
        LAS float* cw = (LAS float*)(lds + L_CW);
        if (tid < 256) cw[tid] = a.in[I_LCW][(tid >> 6) * 1024 + h * 64 + (tid & 63)];
        else if (tid < 320) { const int c = tid - 256, gc = h * 64 + c;
            cw[256 + c] = a.in[I_LCB][gc]; cw[320 + c] = a.in[I_BA][gc]; cw[384 + c] = a.in[I_BI][gc];
            const float lam = a.in[I_LAM][gc];
            const float logsig = (lam >= 0.f) ? -log1pf(expf(-lam)) : (lam - log1pf(expf(lam)));
            cw[448 + c] = 8.0f * logsig * 1.44269504f;
            cw[512 + c] = a.in[I_LG][gc]; }
    }
    __syncthreads();
    const int r = lane & 31, hh = lane >> 5;
    LAS unsigned char* wt = lds + L_WT + wave * WT_BYTES;
    LAS const float* cw = (LAS const float*)(lds + L_CW);
    bf16x8 I0, I1;
    {
        u32x4 t0 = (u32x4){0u, 0u, 0u, 0u}, t1 = t0;
        const int j0 = r - 8 * hh, j1 = r - 16 - 8 * hh;
#pragma unroll
        for (int d = 0; d < 4; ++d) {
            t0[d] = (j0 == 2 * d) ? 0x00003F80u : ((j0 == 2 * d + 1) ? 0x3F800000u : 0u);
            t1[d] = (j1 == 2 * d) ? 0x00003F80u : ((j1 == 2 * d + 1) ? 0x3F800000u : 0u);
        }
        I0 = __builtin_bit_cast(bf16x8, t0); I1 = __builtin_bit_cast(bf16x8, t1);
    }
    float ba[2], bi[2], cf[2];
#pragma unroll
    for (int n = 0; n < 2; ++n) { ba[n] = cw[320 + 32 * n + r]; bi[n] = cw[384 + 32 * n + r]; cf[n] = cw[448 + 32 * n + r]; }
    float carry[2] = {0.f, 0.f};
    unsigned* flags = (unsigned*)(a.ws + WS_CTL + 4096) + chain * 32;
    unsigned long long* aggg = (unsigned long long*)(a.ws + WS_AGG) + (size_t)chain * 16 * 64;

    const bf16_t* xl_base = proj + (size_t)b * SEQ * LDPA + COL_XL + h * 64;
    const bf16_t* gl_base = projg + (size_t)b * SEQ * LDPG + 1024 + h * 64;
    u32x4 xr[5];
#define LOAD_X(seg_) do { const int s0_ = (seg_) * 256 + wave * 32; _Pragma("unroll") for (int i = 0; i < 5; ++i) { const int idx = lane + 64 * i, row = idx >> 3, c = idx & 7; const int s = s0_ - 3 + row; \
        xr[i] = (u32x4){0u, 0u, 0u, 0u}; if (idx < 280 && s >= 0) xr[i] = __builtin_nontemporal_load((const u32x4*)(xl_base + (size_t)s * LDPA + c * 8)); } } while (0)
    LOAD_X(part);
    for (int seg = part; seg < 16; seg += nsplit) {
        const int s0 = seg * 256 + wave * 32;
#pragma unroll
        for (int i = 0; i < 5; ++i) { const int idx = lane + 64 * i, row = idx >> 3, c = idx & 7; if (idx < 280) *(LAS u32x4*)(wt + row * 144 + c * 16) = xr[i]; }
        if (seg + nsplit < 16) LOAD_X(seg + nsplit);
        u32x4 gl[4];
#define LOAD_GL() do { _Pragma("unroll") for (int i = 0; i < 4; ++i) { const int tok = (lane >> 3) + 8 * i, c = lane & 7; gl[i] = __builtin_nontemporal_load((const u32x4*)(gl_base + (size_t)(s0 + tok) * LDPG + c * 8)); } } while (0)
#if GL_EARLY
        LOAD_GL();
#endif
        asm volatile("s_waitcnt lgkmcnt(0)" ::: "memory");
        bf16x8 Af[4];
#pragma unroll
        for (int s = 0; s < 4; ++s) {
            const int c0 = 16 * s + 8 * hh;
            float u8[8];
            { const f32x4 b0 = *(LAS const f32x4*)(cw + 256 + c0), b1 = *(LAS const f32x4*)(cw + 256 + c0 + 4);
              u8[0] = b0[0]; u8[1] = b0[1]; u8[2] = b0[2]; u8[3] = b0[3]; u8[4] = b1[0]; u8[5] = b1[1]; u8[6] = b1[2]; u8[7] = b1[3]; }
#pragma unroll
            for (int k = 0; k < 4; ++k) {
                const u32x4 xv = *(LAS const u32x4*)(wt + (r + k) * 144 + c0 * 2);
                const f32x4 wv0 = *(LAS const f32x4*)(cw + k * 64 + c0), wv1 = *(LAS const f32x4*)(cw + k * 64 + c0 + 4);
                float fx[8]; unpack8(xv, fx);
                u8[0] += wv0[0] * fx[0]; u8[1] += wv0[1] * fx[1]; u8[2] += wv0[2] * fx[2]; u8[3] += wv0[3] * fx[3];
                u8[4] += wv1[0] * fx[4]; u8[5] += wv1[1] * fx[5]; u8[6] += wv1[2] * fx[6]; u8[7] += wv1[3] * fx[7];
            }
            u32x4 pk; pk.x = cvt_pk_bf16(u8[0], u8[1]); pk.y = cvt_pk_bf16(u8[2], u8[3]); pk.z = cvt_pk_bf16(u8[4], u8[5]); pk.w = cvt_pk_bf16(u8[6], u8[7]);
            Af[s] = __builtin_bit_cast(bf16x8, pk);
        }
#pragma unroll
        for (int n = 0; n < 2; ++n) {
            float hl[16], pc[16];
            f32x16 accR, accI, accU;
#pragma unroll
            for (int j = 0; j < 16; ++j) { accR[j] = 0.f; accI[j] = 0.f; accU[j] = 0.f; }
#pragma unroll
            for (int s = 0; s < 4; ++s) {
                const bf16x8 Ba = *(LAS const bf16x8*)(lds + L_GW + (32 * n + r) * 144 + (16 * s + 8 * hh) * 2);
                const bf16x8 Bi = *(LAS const bf16x8*)(lds + L_GW + 9216 + (32 * n + r) * 144 + (16 * s + 8 * hh) * 2);
                accR = __builtin_amdgcn_mfma_f32_32x32x16_bf16(Af[s], Ba, accR, 0, 0, 0);
                accI = __builtin_amdgcn_mfma_f32_32x32x16_bf16(Af[s], Bi, accI, 0, 0, 0);
            }
            accU = __builtin_amdgcn_mfma_f32_32x32x16_bf16(Af[2 * n], I0, accU, 0, 0, 0);
            accU = __builtin_amdgcn_mfma_f32_32x32x16_bf16(Af[2 * n + 1], I1, accU, 0, 0, 0);
            float gP[4], gH[4];
#pragma unroll
            for (int g = 0; g < 4; ++g) {
                float P = 1.f, H = 0.f;
#pragma unroll
                for (int i = 0; i < 4; ++i) { const int j = 4 * g + i;
                    const float rr = sigmoid_fast(accR[j] + ba[n]);
                    const float ii = sigmoid_fast(accI[j] + bi[n]);
                    const float l2 = rr * cf[n];
                    const float aa = __builtin_amdgcn_exp2f(l2);
                    const float t = l2 * 1.38629436f;
                    const float em_small = -t * (1.0f + t * (0.5f + t * (0.16666667f + t * 0.041666667f)));
                    const float one_m = (t > -0.0625f) ? em_small : (1.0f - aa * aa);
                    const float dd = __builtin_amdgcn_sqrtf(one_m) * ii * accU[j];
                    H = aa * H + dd; P = P * aa; hl[j] = H; pc[j] = P; }
                gP[g] = P; gH[g] = H;
            }
            float cp = 1.f, ch = 0.f;
#pragma unroll
            for (int g = 0; g < 4; ++g) {
                const auto sp = __builtin_amdgcn_permlane32_swap(__float_as_uint(gP[g]), __float_as_uint(gP[g]), false, false);
                const auto sh = __builtin_amdgcn_permlane32_swap(__float_as_uint(gH[g]), __float_as_uint(gH[g]), false, false);
                const float oP = __uint_as_float(hh ? sp[0] : sp[1]), oH = __uint_as_float(hh ? sh[0] : sh[1]);
                const float P = gP[g], H = gH[g];
                const float A1 = hh ? oP : P, H1 = hh ? oH : H, A2 = hh ? P : oP, H2 = hh ? H : oH;
                const float cp1 = cp * A1, ch1 = A1 * ch + H1;
                const float inP = hh ? cp1 : cp, inH = hh ? ch1 : ch;
#pragma unroll
                for (int i = 0; i < 4; ++i) { const int j = 4 * g + i; hl[j] += pc[j] * inH; pc[j] *= inP; }
                cp = cp1 * A2; ch = A2 * ch1 + H2;
            }
            if (hh == 0) *(LAS f32x2*)(lds + L_AGG + ((n * 8 + wave) * 64 + 32 * n + r) * 8) = (f32x2){cp, ch};
#if !GL_EARLY
            if (n == 1) LOAD_GL();
#endif
            if (nsplit > 1 && seg > 0 && wave == 0) {
                unsigned spins = 0;
                while (__builtin_amdgcn_readfirstlane(__hip_atomic_load(flags + (seg - 1) * 2 + n, __ATOMIC_RELAXED, __HIP_MEMORY_SCOPE_AGENT)) == 0u) { __builtin_amdgcn_s_sleep(2); if (++spins > (1u << 22)) break; }
                asm volatile("" ::: "memory");
            }
            __syncthreads();
            float c = carry[n];
            if (nsplit > 1 && seg > 0) {
                const unsigned long long pw = __hip_atomic_load(aggg + (size_t)(seg - 1) * 64 + n * 32 + r, __ATOMIC_RELAXED, __HIP_MEMORY_SCOPE_AGENT);
                c = __uint_as_float((unsigned)pw) * c + __uint_as_float((unsigned)(pw >> 32));
            }
            float cin = 0.f, iP = 1.f, iH = 0.f;
#pragma unroll
            for (int w = 0; w < 8; ++w) {
                const f32x2 ag = *(LAS const f32x2*)(lds + L_AGG + ((n * 8 + w) * 64 + 32 * n + r) * 8);
                cin = (w == wave) ? c : cin; c = ag.x * c + ag.y; iH = ag.x * iH + ag.y; iP *= ag.x; }
            carry[n] = c;
            if (nsplit > 1 && wave == 0) {
                if (hh == 0) __hip_atomic_store(aggg + (size_t)seg * 64 + n * 32 + r, ((unsigned long long)__float_as_uint(iH) << 32) | __float_as_uint(iP), __ATOMIC_RELAXED, __HIP_MEMORY_SCOPE_AGENT);
                asm volatile("s_waitcnt vmcnt(0)" ::: "memory");
                if (lane == 0) __hip_atomic_store(flags + seg * 2 + n, 1u, __ATOMIC_RELAXED, __HIP_MEMORY_SCOPE_AGENT);
            }
#pragma unroll
            for (int j = 0; j < 16; ++j) { const int row = (j & 3) + 8 * (j >> 2) + 4 * hh;
                *(LAS float*)(wt + row * 272 + (32 * n + r) * 4) = hl[j] + pc[j] * cin; }
        }
        asm volatile("s_waitcnt lgkmcnt(0)" ::: "memory");
#pragma unroll
        for (int i = 0; i < 4; ++i) {
            const int tok = (lane >> 3) + 8 * i, c = lane & 7;
            const f32x4 h0 = *(LAS const f32x4*)(wt + tok * 272 + c * 32), h1 = *(LAS const f32x4*)(wt + tok * 272 + c * 32 + 16);
            const f32x4 g0 = *(LAS const f32x4*)(cw + 512 + c * 8), g1 = *(LAS const f32x4*)(cw + 512 + c * 8 + 4);
            float ss = (h0[0] * h0[0] + h0[1] * h0[1]) + (h0[2] * h0[2] + h0[3] * h0[3]) + (h1[0] * h1[0] + h1[1] * h1[1]) + (h1[2] * h1[2] + h1[3] * h1[3]);
            ss = DPP_ADD(ss, 0xB1); ss = DPP_ADD(ss, 0x4E); ss = DPP_ADD(ss, 0x141);
            const float rstd = __builtin_amdgcn_rsqf(ss * (1.f / 64.f) + RMS_EPS);
            float fg[8]; unpack8(gl[i], fg);
            float o[8];
            o[0] = h0[0] * rstd * g0[0]; o[1] = h0[1] * rstd * g0[1]; o[2] = h0[2] * rstd * g0[2]; o[3] = h0[3] * rstd * g0[3];
            o[4] = h1[0] * rstd * g1[0]; o[5] = h1[1] * rstd * g1[1]; o[6] = h1[2] * rstd * g1[2]; o[7] = h1[3] * rstd * g1[3];
#pragma unroll
            for (int j = 0; j < 8; ++j) o[j] *= fg[j];
            u32x4 w; w.x = cvt_pk_bf16(o[0], o[1]); w.y = cvt_pk_bf16(o[2], o[3]); w.z = cvt_pk_bf16(o[4], o[5]); w.w = cvt_pk_bf16(o[6], o[7]);
            *(u32x4*)(obase + (size_t)(b * SEQ + s0 + tok) * ostride + h * 64 + c * 8) = w;
        }
        asm volatile("s_waitcnt lgkmcnt(0)" ::: "memory");
    }
#undef LOAD_X
    __syncthreads();
}

__global__ void __launch_bounds__(NTHREADS, 2) hymba_fwd(Args a) {
    extern __shared__ __attribute__((aligned(16))) unsigned char lds_raw[];
    LAS unsigned char* lds = (LAS unsigned char*)lds_raw;
    cg::grid_group grid = cg::this_grid();
    if (gridDim.y == 0x7fffu) grid.sync();
    volatile LAS unsigned* bst = (volatile LAS unsigned*)(lds + LDS_CTL + 64);
    if (threadIdx.x == 0) { bst[0] = 0u; bst[1] = 0u; }
    __syncthreads();
    const XcdBarrier bar = xcd_barrier_post((unsigned*)(a.ws + WS_CTL + 32768), bst);
    const int tid = threadIdx.x, lane = tid & 63, wave = __builtin_amdgcn_readfirstlane(tid >> 6);
    bf16_t* proj = (bf16_t*)(a.ws + WS_PROJ); bf16_t* projg = (bf16_t*)(a.ws + WS_PROJG);

#pragma unroll
    for (int rep = 0; rep < REP0; ++rep) {
#ifndef SKIP_P0
    phase0(a, lds, wave, lane);
#endif

    xcd_barrier(bar); }
#pragma unroll
    for (int rep = 0; rep < REP1; ++rep) {
        pg8::Gemm g{(const bf16_t*)(a.ws + WS_XN), (const bf16_t*)(a.ws + WS_WIN), T_TOK, NPROJ, DM, DM, SKEW1};
        pg8::StaticOrder S; S.init(T_TOK, NPROJ, (int)gridDim.x, (int)blockIdx.x);
        pg8::EpiBf16 E{proj, LDPA, projg, LDPG, lds + LDS_EST + wave * 2048};
#ifndef SKIP_G1
        pg8::gemm_phase<pg8::EpiBf16>(lds, g, S, E);
#endif
    xcd_barrier(bar); }
    {
#ifndef SKIP_LRU
        if (gridDim.x >= 256) { if (blockIdx.x < 256) lru_item(a, proj, projg, projg + 1024, LDPG, lds, (int)blockIdx.x >> 1, (int)blockIdx.x & 1, 2, tid, wave, lane); }
        else for (int it = blockIdx.x; it < 128; it += gridDim.x) lru_item(a, proj, projg, projg + 1024, LDPG, lds, it, 0, 1, tid, wave, lane);
#endif
        LAS unsigned* qs = (LAS unsigned*)(lds + LDS_CTL);
        unsigned* qctr = (unsigned*)(a.ws + WS_CTL);
        for (;;) {
            if (tid == 0) qs[0] = atomicAdd(qctr, 1u);
            __syncthreads();
            const unsigned it = qs[0];
            __syncthreads();
            if (it >= (unsigned)(T_TOK / (4 * CONV_R))) break;
#ifndef SKIP_CONV
            conv_item(a, proj, projg, projg, LDPG, (int)it, wave, lane);
#endif
        }
    }
    xcd_barrier(bar);
#pragma unroll
    for (int rep = 0; rep < REP3; ++rep) {
        pg8::Gemm g{projg, (const bf16_t*)(a.ws + WS_WOUT), T_TOK, DM, DMIX, LDPG, SKEW3};
        pg8::StaticOrder S; S.init(T_TOK, DM, (int)gridDim.x, (int)blockIdx.x);
        pg8::EpiResidNorm E{a.in[I_X], a.out, (unsigned*)(a.ws + WS_SS), (unsigned*)(a.ws + WS_CTL + 65536), a.in[I_FG], lds + LDS_EST + wave * 2048};
#ifndef SKIP_G2
        pg8::gemm_phase<pg8::EpiResidNorm>(lds, g, S, E);
#endif
    }
}

extern "C" void kernel_launch(void* const* d_in, const int* in_sizes, int n_in, void* d_out, int out_size, void* d_ws, size_t ws_size, hipStream_t stream) {
    static int grid = 0;
    if (grid == 0) {
        if (n_in != 15 || out_size != T_TOK * DM || ws_size < WS_END) { fprintf(stderr, "kernel_launch: unexpected shapes (n_in %d out %d ws %zu)\n", n_in, out_size, ws_size); grid = -1; return; }
        int dev = 0, cus = 0, per_cu = 0;
        hipGetDevice(&dev);
        hipDeviceGetAttribute(&cus, hipDeviceAttributeMultiprocessorCount, dev);
        if (hipFuncSetAttribute((const void*)hymba_fwd, hipFuncAttributeMaxDynamicSharedMemorySize, LDS_BYTES) != hipSuccess) { fprintf(stderr, "kernel_launch: hipFuncSetAttribute failed\n"); grid = -1; return; }
        if (hipOccupancyMaxActiveBlocksPerMultiprocessor(&per_cu, (const void*)hymba_fwd, NTHREADS, LDS_BYTES) != hipSuccess || per_cu < 1) { fprintf(stderr, "kernel_launch: occupancy query says %d\n", per_cu); per_cu = 1; }
        (void)hipGetLastError();
        grid = cus;
        if (grid != 256) { fprintf(stderr, "kernel_launch: built for a 256-CU device (got %d)\n", cus); grid = -1; return; }
    }
    if (grid < 0) return;
    hipMemsetAsync((char*)d_ws + WS_CTL, 0, CTL_BYTES, stream);
    Args a{};
    for (int i = 0; i < 15; ++i) a.in[i] = (const float*)d_in[i];
    a.out = (float*)d_out; a.ws = (unsigned char*)d_ws;
    void* args[] = {&a};
    hipError_t e = hipLaunchCooperativeKernel((const void*)hymba_fwd, dim3(grid), dim3(NTHREADS), args, LDS_BYTES, stream);
    if (e != hipSuccess) fprintf(stderr, "kernel_launch: cooperative launch failed: %s (grid %d)\n", hipGetErrorString(e), grid);
}
```

```cpp
#include <hip/hip_runtime.h>
#include <hip/hip_cooperative_groups.h>
#include <cstdio>
namespace cg = cooperative_groups;

#define LAS __attribute__((address_space(3)))
typedef unsigned short bf16_t;
typedef short bf16x8 __attribute__((ext_vector_type(8)));
typedef float f32x4 __attribute__((ext_vector_type(4)));
typedef float f32x16 __attribute__((ext_vector_type(16)));
typedef unsigned u32x4 __attribute__((ext_vector_type(4)));
typedef unsigned u32x2 __attribute__((ext_vector_type(2)));

constexpr int T_TOK = 32768, SEQ = 4096, DM = 1024, NPROJ = 6144, DMIX = 2048;
constexpr float RMS_EPS = 1e-6f;
constexpr int COL_B = 0, COL_CX = 1024, COL_XL = 2048;
constexpr size_t MiB = 1u << 20;
constexpr size_t WS_CTL = 0, CTL_BYTES = 131072;
constexpr size_t WS_WIN = 2 * MiB;
constexpr size_t WS_WOUT = 14 * MiB;
constexpr size_t WS_WG = 18 * MiB;
constexpr size_t WS_SS = 20 * MiB;
constexpr size_t WS_AGG = 22 * MiB;
constexpr size_t WS_XN = 32 * MiB;
constexpr size_t WS_PROJ = 96 * MiB;
constexpr int LDPA = 3072, LDPG = 2048;
constexpr size_t WS_PROJG = WS_PROJ + (size_t)T_TOK * LDPA * 2;
constexpr size_t WS_END = WS_PROJG + (size_t)T_TOK * LDPG * 2;
static_assert(WS_END <= 480 * MiB, "ws");
constexpr int LDS_BYTES = 148480;
constexpr int LDS_EST = 131072, LDS_CTL = 147456;
constexpr int NTHREADS = 512;
#ifndef REP0
#define REP0 1
#endif
#ifndef REP1
#define REP1 1
#endif
#ifndef REP3
#define REP3 1
#endif
#ifndef CONV_R
#define CONV_R 8
#endif
#ifndef PG8_SP2
#define PG8_SP2 1
#endif
#ifndef PG8_ALIGN
#define PG8_ALIGN 1
#endif
#ifndef SKEW1
#define SKEW1 0
#endif
#ifndef SKEW3
#define SKEW3 0
#endif
#ifndef GL_EARLY
#define GL_EARLY 1
#endif
#ifndef REPLRU
#define REPLRU 1
#endif
#ifndef REPCONV
#define REPCONV 1
#endif

struct Args { const float* in[15]; float* out; unsigned char* ws; };
enum { I_X = 0, I_LNG, I_WIN, I_CONVW, I_LCW, I_LCB, I_WA, I_BA, I_WI, I_BI, I_LAM, I_CG, I_LG, I_WOUT, I_FG };

__device__ __forceinline__ unsigned cvt_pk_bf16(float lo, float hi) { unsigned r; asm volatile("v_cvt_pk_bf16_f32 %0, %1, %2" : "=v"(r) : "v"(lo), "v"(hi)); return r; }
__device__ __forceinline__ float bf_lo(unsigned w) { return __uint_as_float(w << 16); }
__device__ __forceinline__ float bf_hi(unsigned w) { return __uint_as_float(w & 0xffff0000u); }
__device__ __forceinline__ float wave_sum(float v) {
#pragma unroll
    for (int o = 1; o < 64; o <<= 1) v += __shfl_xor(v, o);
    return v;
}
__device__ __forceinline__ float sigmoid_fast(float x) { return __builtin_amdgcn_rcpf(1.0f + __builtin_amdgcn_exp2f(-1.44269504f * x)); }
__device__ __forceinline__ void unpack8(const u32x4 v, float (&f)[8]) {
    f[0] = bf_lo(v.x); f[1] = bf_hi(v.x); f[2] = bf_lo(v.y); f[3] = bf_hi(v.y); f[4] = bf_lo(v.z); f[5] = bf_hi(v.z); f[6] = bf_lo(v.w); f[7] = bf_hi(v.w);
}


#define XB_TMO      128
#define XB_XCNT(j)  (256  + 64 * (j))
#define XB_XSUB(j)  (1280 + 64 * (j))
#define XB_XGEN(j)  (2304 + 64 * (j))
#define XB_TOP      3328
#define XB_TOPGEN   3392
#define XCD_BAR_WORDS 3456
#define XB_SPIN_CAP (1u << 20)
__device__ __forceinline__ unsigned xb_ld(unsigned* p)              { return __hip_atomic_load(p, __ATOMIC_RELAXED, __HIP_MEMORY_SCOPE_AGENT); }
__device__ __forceinline__ unsigned xb_add(unsigned* p, unsigned v) { return __hip_atomic_fetch_add(p, v, __ATOMIC_RELAXED, __HIP_MEMORY_SCOPE_AGENT); }
__device__ __forceinline__ unsigned xb_xcc_id() { return (unsigned)__builtin_amdgcn_s_getreg((3 << 11) | 20) & 0xFu; }
#define XB_SPIN(cond, bar) do { unsigned _sp = 0; while (cond) { __builtin_amdgcn_s_sleep(1); \
    if ((++_sp & 255u) == 0u) { if (xb_ld(&(bar)[XB_TMO])) break; if (_sp > XB_SPIN_CAP) { atomicAdd(&(bar)[XB_TMO], 1u); break; } } } } while (0)
struct XcdBarrier { unsigned* bar; unsigned x; volatile LAS unsigned* st; };
__device__ __forceinline__ XcdBarrier xcd_barrier_post(unsigned* bar, volatile LAS unsigned* st) {
    XcdBarrier b; b.bar = bar; b.x = xb_xcc_id(); b.st = st;
    if (threadIdx.x == 0) (void)xb_add(&bar[XB_XCNT(b.x)], 1u);
    return b;
}
__device__ __forceinline__ void xcd_barrier_complete(unsigned* bar, unsigned x, unsigned& nloc, unsigned& nx) {
    const unsigned G = gridDim.x * gridDim.y * gridDim.z;
    unsigned sum, cnt, mine, sp = 0u;
    for (;;) {
        sum = 0u; cnt = 0u; mine = 0u;
#pragma unroll
        for (unsigned j = 0; j < 16; ++j) { const unsigned c = xb_ld(&bar[XB_XCNT(j)]); sum += c; cnt += (c > 0u) ? 1u : 0u; mine = (j == x) ? c : mine; }
        if (sum == G) break;
        __builtin_amdgcn_s_sleep(1);
        if ((++sp & 255u) == 0u) { if (xb_ld(&bar[XB_TMO])) break; if (sp > XB_SPIN_CAP) { atomicAdd(&bar[XB_TMO], 1u); break; } }
    }
    nloc = mine > 0u ? mine : 1u; nx = cnt > 0u ? cnt : 1u;
}
__device__ __forceinline__ void xcd_barrier(const XcdBarrier& b) {
    asm volatile("s_waitcnt vmcnt(0)" ::: "memory");
    __syncthreads();
    if (threadIdx.x == 0) {
        unsigned* bar = b.bar;
        __builtin_amdgcn_s_waitcnt(0);
        unsigned nloc = b.st[0], nx = b.st[1];
        if (nloc == 0u) { xcd_barrier_complete(bar, b.x, nloc, nx); b.st[0] = nloc; b.st[1] = nx; }
        const unsigned old = xb_add(&bar[XB_XSUB(b.x)], 1u);
        const unsigned gen = old / nloc;
        if (old + 1u == (gen + 1u) * nloc) {
            __builtin_amdgcn_fence(__ATOMIC_RELEASE, "agent");
            asm volatile("s_waitcnt vmcnt(0)" ::: "memory");
            const unsigned og = xb_add(&bar[XB_TOP], 1u);
            const unsigned tg = og / nx;
            if (og + 1u == (tg + 1u) * nx) xb_add(&bar[XB_TOPGEN], 1u);
            else XB_SPIN(xb_ld(&bar[XB_TOPGEN]) == tg, bar);
            __builtin_amdgcn_fence(__ATOMIC_ACQUIRE, "agent");
            xb_add(&bar[XB_XGEN(b.x)], 1u);
            asm volatile("s_waitcnt vmcnt(0)" ::: "memory");
        } else {
            XB_SPIN(xb_ld(&bar[XB_XGEN(b.x)]) == gen, bar);
            __builtin_amdgcn_fence(__ATOMIC_ACQUIRE, "agent");
            asm volatile("s_waitcnt vmcnt(0)" ::: "memory");
        }
    }
    __syncthreads();
}

namespace pg8 {
constexpr int BM = 256, BK = 64, HALF = 128, HTB = HALF * BK * 2, STAGE_BYTES = 8 * HTB, NXCD = 8, WGM = 8;
__host__ __device__ __forceinline__ int lds_byte(int r, int c) { const int st = (r >> 4) * 2 + (c >> 5), rr = r & 15, cc = c & 31, ob = rr * 64 + cc * 2; return st * 1024 + (ob ^ (((ob >> 9) & 1) << 5)); }
__host__ __device__ __forceinline__ void stage_rc(int b, int& R, int& C) { const int st = b / 1024, sb = b % 1024, swz = sb ^ (((sb >> 9) & 1) << 5); R = (st >> 1) * 16 + swz / 64; C = (st & 1) * 32 + (swz % 64) / 2; }
__host__ __device__ __forceinline__ int perm32(int rho) { const int n = rho >> 4, i = rho & 15; return 8 * (i >> 2) + 4 * n + (i & 3); }

struct Unit { int pm, pn; };
struct Gemm { const bf16_t* A; const bf16_t* Bt; int M, N, K, lda; int skew; };

struct StaticOrder {
    int nM, nN, nwg, G, c;
    __device__ void init(int M, int N, int G_, int c_) { nM = M / BM; nN = N / BM; nwg = nM * nN; G = G_; c = c_; }
    __device__ bool next(int i, Unit& u) const {
        const long L = (long)i * G + c; if (L >= nwg) return false;
        int wgid = (int)L; { const int q = nwg / NXCD, r = nwg % NXCD, xcd = wgid % NXCD, off = wgid / NXCD; wgid = (xcd < r ? xcd * (q + 1) : r * (q + 1) + (xcd - r) * q) + off; }
        const int nig = WGM * nN, gid = wgid / nig, fm = gid * WGM, gsz = (nM - fm) < WGM ? (nM - fm) : WGM;
        u.pm = fm + ((wgid % nig) % gsz); u.pn = (wgid % nig) / gsz; return true;
    }
};

struct EpiBf16 {
    static constexpr bool PERM = true;
    bf16_t* O; int ldc; bf16_t* O2; int ldc2;
    __device__ __forceinline__ void init(f32x4 (&acc)[2][2][4][2], const Unit&, int, int, int, int) const {
#pragma unroll
        for (int a = 0; a < 2; ++a)
#pragma unroll
            for (int b = 0; b < 2; ++b)
#pragma unroll
                for (int m = 0; m < 4; ++m)
#pragma unroll
                    for (int n = 0; n < 2; ++n) acc[a][b][m][n] = (f32x4){0.f, 0.f, 0.f, 0.f};
    }
    LAS unsigned char* est;
    __device__ __forceinline__ void operator()(f32x4 (&acc)[2][2][4][2], const Unit& u, int wr, int wc, int fr, int fq) const {
        const int lane = fq * 16 + fr; const int pn = u.pn;
        const int rbase = u.pm * BM + wr * 64;
        if (pn >= 4 && pn < 12) {
            const int rrow = lane >> 2, rch = lane & 3;
            bf16_t* gp = O + (size_t)(rbase + rrow) * ldc + 1024 + 128 * (pn - 4) + 32 * wc + rch * 8;
#pragma unroll
            for (int ai = 0; ai < 2; ++ai)
#pragma unroll
                for (int m = 0; m < 4; ++m) {
#pragma unroll
                    for (int bj = 0; bj < 2; ++bj) { const f32x4 p = acc[ai][bj][m][0] * acc[ai][bj][m][1];
                        u32x2 w; w.x = cvt_pk_bf16(p[0], p[1]); w.y = cvt_pk_bf16(p[2], p[3]);
                        const int chunk = 2 * bj + (fq >> 1);
                        *(LAS u32x2*)(est + fr * 64 + ((chunk ^ ((fr >> 1) & 3)) * 16) + (fq & 1) * 8) = w; }
                    const u32x4 v = *(LAS const u32x4*)(est + rrow * 64 + ((rch ^ ((rrow >> 1) & 3)) * 16));
                    *(u32x4*)(gp + (size_t)(ai * HALF + m * 16) * ldc) = v; }
        } else {
            const bool second = pn >= 16;
            const int colt = (second ? (pn - 16) * BM : (pn >= 12 ? 2048 + (pn - 12) * BM : pn * BM)) + wc * 64;
            bf16_t* Ob = second ? O2 : O; const int ld = second ? ldc2 : ldc;
            const int rrow = lane >> 3, rch = lane & 7;
            bf16_t* gp = Ob + (size_t)(rbase + rrow) * ld + colt + rch * 8;
#pragma unroll
            for (int ai = 0; ai < 2; ++ai)
#pragma unroll
                for (int m = 0; m < 4; ++m) {
#pragma unroll
                    for (int bj = 0; bj < 2; ++bj) { f32x4 v0 = acc[ai][bj][m][0], v1 = acc[ai][bj][m][1];
                        u32x4 w; w.x = cvt_pk_bf16(v0[0], v0[1]); w.y = cvt_pk_bf16(v0[2], v0[3]); w.z = cvt_pk_bf16(v1[0], v1[1]); w.w = cvt_pk_bf16(v1[2], v1[3]);
                        *(LAS u32x4*)(est + fr * 128 + (((4 * bj + fq) ^ (fr & 7)) * 16)) = w; }
#pragma unroll
                    for (int p = 0; p < 2; ++p) { const int row = p * 8 + rrow;
                        const u32x4 v = *(LAS const u32x4*)(est + row * 128 + ((rch ^ (row & 7)) * 16));
                        *(u32x4*)(gp + (size_t)(ai * HALF + m * 16 + p * 8) * ld) = v; } }
        }
    }
};
struct EpiResidNorm {
    static constexpr bool PERM = false;
    const float* x; float* out; unsigned* ss; unsigned* cnt; const float* fg; LAS unsigned char* est;
    __device__ __forceinline__ void init(f32x4 (&acc)[2][2][4][2], const Unit& u, int wr, int wc, int fr, int fq) const {
        const int row0 = u.pm * BM + wr * 64 + fr, col0 = u.pn * BM + wc * 32 + 4 * fq;
#pragma unroll
        for (int ai = 0; ai < 2; ++ai)
#pragma unroll
            for (int m = 0; m < 4; ++m) { const size_t off = (size_t)(row0 + ai * HALF + m * 16) * DM + col0;
#pragma unroll
                for (int bj = 0; bj < 2; ++bj)
#pragma unroll
                    for (int n = 0; n < 2; ++n) acc[ai][bj][m][n] = __builtin_nontemporal_load((const f32x4*)(x + off + bj * HALF + n * 16)); }
    }
    __device__ __forceinline__ void operator()(f32x4 (&acc)[2][2][4][2], const Unit& u, int wr, int wc, int fr, int fq) const {
        const int row0 = u.pm * BM + wr * 64 + fr, col0 = u.pn * BM + wc * 32 + 4 * fq;
#pragma unroll
        for (int ai = 0; ai < 2; ++ai)
#pragma unroll
            for (int m = 0; m < 4; ++m) { const int row = row0 + ai * HALF + m * 16; const size_t off = (size_t)row * DM + col0; float s = 0.f;
#pragma unroll
                for (int bj = 0; bj < 2; ++bj)
#pragma unroll
                    for (int n = 0; n < 2; ++n) { const f32x4 o = acc[ai][bj][m][n]; s += (o[0] * o[0] + o[1] * o[1]) + (o[2] * o[2] + o[3] * o[3]); }
                s += __shfl_xor(s, 16); s += __shfl_xor(s, 32);
                if (fq == 0) __hip_atomic_store(ss + (size_t)row * 16 + u.pn * 4 + wc, __float_as_uint(s), __ATOMIC_RELAXED, __HIP_MEMORY_SCOPE_AGENT); }
        asm volatile("s_waitcnt vmcnt(0)" ::: "memory");
        unsigned* c = cnt + (u.pm * 2 + wr) * 32;
        if ((threadIdx.x & 63) == 0) __hip_atomic_fetch_add(c, 1u, __ATOMIC_RELAXED, __HIP_MEMORY_SCOPE_AGENT);
        { unsigned spins = 0;
          while ((unsigned)__builtin_amdgcn_readfirstlane(__hip_atomic_load(c, __ATOMIC_RELAXED, __HIP_MEMORY_SCOPE_AGENT)) < 16u) { __builtin_amdgcn_s_sleep(2); if (++spins > (1u << 22)) break; } }
        asm volatile("" ::: "memory");
#pragma unroll
        for (int ai = 0; ai < 2; ++ai)
#pragma unroll
            for (int m = 0; m < 4; ++m) { const int row = row0 + ai * HALF + m * 16; const size_t off = (size_t)row * DM + col0;
                const unsigned long long* sp = (const unsigned long long*)(ss + (size_t)row * 16 + fq * 4);
                const unsigned long long p0 = __hip_atomic_load(sp, __ATOMIC_RELAXED, __HIP_MEMORY_SCOPE_AGENT), p1 = __hip_atomic_load(sp + 1, __ATOMIC_RELAXED, __HIP_MEMORY_SCOPE_AGENT);
                float t = (__uint_as_float((unsigned)p0) + __uint_as_float((unsigned)(p0 >> 32))) + (__uint_as_float((unsigned)p1) + __uint_as_float((unsigned)(p1 >> 32)));
                t += __shfl_xor(t, 16); t += __shfl_xor(t, 32);
                const float rstd = 1.0f / sqrtf(t * (1.f / DM) + RMS_EPS);
                const int lane_ = fq * 16 + fr, rrow = lane_ >> 3, rch = lane_ & 7;
#pragma unroll
                for (int bj = 0; bj < 2; ++bj) {
#pragma unroll
                    for (int n = 0; n < 2; ++n) { const f32x4 gv = *(const f32x4*)(fg + col0 + bj * HALF + n * 16);
                        *(LAS f32x4*)(est + fr * 128 + (((4 * n + fq) ^ (fr & 7)) * 16)) = acc[ai][bj][m][n] * rstd * gv; }
#pragma unroll
                    for (int p = 0; p < 2; ++p) { const int rl = p * 8 + rrow;
                        const f32x4 v = *(LAS const f32x4*)(est + rl * 128 + ((rch ^ (rl & 7)) * 16));
                        *(f32x4*)(out + (size_t)(u.pm * BM + wr * 64 + ai * HALF + m * 16 + rl) * DM + u.pn * BM + bj * HALF + wc * 32 + rch * 4) = v; } } }
    }
};

template <class Epi>
__device__ __forceinline__ void gemm_phase(LAS unsigned char* lds, const Gemm g, const StaticOrder& S, const Epi& E) {
    const int tid = threadIdx.x, wid = __builtin_amdgcn_readfirstlane(tid >> 6), lane = tid & 63, wr = wid >> 2, wc = wid & 3, fr = lane & 15, fq = lane >> 4;
    const int K = g.K, nt = K / BK, lda = g.lda;
    unsigned voffA[2], voffB[2];
#pragma unroll
    for (int i = 0; i < 2; ++i) { int R, C; stage_rc(tid * 16 + i * 8192, R, C); const int Rb = Epi::PERM ? ((R & ~31) + perm32(R & 31)) : R;
        voffA[i] = (unsigned)(R * lda + C) * 2u; voffB[i] = (unsigned)(Rb * K + C) * 2u; }
    const size_t kstep = (size_t)(BK * 2);
    const size_t hstepA = (size_t)HALF * lda * 2, hstepB = (size_t)HALF * K * 2;
    const size_t tstepA = 2 * hstepA, tstepB = 2 * hstepB;
    const unsigned ldsw = (unsigned)wid * 1024u;
    const int aoff = lds_byte(wr * 64 + fr, fq * 8), boff = lds_byte(wc * 32 + fr, fq * 8);
#define PG8_SA(b, h) (((b) * 2 + (h)) * HTB)
#define PG8_SB(b, h) ((4 + (b) * 2 + (h)) * HTB)
#define PG8_STAGE(bufoff, gbase, voff) do { _Pragma("unroll") for (int _i = 0; _i < 2; ++_i) \
        __builtin_amdgcn_global_load_lds((const unsigned*)((const char*)(gbase) + (voff)[_i]), (LAS unsigned*)(lds + (bufoff) + ldsw + _i * 8192), 16, 0, 0); } while (0)
#define PG8_LDA(dst, b, h) do { _Pragma("unroll") for (int m = 0; m < 4; ++m) _Pragma("unroll") for (int k = 0; k < 2; ++k) dst[m][k] = *(const LAS bf16x8*)(lds + PG8_SA(b, h) + aoff + m * 2048 + k * 1024); } while (0)
#define PG8_LDB(dst, b, h) do { _Pragma("unroll") for (int n = 0; n < 2; ++n) _Pragma("unroll") for (int k = 0; k < 2; ++k) dst[n][k] = *(const LAS bf16x8*)(lds + PG8_SB(b, h) + boff + n * 2048 + k * 1024); } while (0)
#define PG8_MMA(ai, bj, At, Bt) do { __builtin_amdgcn_s_setprio(1); _Pragma("unroll") for (int m = 0; m < 4; ++m) _Pragma("unroll") for (int n = 0; n < 2; ++n) _Pragma("unroll") for (int k = 0; k < 2; ++k) \
        acc[ai][bj][m][n] = __builtin_amdgcn_mfma_f32_16x16x32_bf16(Bt[n][k], At[m][k], acc[ai][bj][m][n], 0, 0, 0); __builtin_amdgcn_s_setprio(0); } while (0)
#define PG8_WAIT_V(n) asm volatile("s_waitcnt vmcnt(" #n ")" ::: "memory")
#define PG8_WAIT_L(n) asm volatile("s_waitcnt lgkmcnt(" #n ")" ::: "memory")
#define PG8_BAR __builtin_amdgcn_s_barrier()
#define PG8_SCHED __builtin_amdgcn_sched_barrier(0)
    Unit cur, nxt; int ui = 0;
    if (!S.next(0, cur)) return;
    if (g.skew > 0) { const unsigned long long t0 = __builtin_amdgcn_s_memrealtime(), dt = (unsigned long long)((blockIdx.x & 7u) * (unsigned)g.skew);
        while (__builtin_amdgcn_s_memrealtime() - t0 < dt) __builtin_amdgcn_s_sleep(8); }
    f32x4 acc[2][2][4][2];
    E.init(acc, cur, wr, wc, fr, fq);
    bf16x8 At[4][2], B0[2][2], B1[2][2];
    const char* cA = (const char*)g.A + (size_t)cur.pm * tstepA; const char* cB = (const char*)g.Bt + (size_t)cur.pn * tstepB;
#if PG8_SP2
    PG8_STAGE(PG8_SB(0, 0), cB, voffB); PG8_STAGE(PG8_SB(0, 1), cB + hstepB, voffB); PG8_STAGE(PG8_SA(0, 0), cA, voffA); PG8_STAGE(PG8_SA(0, 1), cA + hstepA, voffA);
    if (wr == 1) PG8_BAR;
    PG8_WAIT_V(2); PG8_BAR;
    PG8_STAGE(PG8_SB(1, 0), cB + kstep, voffB); PG8_STAGE(PG8_SA(1, 0), cA + kstep, voffA); PG8_STAGE(PG8_SB(1, 1), cB + hstepB + kstep, voffB);
    PG8_WAIT_V(6); PG8_BAR;
#else
    PG8_STAGE(PG8_SB(0, 0), cB, voffB); PG8_STAGE(PG8_SA(0, 0), cA, voffA); PG8_STAGE(PG8_SB(0, 1), cB + hstepB, voffB); PG8_STAGE(PG8_SA(0, 1), cA + hstepA, voffA);
    if (wr == 1) PG8_BAR;
    PG8_WAIT_V(4); PG8_BAR;
    PG8_STAGE(PG8_SB(1, 0), cB + kstep, voffB); PG8_STAGE(PG8_SA(1, 0), cA + kstep, voffA); PG8_STAGE(PG8_SB(1, 1), cB + hstepB + kstep, voffB);
    PG8_WAIT_V(6); PG8_BAR;
#endif
    for (;;) {
        const bool has_next = S.next(ui + 1, nxt);
        const char* nA = has_next ? (const char*)g.A + (size_t)nxt.pm * tstepA : cA; const char* nB = has_next ? (const char*)g.Bt + (size_t)nxt.pn * tstepB : cB;
        for (int t = 0; t < nt; t += 2) {
            const bool last = (t == nt - 2);
            const char* a1 = cA + (size_t)(t + 1) * kstep;
            const char* a2 = last ? nA : cA + (size_t)(t + 2) * kstep; const char* b2 = last ? nB : cB + (size_t)(t + 2) * kstep;
            const char* a3 = a2 + kstep; const char* b3 = b2 + kstep;
#if PG8_SP2
            PG8_LDB(B0, 0, 0); PG8_LDB(B1, 0, 1); PG8_SCHED; PG8_LDA(At, 0, 0); PG8_STAGE(PG8_SA(1, 1), a1 + hstepA, voffA);
            PG8_WAIT_V(8); PG8_WAIT_L(0); PG8_BAR; PG8_MMA(0, 0, At, B0); PG8_MMA(0, 1, At, B1); PG8_BAR; PG8_SCHED;
            PG8_LDA(At, 0, 1); PG8_STAGE(PG8_SB(0, 0), b2, voffB); PG8_STAGE(PG8_SB(0, 1), b2 + hstepB, voffB); PG8_STAGE(PG8_SA(0, 0), a2, voffA);
            PG8_WAIT_V(8); PG8_WAIT_L(0); PG8_BAR; PG8_MMA(1, 0, At, B0); PG8_MMA(1, 1, At, B1); PG8_BAR; PG8_SCHED;
            PG8_LDB(B0, 1, 0); PG8_LDB(B1, 1, 1); PG8_SCHED; PG8_LDA(At, 1, 0); PG8_STAGE(PG8_SA(0, 1), a2 + hstepA, voffA);
            PG8_WAIT_V(8); PG8_WAIT_L(0); PG8_BAR; PG8_MMA(0, 0, At, B0); PG8_MMA(0, 1, At, B1); PG8_BAR; PG8_SCHED;
            PG8_LDA(At, 1, 1); PG8_STAGE(PG8_SB(1, 0), b3, voffB); PG8_STAGE(PG8_SB(1, 1), b3 + hstepB, voffB); PG8_STAGE(PG8_SA(1, 0), a3, voffA);
            PG8_WAIT_V(8); PG8_WAIT_L(0); PG8_BAR; PG8_MMA(1, 0, At, B0); PG8_MMA(1, 1, At, B1); PG8_BAR; PG8_SCHED;
#else
            PG8_LDB(B0, 0, 0); PG8_SCHED; PG8_LDA(At, 0, 0); PG8_STAGE(PG8_SA(1, 1), a1 + hstepA, voffA);
            PG8_WAIT_L(8); PG8_BAR; PG8_WAIT_L(0); PG8_MMA(0, 0, At, B0); PG8_BAR; PG8_SCHED;
            PG8_LDB(B1, 0, 1); PG8_STAGE(PG8_SB(0, 0), b2, voffB);
            PG8_BAR; PG8_WAIT_L(0); PG8_MMA(0, 1, At, B1); PG8_BAR;
            PG8_LDA(At, 0, 1); PG8_STAGE(PG8_SA(0, 0), a2, voffA);
            PG8_BAR; PG8_WAIT_L(0); PG8_MMA(1, 0, At, B0); PG8_BAR; PG8_SCHED;
            PG8_STAGE(PG8_SB(0, 1), b2 + hstepB, voffB);
            PG8_WAIT_V(6); PG8_BAR; PG8_MMA(1, 1, At, B1); PG8_BAR;
            PG8_LDB(B0, 1, 0); PG8_SCHED; PG8_LDA(At, 1, 0); PG8_STAGE(PG8_SA(0, 1), a2 + hstepA, voffA);
            PG8_WAIT_L(8); PG8_BAR; PG8_WAIT_L(0); PG8_MMA(0, 0, At, B0); PG8_BAR; PG8_SCHED;
            PG8_LDB(B1, 1, 1); PG8_STAGE(PG8_SB(1, 0), b3, voffB);
            PG8_BAR; PG8_WAIT_L(0); PG8_MMA(0, 1, At, B1); PG8_BAR;
            PG8_LDA(At, 1, 1); PG8_STAGE(PG8_SA(1, 0), a3, voffA);
            PG8_BAR; PG8_WAIT_L(0); PG8_MMA(1, 0, At, B0); PG8_BAR; PG8_SCHED;
            PG8_STAGE(PG8_SB(1, 1), b3 + hstepB, voffB);
            PG8_WAIT_V(6); PG8_BAR; PG8_MMA(1, 1, At, B1); PG8_BAR;
#endif
        }
#if PG8_ALIGN
        if (wr == 0) PG8_BAR;
#endif
        E(acc, cur, wr, wc, fr, fq);
        if (!has_next) break;
        cur = nxt; cA = nA; cB = nB; ++ui;
        E.init(acc, cur, wr, wc, fr, fq);
#if PG8_ALIGN
        if (wr == 1) PG8_BAR;
#endif
    }
    PG8_WAIT_V(0);
#if !PG8_ALIGN
    if (wr == 0) PG8_BAR;
#endif
    PG8_BAR;
#undef PG8_SA
#undef PG8_SB
#undef PG8_STAGE
#undef PG8_LDA
#undef PG8_LDB
#undef PG8_MMA
#undef PG8_WAIT_V
#undef PG8_WAIT_L
#undef PG8_BAR
#undef PG8_SCHED
}
}

__device__ __forceinline__ void p0_transpose_item(const float* W, int ldw, int k0, int ncol0, bf16_t* WT, int ldt, int drow0, int dk0, LAS float* scr, int lane, int mode = 0) {
#pragma unroll 8
    for (int i = 0; i < 32; ++i) { const int kk = 2 * i + (lane >> 5); scr[kk * 33 + (lane & 31)] = __builtin_nontemporal_load(W + (size_t)(k0 + kk) * ldw + ncol0 + (lane & 31)); }
    asm volatile("s_waitcnt lgkmcnt(0)" ::: "memory");
    const int c = lane & 7;
#pragma unroll
    for (int j = 0; j < 4; ++j) { const int n = (lane >> 3) + 8 * j; const LAS float* s = scr + (8 * c) * 33 + n;
        u32x4 o; o.x = cvt_pk_bf16(s[0 * 33], s[1 * 33]); o.y = cvt_pk_bf16(s[2 * 33], s[3 * 33]); o.z = cvt_pk_bf16(s[4 * 33], s[5 * 33]); o.w = cvt_pk_bf16(s[6 * 33], s[7 * 33]);
        int drow = drow0 + n;
        if (mode) { const int ch = drow0 + n; drow = 1024 + 256 * (ch >> 7) + 128 * ((ch >> 4) & 1) + 32 * ((ch >> 5) & 3) + 8 * ((ch >> 2) & 3) + 4 * (mode - 1) + (ch & 3); }
        *(u32x4*)(WT + (size_t)drow * ldt + dk0 + 8 * c) = o; }
    asm volatile("s_waitcnt lgkmcnt(0)" ::: "memory");
}

__device__ __forceinline__ void phase0(const Args& a, LAS unsigned char* lds, int wave, int lane) {
    LAS float* scr = (LAS float*)(lds + wave * 16384);
    const int gw = blockIdx.x * 8 + wave, NGW = gridDim.x * 8;
    bf16_t* win_t = (bf16_t*)(a.ws + WS_WIN); bf16_t* wout_t = (bf16_t*)(a.ws + WS_WOUT); bf16_t* wg = (bf16_t*)(a.ws + WS_WG);
    constexpr int I_IN = 16 * 192, I_OUT = 32 * 32, I_G = 64;
    for (int it = gw; it < I_IN + I_OUT + I_G; it += NGW) {
        int r = it;
        if (r < I_IN) { const int kb = r / 192, nb = r % 192; const int og = nb / 32;
            if (og == 1 || og == 2) p0_transpose_item(a.in[I_WIN], NPROJ, kb * 64, nb * 32, win_t, DM, (nb % 32) * 32, kb * 64, scr, lane, og);
            else { const int nbase = (og == 0) ? 0 : (og == 4 ? 3072 : (og == 3 ? 4096 : 5120));
                const int q = nb % 32;
                p0_transpose_item(a.in[I_WIN], NPROJ, kb * 64, nb * 32, win_t, DM, nbase + 256 * (q >> 3) + 128 * (q & 1) + 32 * ((q & 7) >> 1), kb * 64, scr, lane, 0); }
            continue; }
        r -= I_IN;
        if (r < I_OUT) { const int kb = r / 32, nb = r % 32; p0_transpose_item(a.in[I_WOUT], DM, kb * 64, nb * 32, wout_t, DMIX, nb * 32, kb * 64, scr, lane); continue; }
        r -= I_OUT;
        { const int mat = r / 32, h = (r % 32) / 2, nb = r & 1; const float* W = (mat ? a.in[I_WI] : a.in[I_WA]) + h * 4096;
          p0_transpose_item(W, 64, 0, nb * 32, wg + mat * 65536 + h * 4096, 64, nb * 32, 0, scr, lane); }
    }
    const float* x = a.in[I_X]; bf16_t* xn = (bf16_t*)(a.ws + WS_XN);
    f32x4 gv[4];
#pragma unroll
    for (int j = 0; j < 4; ++j) gv[j] = ((const f32x4*)a.in[I_LNG])[lane + 64 * j];
    for (int m = gw; m < T_TOK; m += NGW) {
        const f32x4* xr = (const f32x4*)(x + (size_t)m * DM) + lane;
        f32x4 v[4]; float s = 0.f;
#pragma unroll
        for (int j = 0; j < 4; ++j) { v[j] = __builtin_nontemporal_load(xr + 64 * j); s += (v[j].x * v[j].x + v[j].y * v[j].y) + (v[j].z * v[j].z + v[j].w * v[j].w); }
        const float rstd = 1.0f / sqrtf(wave_sum(s) * (1.f / DM) + RMS_EPS);
        u32x2* o8 = (u32x2*)(xn + (size_t)m * DM) + lane;
#pragma unroll
        for (int j = 0; j < 4; ++j) { u32x2 w; w.x = cvt_pk_bf16(v[j].x * rstd * gv[j].x, v[j].y * rstd * gv[j].y); w.y = cvt_pk_bf16(v[j].z * rstd * gv[j].z, v[j].w * rstd * gv[j].w); o8[64 * j] = w; }
    }
}

#define DPP_ADD(v, ctrl) ((v) + __uint_as_float(__builtin_amdgcn_update_dpp(0, __float_as_uint(v), (ctrl), 0xF, 0xF, false)))
__device__ __forceinline__ void conv_item(const Args& a, bf16_t* proj, bf16_t* projg, bf16_t* obase, int ostride, int item, int wave, int lane) {
    const int q = lane >> 4, c8 = lane & 15, ch0 = wave * 128 + c8 * 8;
    float w0[8], w1[8], w2[8], gn[8];
    { const float* cw = a.in[I_CONVW] + ch0; const float* cg_ = a.in[I_CG] + ch0;
#pragma unroll
      for (int j = 0; j < 8; ++j) { w0[j] = cw[j]; w1[j] = cw[1024 + j]; w2[j] = cw[2048 + j]; gn[j] = cg_[j]; } }
    const int tok0 = item * (4 * CONV_R) + q * CONV_R;
    bf16_t* base = proj + (size_t)tok0 * LDPA + ch0; const bf16_t* gbase = projg + (size_t)tok0 * LDPG + ch0;
    float p2[8], p1[8];
    if ((tok0 & (SEQ - 1)) == 0) {
#pragma unroll
        for (int j = 0; j < 8; ++j) { p2[j] = 0.f; p1[j] = 0.f; }
    } else {
        const u32x4 c2 = *(const u32x4*)(base - 2 * LDPA + COL_CX), c1 = *(const u32x4*)(base - 1 * LDPA + COL_CX);
        unpack8(c2, p2); unpack8(c1, p1);
    }
    u32x4 nb[2], nc[2], ng[2];
#pragma unroll
    for (int k = 0; k < 2; ++k) { const bf16_t* rp = base + (size_t)k * LDPA; nb[k] = __builtin_nontemporal_load((const u32x4*)(rp + COL_B)); nc[k] = __builtin_nontemporal_load((const u32x4*)(rp + COL_CX)); ng[k] = __builtin_nontemporal_load((const u32x4*)(gbase + (size_t)k * LDPG)); }
    for (int i = 0; i < CONV_R; i += 2) {
        u32x4 vb[2], vc[2], vg[2];
#pragma unroll
        for (int k = 0; k < 2; ++k) { vb[k] = nb[k]; vc[k] = nc[k]; vg[k] = ng[k]; }
        if (i + 2 < CONV_R) {
#pragma unroll
            for (int k = 0; k < 2; ++k) { const bf16_t* rp = base + (size_t)(i + 2 + k) * LDPA; nb[k] = __builtin_nontemporal_load((const u32x4*)(rp + COL_B)); nc[k] = __builtin_nontemporal_load((const u32x4*)(rp + COL_CX)); ng[k] = __builtin_nontemporal_load((const u32x4*)(gbase + (size_t)(i + 2 + k) * LDPG)); }
        }
#pragma unroll
        for (int k = 0; k < 2; ++k) {
            float fb[8], cx[8], fg[8], y[8];
            unpack8(vb[k], fb); unpack8(vc[k], cx); unpack8(vg[k], fg);
            float ss = 0.f;
#pragma unroll
            for (int j = 0; j < 8; ++j) { const float cv = w0[j] * p2[j] + w1[j] * p1[j] + w2[j] * cx[j]; y[j] = fb[j] * cv; ss += y[j] * y[j]; p2[j] = p1[j]; p1[j] = cx[j]; }
            ss = DPP_ADD(ss, 0xB1); ss = DPP_ADD(ss, 0x4E); ss = DPP_ADD(ss, 0x141); ss = DPP_ADD(ss, 0x140);
            const float rstd = __builtin_amdgcn_rsqf(ss * (1.f / 128.f) + RMS_EPS);
            float o[8];
#pragma unroll
            for (int j = 0; j < 8; ++j) o[j] = y[j] * rstd * gn[j] * (fg[j] * sigmoid_fast(fg[j]));
            u32x4 w; w.x = cvt_pk_bf16(o[0], o[1]); w.y = cvt_pk_bf16(o[2], o[3]); w.z = cvt_pk_bf16(o[4], o[5]); w.w = cvt_pk_bf16(o[6], o[7]);
            *(u32x4*)(obase + (size_t)(tok0 + i + k) * ostride + ch0) = w;
        }
    }
}

constexpr int L_GW = 0;
constexpr int L_CW = 18432;
constexpr int L_AGG = 20992;
constexpr int L_WT = 29184;
constexpr int WT_BYTES = 8704;
static_assert(L_WT + 8 * WT_BYTES <= 131072, "lds");
typedef float f32x2 __attribute__((ext_vector_type(2)));

__device__ __forceinline__ void lru_item(const Args& a, bf16_t* proj, bf16_t* projg, bf16_t* obase, int ostride, LAS unsigned char* lds, int chain, int part, int nsplit, int tid, int wave, int lane) {
    const int b = chain >> 4, h = chain & 15;
    {
        const bf16_t* wg = (const bf16_t*)(a.ws + WS_WG);
        for (int i = tid; i < 1024; i += NTHREADS) { const int mat = i >> 9, e = (i >> 3) & 63, c = i & 7;
            const u32x4 v = *(const u32x4*)(wg + mat * 65536 + h * 4096 + e * 64 + c * 8);
            *(LAS u32x4*)(lds + L_GW + mat * 9216 + e * 144 + c * 16) = v; }
        LAS float* cw = (LAS float*)(lds + L_CW);
        if (tid < 256) cw[tid] = a.in[I_LCW][(tid >> 6) * 1024 + h * 64 + (tid & 63)];
        else if (tid < 320) { const int c = tid - 256, gc = h * 64 + c;
            cw[256 + c] = a.in[I_LCB][gc]; cw[320 + c] = a.in[I_BA][gc]; cw[384 + c] = a.in[I_BI][gc];
            const float lam = a.in[I_LAM][gc];
            const float logsig = (lam >= 0.f) ? -log1pf(expf(-lam)) : (lam - log1pf(expf(lam)));
            cw[448 + c] = 8.0f * logsig * 1.44269504f;
            cw[512 + c] = a.in[I_LG][gc]; }
    }
    __syncthreads();
    const int r = lane & 31, hh = lane >> 5;
    LAS unsigned char* wt = lds + L_WT + wave * WT_BYTES;
    LAS const float* cw = (LAS const float*)(lds + L_CW);
    bf16x8 I0, I1;
    {
        u32x4 t0 = (u32x4){0u, 0u, 0u, 0u}, t1 = t0;
        const int j0 = r - 8 * hh, j1 = r - 16 - 8 * hh;
#pragma unroll
        for (int d = 0; d < 4; ++d) {
            t0[d] = (j0 == 2 * d) ? 0x00003F80u : ((j0 == 2 * d + 1) ? 0x3F800000u : 0u);
            t1[d] = (j1 == 2 * d) ? 0x00003F80u : ((j1 == 2 * d + 1) ? 0x3F800000u : 0u);
        }
        I0 = __builtin_bit_cast(bf16x8, t0); I1 = __builtin_bit_cast(bf16x8, t1);
    }
    float ba[2], bi[2], cf[2];
#pragma unroll
    for (int n = 0; n < 2; ++n) { ba[n] = cw[320 + 32 * n + r]; bi[n] = cw[384 + 32 * n + r]; cf[n] = cw[448 + 32 * n + r]; }
    float carry[2] = {0.f, 0.f};
    unsigned* flags = (unsigned*)(a.ws + WS_CTL + 4096) + chain * 32;
    unsigned long long* aggg = (unsigned long long*)(a.ws + WS_AGG) + (size_t)chain * 16 * 64;

    const bf16_t* xl_base = proj + (size_t)b * SEQ * LDPA + COL_XL + h * 64;
    const bf16_t* gl_base = projg + (size_t)b * SEQ * LDPG + 1024 + h * 64;
    u32x4 xr[5];
#define LOAD_X(seg_) do { const int s0_ = (seg_) * 256 + wave * 32; _Pragma("unroll") for (int i = 0; i < 5; ++i) { const int idx = lane + 64 * i, row = idx >> 3, c = idx & 7; const int s = s0_ - 3 + row; \
        xr[i] = (u32x4){0u, 0u, 0u, 0u}; if (idx < 280 && s >= 0) xr[i] = __builtin_nontemporal_load((const u32x4*)(xl_base + (size_t)s * LDPA + c * 8)); } } while (0)
    LOAD_X(part);
    for (int seg = part; seg < 16; seg += nsplit) {
        const int s0 = seg * 256 + wave * 32;
#pragma unroll
        for (int i = 0; i < 5; ++i) { const int idx = lane + 64 * i, row = idx >> 3, c = idx & 7; if (idx < 280) *(LAS u32x4*)(wt + row * 144 + c * 16) = xr[i]; }
        if (seg + nsplit < 16) LOAD_X(seg + nsplit);
        u32x4 gl[4];
#define LOAD_GL() do { _Pragma("unroll") for (int i = 0; i < 4; ++i) { const int tok = (lane >> 3) + 8 * i, c = lane & 7; gl[i] = __builtin_nontemporal_load((const u32x4*)(gl_base + (size_t)(s0 + tok) * LDPG + c * 8)); } } while (0)
#if GL_EARLY
        LOAD_GL();
#endif
        asm volatile("s_waitcnt lgkmcnt(0)" ::: "memory");
        bf16x8 Af[4];
#pragma unroll
        for (int s = 0; s < 4; ++s) {
            const int c0 = 16 * s + 8 * hh;
            float u8[8];
            { const f32x4 b0 = *(LAS const f32x4*)(cw + 256 + c0), b1 = *(LAS const f32x4*)(cw + 256 + c0 + 4);
              u8[0] = b0[0]; u8[1] = b0[1]; u8[2] = b0[2]; u8[3] = b0[3]; u8[4] = b1[0]; u8[5] = b1[1]; u8[6] = b1[2]; u8[7] = b1[3]; }
#pragma unroll
            for (int k = 0; k < 4; ++k) {
                const u32x4 xv = *(LAS const u32x4*)(wt + (r + k) * 144 + c0 * 2);
                const f32x4 wv0 = *(LAS const f32x4*)(cw + k * 64 + c0), wv1 = *(LAS const f32x4*)(cw + k * 64 + c0 + 4);
                float fx[8]; unpack8(xv, fx);
                u8[0] += wv0[0] * fx[0]; u8[1] += wv0[1] * fx[1]; u8[2] += wv0[2] * fx[2]; u8[3] += wv0[3] * fx[3];
                u8[4] += wv1[0] * fx[4]; u8[5] += wv1[1] * fx[5]; u8[6] += wv1[2] * fx[6]; u8[7] += wv1[3] * fx[7];
            }
            u32x4 pk; pk.x = cvt_pk_bf16(u8[0], u8[1]); pk.y = cvt_pk_bf16(u8[2], u8[3]); pk.z = cvt_pk_bf16(u8[4], u8[5]); pk.w = cvt_pk_bf16(u8[6], u8[7]);
            Af[s] = __builtin_bit_cast(bf16x8, pk);
        }
#pragma unroll
        for (int n = 0; n < 2; ++n) {
            float hl[16], pc[16];
            f32x16 accR, accI, accU;
#pragma unroll
            for (int j = 0; j < 16; ++j) { accR[j] = 0.f; accI[j] = 0.f; accU[j] = 0.f; }
#pragma unroll
            for (int s = 0; s < 4; ++s) {
                const bf16x8 Ba = *(LAS const bf16x8*)(lds + L_GW + (32 * n + r) * 144 + (16 * s + 8 * hh) * 2);
                const bf16x8 Bi = *(LAS const bf16x8*)(lds + L_GW + 9216 + (32 * n + r) * 144 + (16 * s + 8 * hh) * 2);
                accR = __builtin_amdgcn_mfma_f32_32x32x16_bf16(Af[s], Ba, accR, 0, 0, 0);
                accI = __builtin_amdgcn_mfma_f32_32x32x16_bf16(Af[s], Bi, accI, 0, 0, 0);
            }
            accU = __builtin_amdgcn_mfma_f32_32x32x16_bf16(Af[2 * n], I0, accU, 0, 0, 0);
            accU = __builtin_amdgcn_mfma_f32_32x32x16_bf16(Af[2 * n + 1], I1, accU, 0, 0, 0);
            float gP[4], gH[4];
#pragma unroll
            for (int g = 0; g < 4; ++g) {
                float P = 1.f, H = 0.f;
#pragma unroll
                for (int i = 0; i < 4; ++i) { const int j = 4 * g + i;
                    const float rr = sigmoid_fast(accR[j] + ba[n]);
                    const float ii = sigmoid_fast(accI[j] + bi[n]);
                    const float l2 = rr * cf[n];
                    const float aa = __builtin_amdgcn_exp2f(l2);
                    const float t = l2 * 1.38629436f;
                    const float em_small = -t * (1.0f + t * (0.5f + t * (0.16666667f + t * 0.041666667f)));
                    const float one_m = (t > -0.0625f) ? em_small : (1.0f - aa * aa);
                    const float dd = __builtin_amdgcn_sqrtf(one_m) * ii * accU[j];
                    H = aa * H + dd; P = P * aa; hl[j] = H; pc[j] = P; }
                gP[g] = P; gH[g] = H;
            }
            float cp = 1.f, ch = 0.f;
#pragma unroll
            for (int g = 0; g < 4; ++g) {
                const auto sp = __builtin_amdgcn_permlane32_swap(__float_as_uint(gP[g]), __float_as_uint(gP[g]), false, false);
                const auto sh = __builtin_amdgcn_permlane32_swap(__float_as_uint(gH[g]), __float_as_uint(gH[g]), false, false);
                const float oP = __uint_as_float(hh ? sp[0] : sp[1]), oH = __uint_as_float(hh ? sh[0] : sh[1]);
                const float P = gP[g], H = gH[g];
                const float A1 = hh ? oP : P, H1 = hh ? oH : H, A2 = hh ? P : oP, H2 = hh ? H : oH;
                const float cp1 = cp * A1, ch1 = A1 * ch + H1;
                const float inP = hh ? cp1 : cp, inH = hh ? ch1 : ch;
#pragma unroll
                for (int i = 0; i < 4; ++i) { const int j = 4 * g + i; hl[j] += pc[j] * inH; pc[j] *= inP; }
                cp = cp1 * A2; ch = A2 * ch1 + H2;
            }
            if (hh == 0) *(LAS f32x2*)(lds + L_AGG + ((n * 8 + wave) * 64 + 32 * n + r) * 8) = (f32x2){cp, ch};
#if !GL_EARLY
            if (n == 1) LOAD_GL();
#endif
            if (nsplit > 1 && seg > 0 && wave == 0) {
                unsigned spins = 0;
                while (__builtin_amdgcn_readfirstlane(__hip_atomic_load(flags + (seg - 1) * 2 + n, __ATOMIC_RELAXED, __HIP_MEMORY_SCOPE_AGENT)) == 0u) { __builtin_amdgcn_s_sleep(2); if (++spins > (1u << 22)) break; }
                asm volatile("" ::: "memory");
            }
            __syncthreads();
            float c = carry[n];
            if (nsplit > 1 && seg > 0) {
                const unsigned long long pw = __hip_atomic_load(aggg + (size_t)(seg - 1) * 64 + n * 32 + r, __ATOMIC_RELAXED, __HIP_MEMORY_SCOPE_AGENT);
                c = __uint_as_float((unsigned)pw) * c + __uint_as_float((unsigned)(pw >> 32));
            }
            float cin = 0.f, iP = 1.f, iH = 0.f;
#pragma unroll
            for (int w = 0; w < 8; ++w) {
                const f32x2 ag = *(LAS const f32x2*)(lds + L_AGG + ((n * 8 + w) * 64 + 32 * n + r) * 8);
                cin = (w == wave) ? c : cin; c = ag.x * c + ag.y; iH = ag.x * iH + ag.y; iP *= ag.x; }
            carry[n] = c;
            if (nsplit > 1 && wave == 0) {
                if (hh == 0) __hip_atomic_store(aggg + (size_t)seg * 64 + n * 32 + r, ((unsigned long long)__float_as_uint(iH) << 32) | __float_as_uint(iP), __ATOMIC_RELAXED, __HIP_MEMORY_SCOPE_AGENT);
                asm volatile("s_waitcnt vmcnt(0)" ::: "memory");
                if (lane == 0) __hip_atomic_store(flags + seg * 2 + n, 1u, __ATOMIC_RELAXED, __HIP_MEMORY_SCOPE_AGENT);
            }
#pragma unroll
            for (int j = 0; j < 16; ++j) { const int row = (j & 3) + 8 * (j >> 2) + 4 * hh;
                *(LAS float*)(wt + row * 272 + (32 * n + r) * 4) = hl[j] + pc[j] * cin; }
        }
        asm volatile("s_waitcnt lgkmcnt(0)" ::: "memory");
#pragma unroll
        for (int i = 0; i < 4; ++i) {
            const int tok = (lane >> 3) + 8 * i, c = lane & 7;
            const f32x4 h0 = *(LAS const f32x4*)(wt + tok * 272 + c * 32), h1 = *(LAS const f32x4*)(wt + tok * 272 + c * 32 + 16);
            const f32x4 g0 = *(LAS const f32x4*)(cw + 512 + c * 8), g1 = *(LAS const f32x4*)(cw + 512 + c * 8 + 4);
            float ss = (h0[0] * h0[0] + h0[1] * h0[1]) + (h0[2] * h0[2] + h0[3] * h0[3]) + (h1[0] * h1[0] + h1[1] * h1[1]) + (h1[2] * h1[2] + h1[3] * h1[3]);
            ss = DPP_ADD(ss, 0xB1); ss = DPP_ADD(ss, 0x4E); ss = DPP_ADD(ss, 0x141);
            const float rstd = __builtin_amdgcn_rsqf(ss * (1.f / 64.f) + RMS_EPS);
            float fg[8]; unpack8(gl[i], fg);
            float o[8];
            o[0] = h0[0] * rstd * g0[0]; o[1] = h0[1] * rstd * g0[1]; o[2] = h0[2] * rstd * g0[2]; o[3] = h0[3] * rstd * g0[3];
            o[4] = h1[0] * rstd * g1[0]; o[5] = h1[1] * rstd * g1[1]; o[6] = h1[2] * rstd * g1[2]; o[7] = h1[3] * rstd * g1[3];
#pragma unroll
            for (int j = 0; j < 8; ++j) o[j] *= fg[j] * sigmoid_fast(fg[j]);
            u32x4 w; w.x = cvt_pk_bf16(o[0], o[1]); w.y = cvt_pk_bf16(o[2], o[3]); w.z = cvt_pk_bf16(o[4], o[5]); w.w = cvt_pk_bf16(o[6], o[7]);
            *(u32x4*)(obase + (size_t)(b * SEQ + s0 + tok) * ostride + h * 64 + c * 8) = w;
        }
        asm volatile("s_waitcnt lgkmcnt(0)" ::: "memory");
    }
#undef LOAD_X
    __syncthreads();
}

__global__ void __launch_bounds__(NTHREADS, 2) hymba_fwd(Args a) {
    extern __shared__ __attribute__((aligned(16))) unsigned char lds_raw[];
    LAS unsigned char* lds = (LAS unsigned char*)lds_raw;
    cg::grid_group grid = cg::this_grid();
    if (gridDim.y == 0x7fffu) grid.sync();
    volatile LAS unsigned* bst = (volatile LAS unsigned*)(lds + LDS_CTL + 64);
    if (threadIdx.x == 0) { bst[0] = 0u; bst[1] = 0u; }
    __syncthreads();
    const XcdBarrier bar = xcd_barrier_post((unsigned*)(a.ws + WS_CTL + 32768), bst);
    const int tid = threadIdx.x, lane = tid & 63, wave = __builtin_amdgcn_readfirstlane(tid >> 6);
    bf16_t* proj = (bf16_t*)(a.ws + WS_PROJ); bf16_t* projg = (bf16_t*)(a.ws + WS_PROJG);

#pragma unroll
    for (int rep = 0; rep < REP0; ++rep) {
#ifndef SKIP_P0
    phase0(a, lds, wave, lane);
#endif

    xcd_barrier(bar); }
#pragma unroll
    for (int rep = 0; rep < REP1; ++rep) {
        pg8::Gemm g{(const bf16_t*)(a.ws + WS_XN), (const bf16_t*)(a.ws + WS_WIN), T_TOK, NPROJ, DM, DM, SKEW1};
        pg8::StaticOrder S; S.init(T_TOK, NPROJ, (int)gridDim.x, (int)blockIdx.x);
        pg8::EpiBf16 E{proj, LDPA, projg, LDPG, lds + LDS_EST + wave * 2048};
#ifndef SKIP_G1
        pg8::gemm_phase<pg8::EpiBf16>(lds, g, S, E);
#endif
    xcd_barrier(bar); }
    {
#ifndef SKIP_LRU
        if (gridDim.x >= 256) { if (blockIdx.x < 256) lru_item(a, proj, projg, projg + 1024, LDPG, lds, (int)blockIdx.x >> 1, (int)blockIdx.x & 1, 2, tid, wave, lane); }
        else for (int it = blockIdx.x; it < 128; it += gridDim.x) lru_item(a, proj, projg, projg + 1024, LDPG, lds, it, 0, 1, tid, wave, lane);
#endif
        LAS unsigned* qs = (LAS unsigned*)(lds + LDS_CTL);
        unsigned* qctr = (unsigned*)(a.ws + WS_CTL);
        for (;;) {
            if (tid == 0) qs[0] = atomicAdd(qctr, 1u);
            __syncthreads();
            const unsigned it = qs[0];
            __syncthreads();
            if (it >= (unsigned)(T_TOK / (4 * CONV_R))) break;
#ifndef SKIP_CONV
            conv_item(a, proj, projg, projg, LDPG, (int)it, wave, lane);
#endif
        }
    }
    xcd_barrier(bar);
#pragma unroll
    for (int rep = 0; rep < REP3; ++rep) {
        pg8::Gemm g{projg, (const bf16_t*)(a.ws + WS_WOUT), T_TOK, DM, DMIX, LDPG, SKEW3};
        pg8::StaticOrder S; S.init(T_TOK, DM, (int)gridDim.x, (int)blockIdx.x);
        pg8::EpiResidNorm E{a.in[I_X], a.out, (unsigned*)(a.ws + WS_SS), (unsigned*)(a.ws + WS_CTL + 65536), a.in[I_FG], lds + LDS_EST + wave * 2048};
#ifndef SKIP_G2
        pg8::gemm_phase<pg8::EpiResidNorm>(lds, g, S, E);
#endif
    }
}

extern "C" void kernel_launch(void* const* d_in, const int* in_sizes, int n_in, void* d_out, int out_size, void* d_ws, size_t ws_size, hipStream_t stream) {
    static int grid = 0;
    if (grid == 0) {
        if (n_in != 15 || out_size != T_TOK * DM || ws_size < WS_END) { fprintf(stderr, "kernel_launch: unexpected shapes (n_in %d out %d ws %zu)\n", n_in, out_size, ws_size); grid = -1; return; }
        int dev = 0, cus = 0, per_cu = 0;
        hipGetDevice(&dev);
        hipDeviceGetAttribute(&cus, hipDeviceAttributeMultiprocessorCount, dev);
        if (hipFuncSetAttribute((const void*)hymba_fwd, hipFuncAttributeMaxDynamicSharedMemorySize, LDS_BYTES) != hipSuccess) { fprintf(stderr, "kernel_launch: hipFuncSetAttribute failed\n"); grid = -1; return; }
        if (hipOccupancyMaxActiveBlocksPerMultiprocessor(&per_cu, (const void*)hymba_fwd, NTHREADS, LDS_BYTES) != hipSuccess || per_cu < 1) { fprintf(stderr, "kernel_launch: occupancy query says %d\n", per_cu); per_cu = 1; }
        (void)hipGetLastError();
        grid = cus;
        if (grid != 256) { fprintf(stderr, "kernel_launch: built for a 256-CU device (got %d)\n", cus); grid = -1; return; }
    }
    if (grid < 0) return;
    hipMemsetAsync((char*)d_ws + WS_CTL, 0, CTL_BYTES, stream);
    Args a{};
    for (int i = 0; i < 15; ++i) a.in[i] = (const float*)d_in[i];
    a.out = (float*)d_out; a.ws = (unsigned char*)d_ws;
    void* args[] = {&a};
    hipError_t e = hipLaunchCooperativeKernel((const void*)hymba_fwd, dim3(grid), dim3(NTHREADS), args, LDS_BYTES, stream);
    if (e != hipSuccess) fprintf(stderr, "kernel_launch: cooperative launch failed: %s (grid %d)\n", hipGetErrorString(e), grid);
}
```

```cpp
#include <hip/hip_runtime.h>
#include <hip/hip_cooperative_groups.h>
#include <cstdio>
namespace cg = cooperative_groups;

#define LAS __attribute__((address_space(3)))
typedef unsigned short bf16_t;
typedef short bf16x8 __attribute__((ext_vector_type(8)));
typedef float f32x4 __attribute__((ext_vector_type(4)));
typedef float f32x16 __attribute__((ext_vector_type(16)));
typedef unsigned u32x4 __attribute__((ext_vector_type(4)));
typedef unsigned u32x2 __attribute__((ext_vector_type(2)));

constexpr int T_TOK = 32768, SEQ = 4096, DM = 1024, NPROJ = 6144, DMIX = 2048;
constexpr float RMS_EPS = 1e-6f;
constexpr int COL_B = 0, COL_CX = 1024, COL_XL = 2048;
constexpr size_t MiB = 1u << 20;
constexpr size_t WS_CTL = 0, CTL_BYTES = 131072;
constexpr size_t WS_WIN = 2 * MiB;
constexpr size_t WS_WOUT = 14 * MiB;
constexpr size_t WS_WG = 18 * MiB;
constexpr size_t WS_SS = 20 * MiB;
constexpr size_t WS_AGG = 22 * MiB;
constexpr size_t WS_XN = 32 * MiB;
constexpr size_t WS_PROJ = 96 * MiB;
constexpr int LDPA = 3072, LDPG = 2048;
constexpr size_t WS_PROJG = WS_PROJ + (size_t)T_TOK * LDPA * 2;
constexpr size_t WS_END = WS_PROJG + (size_t)T_TOK * LDPG * 2;
static_assert(WS_END <= 480 * MiB, "ws");
constexpr int LDS_BYTES = 148480;
constexpr int LDS_EST = 131072, LDS_CTL = 147456;
constexpr int NTHREADS = 512;
#ifndef REP0
#define REP0 1
#endif
#ifndef REP1
#define REP1 1
#endif
#ifndef REP3
#define REP3 1
#endif
#ifndef CONV_R
#define CONV_R 8
#endif
#ifndef PG8_SP2
#define PG8_SP2 1
#endif
#ifndef PG8_ALIGN
#define PG8_ALIGN 1
#endif
#ifndef SKEW1
#define SKEW1 0
#endif
#ifndef SKEW3
#define SKEW3 0
#endif
#ifndef GL_EARLY
#define GL_EARLY 1
#endif
#ifndef REPLRU
#define REPLRU 1
#endif
#ifndef REPCONV
#define REPCONV 1
#endif

struct Args { const float* in[15]; float* out; unsigned char* ws; };
enum { I_X = 0, I_LNG, I_WIN, I_CONVW, I_LCW, I_LCB, I_WA, I_BA, I_WI, I_BI, I_LAM, I_CG, I_LG, I_WOUT, I_FG };

__device__ __forceinline__ unsigned cvt_pk_bf16(float lo, float hi) { unsigned r; asm volatile("v_cvt_pk_bf16_f32 %0, %1, %2" : "=v"(r) : "v"(lo), "v"(hi)); return r; }
__device__ __forceinline__ float bf_lo(unsigned w) { return __uint_as_float(w << 16); }
__device__ __forceinline__ float bf_hi(unsigned w) { return __uint_as_float(w & 0xffff0000u); }
__device__ __forceinline__ float wave_sum(float v) {
#pragma unroll
    for (int o = 1; o < 64; o <<= 1) v += __shfl_xor(v, o);
    return v;
}
__device__ __forceinline__ float sigmoid_fast(float x) { return __builtin_amdgcn_rcpf(1.0f + __builtin_amdgcn_exp2f(-1.44269504f * x)); }
__device__ __forceinline__ void unpack8(const u32x4 v, float (&f)[8]) {
    f[0] = bf_lo(v.x); f[1] = bf_hi(v.x); f[2] = bf_lo(v.y); f[3] = bf_hi(v.y); f[4] = bf_lo(v.z); f[5] = bf_hi(v.z); f[6] = bf_lo(v.w); f[7] = bf_hi(v.w);
}


#define XB_TMO      128
#define XB_XCNT(j)  (256  + 64 * (j))
#define XB_XSUB(j)  (1280 + 64 * (j))
#define XB_XGEN(j)  (2304 + 64 * (j))
#define XB_TOP      3328
#define XB_TOPGEN   3392
#define XCD_BAR_WORDS 3456
#define XB_SPIN_CAP (1u << 20)
__device__ __forceinline__ unsigned xb_ld(unsigned* p)              { return __hip_atomic_load(p, __ATOMIC_RELAXED, __HIP_MEMORY_SCOPE_AGENT); }
__device__ __forceinline__ unsigned xb_add(unsigned* p, unsigned v) { return __hip_atomic_fetch_add(p, v, __ATOMIC_RELAXED, __HIP_MEMORY_SCOPE_AGENT); }
__device__ __forceinline__ unsigned xb_xcc_id() { return (unsigned)__builtin_amdgcn_s_getreg((3 << 11) | 20) & 0xFu; }
#define XB_SPIN(cond, bar) do { unsigned _sp = 0; while (cond) { __builtin_amdgcn_s_sleep(1); \
    if ((++_sp & 255u) == 0u) { if (xb_ld(&(bar)[XB_TMO])) break; if (_sp > XB_SPIN_CAP) { atomicAdd(&(bar)[XB_TMO], 1u); break; } } } } while (0)
struct XcdBarrier { unsigned* bar; unsigned x; volatile LAS unsigned* st; };
__device__ __forceinline__ XcdBarrier xcd_barrier_post(unsigned* bar, volatile LAS unsigned* st) {
    XcdBarrier b; b.bar = bar; b.x = xb_xcc_id(); b.st = st;
    if (threadIdx.x == 0) (void)xb_add(&bar[XB_XCNT(b.x)], 1u);
    return b;
}
__device__ __forceinline__ void xcd_barrier_complete(unsigned* bar, unsigned x, unsigned& nloc, unsigned& nx) {
    const unsigned G = gridDim.x * gridDim.y * gridDim.z;
    unsigned sum, cnt, mine, sp = 0u;
    for (;;) {
        sum = 0u; cnt = 0u; mine = 0u;
#pragma unroll
        for (unsigned j = 0; j < 16; ++j) { const unsigned c = xb_ld(&bar[XB_XCNT(j)]); sum += c; cnt += (c > 0u) ? 1u : 0u; mine = (j == x) ? c : mine; }
        if (sum == G) break;
        __builtin_amdgcn_s_sleep(1);
        if ((++sp & 255u) == 0u) { if (xb_ld(&bar[XB_TMO])) break; if (sp > XB_SPIN_CAP) { atomicAdd(&bar[XB_TMO], 1u); break; } }
    }
    nloc = mine > 0u ? mine : 1u; nx = cnt > 0u ? cnt : 1u;
}
__device__ __forceinline__ void xcd_barrier(const XcdBarrier& b) {
    asm volatile("s_waitcnt vmcnt(0)" ::: "memory");
    __syncthreads();
    if (threadIdx.x == 0) {
        unsigned* bar = b.bar;
        __builtin_amdgcn_s_waitcnt(0);
        unsigned nloc = b.st[0], nx = b.st[1];
        if (nloc == 0u) { xcd_barrier_complete(bar, b.x, nloc, nx); b.st[0] = nloc; b.st[1] = nx; }
        const unsigned old = xb_add(&bar[XB_XSUB(b.x)], 1u);
        const unsigned gen = old / nloc;
        if (old + 1u == (gen + 1u) * nloc) {
            __builtin_amdgcn_fence(__ATOMIC_RELEASE, "agent");
            asm volatile("s_waitcnt vmcnt(0)" ::: "memory");
            const unsigned og = xb_add(&bar[XB_TOP], 1u);
            const unsigned tg = og / nx;
            if (og + 1u == (tg + 1u) * nx) xb_add(&bar[XB_TOPGEN], 1u);
            else XB_SPIN(xb_ld(&bar[XB_TOPGEN]) == tg, bar);
            __builtin_amdgcn_fence(__ATOMIC_ACQUIRE, "agent");
            xb_add(&bar[XB_XGEN(b.x)], 1u);
            asm volatile("s_waitcnt vmcnt(0)" ::: "memory");
        } else {
            XB_SPIN(xb_ld(&bar[XB_XGEN(b.x)]) == gen, bar);
            __builtin_amdgcn_fence(__ATOMIC_ACQUIRE, "agent");
            asm volatile("s_waitcnt vmcnt(0)" ::: "memory");
        }
    }
    __syncthreads();
}

namespace pg8 {
constexpr int BM = 256, BK = 64, HALF = 128, HTB = HALF * BK * 2, STAGE_BYTES = 8 * HTB, NXCD = 8, WGM = 8;
__host__ __device__ __forceinline__ int lds_byte(int r, int c) { const int st = (r >> 4) * 2 + (c >> 5), rr = r & 15, cc = c & 31, ob = rr * 64 + cc * 2; return st * 1024 + (ob ^ (((ob >> 9) & 1) << 5)); }
__host__ __device__ __forceinline__ void stage_rc(int b, int& R, int& C) { const int st = b / 1024, sb = b % 1024, swz = sb ^ (((sb >> 9) & 1) << 5); R = (st >> 1) * 16 + swz / 64; C = (st & 1) * 32 + (swz % 64) / 2; }
__host__ __device__ __forceinline__ int perm32(int rho) { const int n = rho >> 4, i = rho & 15; return 8 * (i >> 2) + 4 * n + (i & 3); }

struct Unit { int pm, pn; };
struct Gemm { const bf16_t* A; const bf16_t* Bt; int M, N, K, lda; int skew; };

struct StaticOrder {
    int nM, nN, nwg, G, c;
    __device__ void init(int M, int N, int G_, int c_) { nM = M / BM; nN = N / BM; nwg = nM * nN; G = G_; c = c_; }
    __device__ bool next(int i, Unit& u) const {
        const long L = (long)i * G + c; if (L >= nwg) return false;
        int wgid = (int)L; { const int q = nwg / NXCD, r = nwg % NXCD, xcd = wgid % NXCD, off = wgid / NXCD; wgid = (xcd < r ? xcd * (q + 1) : r * (q + 1) + (xcd - r) * q) + off; }
        const int nig = WGM * nN, gid = wgid / nig, fm = gid * WGM, gsz = (nM - fm) < WGM ? (nM - fm) : WGM;
        u.pm = fm + ((wgid % nig) % gsz); u.pn = (wgid % nig) / gsz; return true;
    }
};

struct EpiBf16 {
    static constexpr bool PERM = true;
    bf16_t* O; int ldc; bf16_t* O2; int ldc2;
    __device__ __forceinline__ void init(f32x4 (&acc)[2][2][4][2], const Unit&, int, int, int, int) const {
#pragma unroll
        for (int a = 0; a < 2; ++a)
#pragma unroll
            for (int b = 0; b < 2; ++b)
#pragma unroll
                for (int m = 0; m < 4; ++m)
#pragma unroll
                    for (int n = 0; n < 2; ++n) acc[a][b][m][n] = (f32x4){0.f, 0.f, 0.f, 0.f};
    }
    LAS unsigned char* est;
    __device__ __forceinline__ void operator()(f32x4 (&acc)[2][2][4][2], const Unit& u, int wr, int wc, int fr, int fq) const {
        const int lane = fq * 16 + fr; const int pn = u.pn;
        const int rbase = u.pm * BM + wr * 64;
        if (pn >= 4 && pn < 12) {
            const int rrow = lane >> 2, rch = lane & 3;
            bf16_t* gp = O + (size_t)(rbase + rrow) * ldc + 1024 + 128 * (pn - 4) + 32 * wc + rch * 8;
#pragma unroll
            for (int ai = 0; ai < 2; ++ai)
#pragma unroll
                for (int m = 0; m < 4; ++m) {
#pragma unroll
                    for (int bj = 0; bj < 2; ++bj) { const f32x4 p = acc[ai][bj][m][0] * acc[ai][bj][m][1];
                        u32x2 w; w.x = cvt_pk_bf16(p[0], p[1]); w.y = cvt_pk_bf16(p[2], p[3]);
                        const int chunk = 2 * bj + (fq >> 1);
                        *(LAS u32x2*)(est + fr * 64 + ((chunk ^ ((fr >> 1) & 3)) * 16) + (fq & 1) * 8) = w; }
                    const u32x4 v = *(LAS const u32x4*)(est + rrow * 64 + ((rch ^ ((rrow >> 1) & 3)) * 16));
                    *(u32x4*)(gp + (size_t)(ai * HALF + m * 16) * ldc) = v; }
        } else {
            const bool second = pn >= 16;
            const int colt = (second ? (pn - 16) * BM : (pn >= 12 ? 2048 + (pn - 12) * BM : pn * BM)) + wc * 64;
            bf16_t* Ob = second ? O2 : O; const int ld = second ? ldc2 : ldc;
            const int rrow = lane >> 3, rch = lane & 7;
            bf16_t* gp = Ob + (size_t)(rbase + rrow) * ld + colt + rch * 8;
#pragma unroll
            for (int ai = 0; ai < 2; ++ai)
#pragma unroll
                for (int m = 0; m < 4; ++m) {
#pragma unroll
                    for (int bj = 0; bj < 2; ++bj) { f32x4 v0 = acc[ai][bj][m][0], v1 = acc[ai][bj][m][1];
                        u32x4 w; w.x = cvt_pk_bf16(v0[0], v0[1]); w.y = cvt_pk_bf16(v0[2], v0[3]); w.z = cvt_pk_bf16(v1[0], v1[1]); w.w = cvt_pk_bf16(v1[2], v1[3]);
                        *(LAS u32x4*)(est + fr * 128 + (((4 * bj + fq) ^ (fr & 7)) * 16)) = w; }
#pragma unroll
                    for (int p = 0; p < 2; ++p) { const int row = p * 8 + rrow;
                        const u32x4 v = *(LAS const u32x4*)(est + row * 128 + ((rch ^ (row & 7)) * 16));
                        *(u32x4*)(gp + (size_t)(ai * HALF + m * 16 + p * 8) * ld) = v; } }
        }
    }
};
struct EpiResidNorm {
    static constexpr bool PERM = false;
    const float* x; float* out; unsigned* ss; unsigned* cnt; const float* fg; LAS unsigned char* est;
    __device__ __forceinline__ void init(f32x4 (&acc)[2][2][4][2], const Unit& u, int wr, int wc, int fr, int fq) const {
        const int row0 = u.pm * BM + wr * 64 + fr, col0 = u.pn * BM + wc * 32 + 4 * fq;
#pragma unroll
        for (int ai = 0; ai < 2; ++ai)
#pragma unroll
            for (int m = 0; m < 4; ++m) { const size_t off = (size_t)(row0 + ai * HALF + m * 16) * DM + col0;
#pragma unroll
                for (int bj = 0; bj < 2; ++bj)
#pragma unroll
                    for (int n = 0; n < 2; ++n) acc[ai][bj][m][n] = __builtin_nontemporal_load((const f32x4*)(x + off + bj * HALF + n * 16)); }
    }
    __device__ __forceinline__ void operator()(f32x4 (&acc)[2][2][4][2], const Unit& u, int wr, int wc, int fr, int fq) const {
        const int row0 = u.pm * BM + wr * 64 + fr, col0 = u.pn * BM + wc * 32 + 4 * fq;
#pragma unroll
        for (int ai = 0; ai < 2; ++ai)
#pragma unroll
            for (int m = 0; m < 4; ++m) { const int row = row0 + ai * HALF + m * 16; const size_t off = (size_t)row * DM + col0; float s = 0.f;
#pragma unroll
                for (int bj = 0; bj < 2; ++bj)
#pragma unroll
                    for (int n = 0; n < 2; ++n) { const f32x4 o = acc[ai][bj][m][n]; s += (o[0] * o[0] + o[1] * o[1]) + (o[2] * o[2] + o[3] * o[3]); }
                s += __shfl_xor(s, 16); s += __shfl_xor(s, 32);
                if (fq == 0) __hip_atomic_store(ss + (size_t)row * 16 + u.pn * 4 + wc, __float_as_uint(s), __ATOMIC_RELAXED, __HIP_MEMORY_SCOPE_AGENT); }
        asm volatile("s_waitcnt vmcnt(0)" ::: "memory");
        unsigned* c = cnt + (u.pm * 2 + wr) * 32;
        if ((threadIdx.x & 63) == 0) __hip_atomic_fetch_add(c, 1u, __ATOMIC_RELAXED, __HIP_MEMORY_SCOPE_AGENT);
        { unsigned spins = 0;
          while ((unsigned)__builtin_amdgcn_readfirstlane(__hip_atomic_load(c, __ATOMIC_RELAXED, __HIP_MEMORY_SCOPE_AGENT)) < 16u) { __builtin_amdgcn_s_sleep(2); if (++spins > (1u << 22)) break; } }
        asm volatile("" ::: "memory");
#pragma unroll
        for (int ai = 0; ai < 2; ++ai)
#pragma unroll
            for (int m = 0; m < 4; ++m) { const int row = row0 + ai * HALF + m * 16; const size_t off = (size_t)row * DM + col0;
                const unsigned long long* sp = (const unsigned long long*)(ss + (size_t)row * 16 + fq * 4);
                const unsigned long long p0 = __hip_atomic_load(sp, __ATOMIC_RELAXED, __HIP_MEMORY_SCOPE_AGENT), p1 = __hip_atomic_load(sp + 1, __ATOMIC_RELAXED, __HIP_MEMORY_SCOPE_AGENT);
                float t = (__uint_as_float((unsigned)p0) + __uint_as_float((unsigned)(p0 >> 32))) + (__uint_as_float((unsigned)p1) + __uint_as_float((unsigned)(p1 >> 32)));
                t += __shfl_xor(t, 16); t += __shfl_xor(t, 32);
                const float rstd = 1.0f / sqrtf(t * (1.f / DM) + RMS_EPS);
                const int lane_ = fq * 16 + fr, rrow = lane_ >> 3, rch = lane_ & 7;
#pragma unroll
                for (int bj = 0; bj < 2; ++bj) {
#pragma unroll
                    for (int n = 0; n < 2; ++n) { const f32x4 gv = *(const f32x4*)(fg + col0 + bj * HALF + n * 16);
                        *(LAS f32x4*)(est + fr * 128 + (((4 * n + fq) ^ (fr & 7)) * 16)) = acc[ai][bj][m][n] * rstd * gv; }
#pragma unroll
                    for (int p = 0; p < 2; ++p) { const int rl = p * 8 + rrow;
                        const f32x4 v = *(LAS const f32x4*)(est + rl * 128 + ((rch ^ (rl & 7)) * 16));
                        *(f32x4*)(out + (size_t)(u.pm * BM + wr * 64 + ai * HALF + m * 16 + rl) * DM + u.pn * BM + bj * HALF + wc * 32 + rch * 4) = v; } } }
    }
};

template <class Epi>
__device__ __forceinline__ void gemm_phase(LAS unsigned char* lds, const Gemm g, const StaticOrder& S, const Epi& E) {
    const int tid = threadIdx.x, wid = __builtin_amdgcn_readfirstlane(tid >> 6), lane = tid & 63, wr = wid >> 2, wc = wid & 3, fr = lane & 15, fq = lane >> 4;
    const int K = g.K, nt = K / BK, lda = g.lda;
    unsigned voffA[2], voffB[2];
#pragma unroll
    for (int i = 0; i < 2; ++i) { int R, C; stage_rc(tid * 16 + i * 8192, R, C); const int Rb = Epi::PERM ? ((R & ~31) + perm32(R & 31)) : R;
        voffA[i] = (unsigned)(R * lda + C) * 2u; voffB[i] = (unsigned)(Rb * K + C) * 2u; }
    const size_t kstep = (size_t)(BK * 2);
    const size_t hstepA = (size_t)HALF * lda * 2, hstepB = (size_t)HALF * K * 2;
    const size_t tstepA = 2 * hstepA, tstepB = 2 * hstepB;
    const unsigned ldsw = (unsigned)wid * 1024u;
    const int aoff = lds_byte(wr * 64 + fr, fq * 8), boff = lds_byte(wc * 32 + fr, fq * 8);
#define PG8_SA(b, h) (((b) * 2 + (h)) * HTB)
#define PG8_SB(b, h) ((4 + (b) * 2 + (h)) * HTB)
#define PG8_STAGE(bufoff, gbase, voff) do { _Pragma("unroll") for (int _i = 0; _i < 2; ++_i) \
        __builtin_amdgcn_global_load_lds((const unsigned*)((const char*)(gbase) + (voff)[_i]), (LAS unsigned*)(lds + (bufoff) + ldsw + _i * 8192), 16, 0, 0); } while (0)
#define PG8_LDA(dst, b, h) do { _Pragma("unroll") for (int m = 0; m < 4; ++m) _Pragma("unroll") for (int k = 0; k < 2; ++k) dst[m][k] = *(const LAS bf16x8*)(lds + PG8_SA(b, h) + aoff + m * 2048 + k * 1024); } while (0)
#define PG8_LDB(dst, b, h) do { _Pragma("unroll") for (int n = 0; n < 2; ++n) _Pragma("unroll") for (int k = 0; k < 2; ++k) dst[n][k] = *(const LAS bf16x8*)(lds + PG8_SB(b, h) + boff + n * 2048 + k * 1024); } while (0)
#define PG8_MMA(ai, bj, At, Bt) do { __builtin_amdgcn_s_setprio(1); _Pragma("unroll") for (int m = 0; m < 4; ++m) _Pragma("unroll") for (int n = 0; n < 2; ++n) _Pragma("unroll") for (int k = 0; k < 2; ++k) \
        acc[ai][bj][m][n] = __builtin_amdgcn_mfma_f32_16x16x32_bf16(Bt[n][k], At[m][k], acc[ai][bj][m][n], 0, 0, 0); __builtin_amdgcn_s_setprio(0); } while (0)
#define PG8_WAIT_V(n) asm volatile("s_waitcnt vmcnt(" #n ")" ::: "memory")
#define PG8_WAIT_L(n) asm volatile("s_waitcnt lgkmcnt(" #n ")" ::: "memory")
#define PG8_BAR __builtin_amdgcn_s_barrier()
#define PG8_SCHED __builtin_amdgcn_sched_barrier(0)
    Unit cur, nxt; int ui = 0;
    if (!S.next(0, cur)) return;
    if (g.skew > 0) { const unsigned long long t0 = __builtin_amdgcn_s_memrealtime(), dt = (unsigned long long)((blockIdx.x & 7u) * (unsigned)g.skew);
        while (__builtin_amdgcn_s_memrealtime() - t0 < dt) __builtin_amdgcn_s_sleep(8); }
    f32x4 acc[2][2][4][2];
    E.init(acc, cur, wr, wc, fr, fq);
    bf16x8 At[4][2], B0[2][2], B1[2][2];
    const char* cA = (const char*)g.A + (size_t)cur.pm * tstepA; const char* cB = (const char*)g.Bt + (size_t)cur.pn * tstepB;
#if PG8_SP2
    PG8_STAGE(PG8_SB(0, 0), cB, voffB); PG8_STAGE(PG8_SB(0, 1), cB + hstepB, voffB); PG8_STAGE(PG8_SA(0, 0), cA, voffA); PG8_STAGE(PG8_SA(0, 1), cA + hstepA, voffA);
    if (wr == 1) PG8_BAR;
    PG8_WAIT_V(2); PG8_BAR;
    PG8_STAGE(PG8_SB(1, 0), cB + kstep, voffB); PG8_STAGE(PG8_SA(1, 0), cA + kstep, voffA); PG8_STAGE(PG8_SB(1, 1), cB + hstepB + kstep, voffB);
    PG8_WAIT_V(6); PG8_BAR;
#else
    PG8_STAGE(PG8_SB(0, 0), cB, voffB); PG8_STAGE(PG8_SA(0, 0), cA, voffA); PG8_STAGE(PG8_SB(0, 1), cB + hstepB, voffB); PG8_STAGE(PG8_SA(0, 1), cA + hstepA, voffA);
    if (wr == 1) PG8_BAR;
    PG8_WAIT_V(4); PG8_BAR;
    PG8_STAGE(PG8_SB(1, 0), cB + kstep, voffB); PG8_STAGE(PG8_SA(1, 0), cA + kstep, voffA); PG8_STAGE(PG8_SB(1, 1), cB + hstepB + kstep, voffB);
    PG8_WAIT_V(6); PG8_BAR;
#endif
    for (;;) {
        const bool has_next = S.next(ui + 1, nxt);
        const char* nA = has_next ? (const char*)g.A + (size_t)nxt.pm * tstepA : cA; const char* nB = has_next ? (const char*)g.Bt + (size_t)nxt.pn * tstepB : cB;
        for (int t = 0; t < nt; t += 2) {
            const bool last = (t == nt - 2);
            const char* a1 = cA + (size_t)(t + 1) * kstep;
            const char* a2 = last ? nA : cA + (size_t)(t + 2) * kstep; const char* b2 = last ? nB : cB + (size_t)(t + 2) * kstep;
            const char* a3 = a2 + kstep; const char* b3 = b2 + kstep;
#if PG8_SP2
            PG8_LDB(B0, 0, 0); PG8_LDB(B1, 0, 1); PG8_SCHED; PG8_LDA(At, 0, 0); PG8_STAGE(PG8_SA(1, 1), a1 + hstepA, voffA);
            PG8_WAIT_V(8); PG8_WAIT_L(0); PG8_BAR; PG8_MMA(0, 0, At, B0); PG8_MMA(0, 1, At, B1); PG8_BAR; PG8_SCHED;
            PG8_LDA(At, 0, 1); PG8_STAGE(PG8_SB(0, 0), b2, voffB); PG8_STAGE(PG8_SB(0, 1), b2 + hstepB, voffB); PG8_STAGE(PG8_SA(0, 0), a2, voffA);
            PG8_WAIT_V(8); PG8_WAIT_L(0); PG8_BAR; PG8_MMA(1, 0, At, B0); PG8_MMA(1, 1, At, B1); PG8_BAR; PG8_SCHED;
            PG8_LDB(B0, 1, 0); PG8_LDB(B1, 1, 1); PG8_SCHED; PG8_LDA(At, 1, 0); PG8_STAGE(PG8_SA(0, 1), a2 + hstepA, voffA);
            PG8_WAIT_V(8); PG8_WAIT_L(0); PG8_BAR; PG8_MMA(0, 0, At, B0); PG8_MMA(0, 1, At, B1); PG8_BAR; PG8_SCHED;
            PG8_LDA(At, 1, 1); PG8_STAGE(PG8_SB(1, 0), b3, voffB); PG8_STAGE(PG8_SB(1, 1), b3 + hstepB, voffB); PG8_STAGE(PG8_SA(1, 0), a3, voffA);
            PG8_WAIT_V(8); PG8_WAIT_L(0); PG8_BAR; PG8_MMA(1, 0, At, B0); PG8_MMA(1, 1, At, B1); PG8_BAR; PG8_SCHED;
#else
            PG8_LDB(B0, 0, 0); PG8_SCHED; PG8_LDA(At, 0, 0); PG8_STAGE(PG8_SA(1, 1), a1 + hstepA, voffA);
            PG8_WAIT_L(8); PG8_BAR; PG8_WAIT_L(0); PG8_MMA(0, 0, At, B0); PG8_BAR; PG8_SCHED;
            PG8_LDB(B1, 0, 1); PG8_STAGE(PG8_SB(0, 0), b2, voffB);
            PG8_BAR; PG8_WAIT_L(0); PG8_MMA(0, 1, At, B1); PG8_BAR;
            PG8_LDA(At, 0, 1); PG8_STAGE(PG8_SA(0, 0), a2, voffA);
            PG8_BAR; PG8_WAIT_L(0); PG8_MMA(1, 0, At, B0); PG8_BAR; PG8_SCHED;
            PG8_STAGE(PG8_SB(0, 1), b2 + hstepB, voffB);
            PG8_WAIT_V(6); PG8_BAR; PG8_MMA(1, 1, At, B1); PG8_BAR;
            PG8_LDB(B0, 1, 0); PG8_SCHED; PG8_LDA(At, 1, 0); PG8_STAGE(PG8_SA(0, 1), a2 + hstepA, voffA);
            PG8_WAIT_L(8); PG8_BAR; PG8_WAIT_L(0); PG8_MMA(0, 0, At, B0); PG8_BAR; PG8_SCHED;
            PG8_LDB(B1, 1, 1); PG8_STAGE(PG8_SB(1, 0), b3, voffB);
            PG8_BAR; PG8_WAIT_L(0); PG8_MMA(0, 1, At, B1); PG8_BAR;
            PG8_LDA(At, 1, 1); PG8_STAGE(PG8_SA(1, 0), a3, voffA);
            PG8_BAR; PG8_WAIT_L(0); PG8_MMA(1, 0, At, B0); PG8_BAR; PG8_SCHED;
            PG8_STAGE(PG8_SB(1, 1), b3 + hstepB, voffB);
            PG8_WAIT_V(6); PG8_BAR; PG8_MMA(1, 1, At, B1); PG8_BAR;
#endif
        }
#if PG8_ALIGN
        if (wr == 0) PG8_BAR;
#endif
        E(acc, cur, wr, wc, fr, fq);
        if (!has_next) break;
        cur = nxt; cA = nA; cB = nB; ++ui;
        E.init(acc, cur, wr, wc, fr, fq);
#if PG8_ALIGN
        if (wr == 1) PG8_BAR;
#endif
    }
    PG8_WAIT_V(0);
#if !PG8_ALIGN
    if (wr == 0) PG8_BAR;
#endif
    PG8_BAR;
#undef PG8_SA
#undef PG8_SB
#undef PG8_STAGE
#undef PG8_LDA
#undef PG8_LDB
#undef PG8_MMA
#undef PG8_WAIT_V
#undef PG8_WAIT_L
#undef PG8_BAR
#undef PG8_SCHED
}
}

__device__ __forceinline__ void p0_transpose_item(const float* W, int ldw, int k0, int ncol0, bf16_t* WT, int ldt, int drow0, int dk0, LAS float* scr, int lane, int mode = 0) {
#pragma unroll 8
    for (int i = 0; i < 32; ++i) { const int kk = 2 * i + (lane >> 5); scr[kk * 33 + (lane & 31)] = __builtin_nontemporal_load(W + (size_t)(k0 + kk) * ldw + ncol0 + (lane & 31)); }
    asm volatile("s_waitcnt lgkmcnt(0)" ::: "memory");
    const int c = lane & 7;
#pragma unroll
    for (int j = 0; j < 4; ++j) { const int n = (lane >> 3) + 8 * j; const LAS float* s = scr + (8 * c) * 33 + n;
        u32x4 o; o.x = cvt_pk_bf16(s[0 * 33], s[1 * 33]); o.y = cvt_pk_bf16(s[2 * 33], s[3 * 33]); o.z = cvt_pk_bf16(s[4 * 33], s[5 * 33]); o.w = cvt_pk_bf16(s[6 * 33], s[7 * 33]);
        int drow = drow0 + n;
        if (mode) { const int ch = drow0 + n; drow = 1024 + 256 * (ch >> 7) + 128 * ((ch >> 4) & 1) + 32 * ((ch >> 5) & 3) + 8 * ((ch >> 2) & 3) + 4 * (mode - 1) + (ch & 3); }
        *(u32x4*)(WT + (size_t)drow * ldt + dk0 + 8 * c) = o; }
    asm volatile("s_waitcnt lgkmcnt(0)" ::: "memory");
}

__device__ __forceinline__ void phase0(const Args& a, LAS unsigned char* lds, int wave, int lane) {
    LAS float* scr = (LAS float*)(lds + wave * 16384);
    const int gw = blockIdx.x * 8 + wave, NGW = gridDim.x * 8;
    bf16_t* win_t = (bf16_t*)(a.ws + WS_WIN); bf16_t* wout_t = (bf16_t*)(a.ws + WS_WOUT); bf16_t* wg = (bf16_t*)(a.ws + WS_WG);
    constexpr int I_IN = 16 * 192, I_OUT = 32 * 32, I_G = 64;
    const float* x = a.in[I_X]; bf16_t* xn = (bf16_t*)(a.ws + WS_XN);
    f32x4 gv[4];
#pragma unroll
    for (int j = 0; j < 4; ++j) gv[j] = ((const f32x4*)a.in[I_LNG])[lane + 64 * j];
    for (int m = gw; m < T_TOK; m += NGW) {
        const f32x4* xr = (const f32x4*)(x + (size_t)m * DM) + lane;
        f32x4 v[4]; float s = 0.f;
#pragma unroll
        for (int j = 0; j < 4; ++j) { v[j] = __builtin_nontemporal_load(xr + 64 * j); s += (v[j].x * v[j].x + v[j].y * v[j].y) + (v[j].z * v[j].z + v[j].w * v[j].w); }
        const float rstd = 1.0f / sqrtf(wave_sum(s) * (1.f / DM) + RMS_EPS);
        u32x2* o8 = (u32x2*)(xn + (size_t)m * DM) + lane;
#pragma unroll
        for (int j = 0; j < 4; ++j) { u32x2 w; w.x = cvt_pk_bf16(v[j].x * rstd * gv[j].x, v[j].y * rstd * gv[j].y); w.y = cvt_pk_bf16(v[j].z * rstd * gv[j].z, v[j].w * rstd * gv[j].w); o8[64 * j] = w; }
    }
    for (int it = gw; it < I_IN + I_OUT + I_G; it += NGW) {
        int r = it;
        if (r < I_IN) { const int kb = r / 192, nb = r % 192; const int og = nb / 32;
            if (og == 1 || og == 2) p0_transpose_item(a.in[I_WIN], NPROJ, kb * 64, nb * 32, win_t, DM, (nb % 32) * 32, kb * 64, scr, lane, og);
            else { const int nbase = (og == 0) ? 0 : (og == 4 ? 3072 : (og == 3 ? 4096 : 5120));
                const int q = nb % 32;
                p0_transpose_item(a.in[I_WIN], NPROJ, kb * 64, nb * 32, win_t, DM, nbase + 256 * (q >> 3) + 128 * (q & 1) + 32 * ((q & 7) >> 1), kb * 64, scr, lane, 0); }
            continue; }
        r -= I_IN;
        if (r < I_OUT) { const int kb = r / 32, nb = r % 32; p0_transpose_item(a.in[I_WOUT], DM, kb * 64, nb * 32, wout_t, DMIX, nb * 32, kb * 64, scr, lane); continue; }
        r -= I_OUT;
        { const int mat = r / 32, h = (r % 32) / 2, nb = r & 1; const float* W = (mat ? a.in[I_WI] : a.in[I_WA]) + h * 4096;
          p0_transpose_item(W, 64, 0, nb * 32, wg + mat * 65536 + h * 4096, 64, nb * 32, 0, scr, lane); }
    }
}

#define DPP_ADD(v, ctrl) ((v) + __uint_as_float(__builtin_amdgcn_update_dpp(0, __float_as_uint(v), (ctrl), 0xF, 0xF, false)))
__device__ __forceinline__ void conv_item(const Args& a, bf16_t* proj, bf16_t* projg, bf16_t* obase, int ostride, int item, int wave, int lane) {
    const int q = lane >> 4, c8 = lane & 15, ch0 = wave * 128 + c8 * 8;
    float w0[8], w1[8], w2[8], gn[8];
    { const float* cw = a.in[I_CONVW] + ch0; const float* cg_ = a.in[I_CG] + ch0;
#pragma unroll
      for (int j = 0; j < 8; ++j) { w0[j] = cw[j]; w1[j] = cw[1024 + j]; w2[j] = cw[2048 + j]; gn[j] = cg_[j]; } }
    const int tok0 = item * (4 * CONV_R) + q * CONV_R;
    bf16_t* base = proj + (size_t)tok0 * LDPA + ch0; const bf16_t* gbase = projg + (size_t)tok0 * LDPG + ch0;
    float p2[8], p1[8];
    if ((tok0 & (SEQ - 1)) == 0) {
#pragma unroll
        for (int j = 0; j < 8; ++j) { p2[j] = 0.f; p1[j] = 0.f; }
    } else {
        const u32x4 c2 = *(const u32x4*)(base - 2 * LDPA + COL_CX), c1 = *(const u32x4*)(base - 1 * LDPA + COL_CX);
        unpack8(c2, p2); unpack8(c1, p1);
    }
    u32x4 nb[2], nc[2], ng[2];
#pragma unroll
    for (int k = 0; k < 2; ++k) { const bf16_t* rp = base + (size_t)k * LDPA; nb[k] = __builtin_nontemporal_load((const u32x4*)(rp + COL_B)); nc[k] = __builtin_nontemporal_load((const u32x4*)(rp + COL_CX)); ng[k] = __builtin_nontemporal_load((const u32x4*)(gbase + (size_t)k * LDPG)); }
    for (int i = 0; i < CONV_R; i += 2) {
        u32x4 vb[2], vc[2], vg[2];
#pragma unroll
        for (int k = 0; k < 2; ++k) { vb[k] = nb[k]; vc[k] = nc[k]; vg[k] = ng[k]; }
        if (i + 2 < CONV_R) {
#pragma unroll
            for (int k = 0; k < 2; ++k) { const bf16_t* rp = base + (size_t)(i + 2 + k) * LDPA; nb[k] = __builtin_nontemporal_load((const u32x4*)(rp + COL_B)); nc[k] = __builtin_nontemporal_load((const u32x4*)(rp + COL_CX)); ng[k] = __builtin_nontemporal_load((const u32x4*)(gbase + (size_t)(i + 2 + k) * LDPG)); }
        }
#pragma unroll
        for (int k = 0; k < 2; ++k) {
            float fb[8], cx[8], fg[8], y[8];
            unpack8(vb[k], fb); unpack8(vc[k], cx); unpack8(vg[k], fg);
            float ss = 0.f;
#pragma unroll
            for (int j = 0; j < 8; ++j) { const float cv = w0[j] * p2[j] + w1[j] * p1[j] + w2[j] * cx[j]; y[j] = fb[j] * cv; ss += y[j] * y[j]; p2[j] = p1[j]; p1[j] = cx[j]; }
            ss = DPP_ADD(ss, 0xB1); ss = DPP_ADD(ss, 0x4E); ss = DPP_ADD(ss, 0x141); ss = DPP_ADD(ss, 0x140);
            const float rstd = __builtin_amdgcn_rsqf(ss * (1.f / 128.f) + RMS_EPS);
            float o[8];
#pragma unroll
            for (int j = 0; j < 8; ++j) o[j] = y[j] * rstd * gn[j] * (fg[j] * sigmoid_fast(fg[j]));
            u32x4 w; w.x = cvt_pk_bf16(o[0], o[1]); w.y = cvt_pk_bf16(o[2], o[3]); w.z = cvt_pk_bf16(o[4], o[5]); w.w = cvt_pk_bf16(o[6], o[7]);
            *(u32x4*)(obase + (size_t)(tok0 + i + k) * ostride + ch0) = w;
        }
    }
}

constexpr int L_GW = 0;
constexpr int L_CW = 18432;
constexpr int L_AGG = 20992;
constexpr int L_WT = 29184;
constexpr int WT_BYTES = 8704;
static_assert(L_WT + 8 * WT_BYTES <= 131072, "lds");
typedef float f32x2 __attribute__((ext_vector_type(2)));

__device__ __forceinline__ void lru_item(const Args& a, bf16_t* proj, bf16_t* projg, bf16_t* obase, int ostride, LAS unsigned char* lds, int chain, int part, int nsplit, int tid, int wave, int lane) {
    const int b = chain >> 4, h = chain & 15;
    {
        const bf16_t* wg = (const bf16_t*)(a.ws + WS_WG);
        for (int i = tid; i < 1024; i += NTHREADS) { const int mat = i >> 9, e = (i >> 3) & 63, c = i & 7;
            const u32x4 v = *(const u32x4*)(wg + mat * 65536 + h * 4096 + e * 64 + c * 8);
            *(LAS u32x4*)(lds + L_GW + mat * 9216 + e * 144 + c * 16) = v; }
        LAS float* cw = (LAS float*)(lds + L_CW);
        if (tid < 256) cw[tid] = a.in[I_LCW][(tid >> 6) * 1024 + h * 64 + (tid & 63)];
        else if (tid < 320) { const int c = tid - 256, gc = h * 64 + c;
            cw[256 + c] = a.in[I_LCB][gc]; cw[320 + c] = a.in[I_BA][gc]; cw[384 + c] = a.in[I_BI][gc];
            const float lam = a.in[I_LAM][gc];
            const float logsig = (lam >= 0.f) ? -log1pf(expf(-lam)) : (lam - log1pf(expf(lam)));
            cw[448 + c] = 8.0f * logsig * 1.44269504f;
            cw[512 + c] = a.in[I_LG][gc]; }
    }
    __syncthreads();
    const int r = lane & 31, hh = lane >> 5;
    LAS unsigned char* wt = lds + L_WT + wave * WT_BYTES;
    LAS const float* cw = (LAS const float*)(lds + L_CW);
    bf16x8 I0, I1;
    {
        u32x4 t0 = (u32x4){0u, 0u, 0u, 0u}, t1 = t0;
        const int j0 = r - 8 * hh, j1 = r - 16 - 8 * hh;
#pragma unroll
        for (int d = 0; d < 4; ++d) {
            t0[d] = (j0 == 2 * d) ? 0x00003F80u : ((j0 == 2 * d + 1) ? 0x3F800000u : 0u);
            t1[d] = (j1 == 2 * d) ? 0x00003F80u : ((j1 == 2 * d + 1) ? 0x3F800000u : 0u);
        }
        I0 = __builtin_bit_cast(bf16x8, t0); I1 = __builtin_bit_cast(bf16x8, t1);
    }
    float ba[2], bi[2], cf[2];
#pragma unroll
    for (int n = 0; n < 2; ++n) { ba[n] = cw[320 + 32 * n + r]; bi[n] = cw[384 + 32 * n + r]; cf[n] = cw[448 + 32 * n + r]; }
    float carry[2] = {0.f, 0.f};
    unsigned* flags = (unsigned*)(a.ws + WS_CTL + 4096) + chain * 32;
    unsigned long long* aggg = (unsigned long long*)(a.ws + WS_AGG) + (size_t)chain * 16 * 64;

    const bf16_t* xl_base = proj + (size_t)b * SEQ * LDPA + COL_XL + h * 64;
    const bf16_t* gl_base = projg + (size_t)b * SEQ * LDPG + 1024 + h * 64;
    u32x4 xr[5];
#define LOAD_X(seg_) do { const int s0_ = (seg_) * 256 + wave * 32; _Pragma("unroll") for (int i = 0; i < 5; ++i) { const int idx = lane + 64 * i, row = idx >> 3, c = idx & 7; const int s = s0_ - 3 + row; \
        xr[i] = (u32x4){0u, 0u, 0u, 0u}; if (idx < 280 && s >= 0) xr[i] = __builtin_nontemporal_load((const u32x4*)(xl_base + (size_t)s * LDPA + c * 8)); } } while (0)
    LOAD_X(part);
    for (int seg = part; seg < 16; seg += nsplit) {
        const int s0 = seg * 256 + wave * 32;
#pragma unroll
        for (int i = 0; i < 5; ++i) { const int idx = lane + 64 * i, row = idx >> 3, c = idx & 7; if (idx < 280) *(LAS u32x4*)(wt + row * 144 + c * 16) = xr[i]; }
        if (seg + nsplit < 16) LOAD_X(seg + nsplit);
        u32x4 gl[4];
#define LOAD_GL() do { _Pragma("unroll") for (int i = 0; i < 4; ++i) { const int tok = (lane >> 3) + 8 * i, c = lane & 7; gl[i] = __builtin_nontemporal_load((const u32x4*)(gl_base + (size_t)(s0 + tok) * LDPG + c * 8)); } } while (0)
#if GL_EARLY
        LOAD_GL();
#endif
        asm volatile("s_waitcnt lgkmcnt(0)" ::: "memory");
        bf16x8 Af[4];
#pragma unroll
        for (int s = 0; s < 4; ++s) {
            const int c0 = 16 * s + 8 * hh;
            float u8[8];
            { const f32x4 b0 = *(LAS const f32x4*)(cw + 256 + c0), b1 = *(LAS const f32x4*)(cw + 256 + c0 + 4);
              u8[0] = b0[0]; u8[1] = b0[1]; u8[2] = b0[2]; u8[3] = b0[3]; u8[4] = b1[0]; u8[5] = b1[1]; u8[6] = b1[2]; u8[7] = b1[3]; }
#pragma unroll
            for (int k = 0; k < 4; ++k) {
                const u32x4 xv = *(LAS const u32x4*)(wt + (r + k) * 144 + c0 * 2);
                const f32x4 wv0 = *(LAS const f32x4*)(cw + k * 64 + c0), wv1 = *(LAS const f32x4*)(cw + k * 64 + c0 + 4);
                float fx[8]; unpack8(xv, fx);
                u8[0] += wv0[0] * fx[0]; u8[1] += wv0[1] * fx[1]; u8[2] += wv0[2] * fx[2]; u8[3] += wv0[3] * fx[3];
                u8[4] += wv1[0] * fx[4]; u8[5] += wv1[1] * fx[5]; u8[6] += wv1[2] * fx[6]; u8[7] += wv1[3] * fx[7];
            }
            u32x4 pk; pk.x = cvt_pk_bf16(u8[0], u8[1]); pk.y = cvt_pk_bf16(u8[2], u8[3]); pk.z = cvt_pk_bf16(u8[4], u8[5]); pk.w = cvt_pk_bf16(u8[6], u8[7]);
            Af[s] = __builtin_bit_cast(bf16x8, pk);
        }
#pragma unroll
        for (int n = 0; n < 2; ++n) {
            float hl[16], pc[16];
            f32x16 accR, accI, accU;
#pragma unroll
            for (int j = 0; j < 16; ++j) { accR[j] = 0.f; accI[j] = 0.f; accU[j] = 0.f; }
#pragma unroll
            for (int s = 0; s < 4; ++s) {
                const bf16x8 Ba = *(LAS const bf16x8*)(lds + L_GW + (32 * n + r) * 144 + (16 * s + 8 * hh) * 2);
                const bf16x8 Bi = *(LAS const bf16x8*)(lds + L_GW + 9216 + (32 * n + r) * 144 + (16 * s + 8 * hh) * 2);
                accR = __builtin_amdgcn_mfma_f32_32x32x16_bf16(Af[s], Ba, accR, 0, 0, 0);
                accI = __builtin_amdgcn_mfma_f32_32x32x16_bf16(Af[s], Bi, accI, 0, 0, 0);
            }
            accU = __builtin_amdgcn_mfma_f32_32x32x16_bf16(Af[2 * n], I0, accU, 0, 0, 0);
            accU = __builtin_amdgcn_mfma_f32_32x32x16_bf16(Af[2 * n + 1], I1, accU, 0, 0, 0);
            float gP[4], gH[4];
#pragma unroll
            for (int g = 0; g < 4; ++g) {
                float P = 1.f, H = 0.f;
#pragma unroll
                for (int i = 0; i < 4; ++i) { const int j = 4 * g + i;
                    const float rr = sigmoid_fast(accR[j] + ba[n]);
                    const float ii = sigmoid_fast(accI[j] + bi[n]);
                    const float l2 = rr * cf[n];
                    const float aa = __builtin_amdgcn_exp2f(l2);
                    const float t = l2 * 1.38629436f;
                    const float em_small = -t * (1.0f + t * (0.5f + t * (0.16666667f + t * 0.041666667f)));
                    const float one_m = (t > -0.0625f) ? em_small : (1.0f - aa * aa);
                    const float dd = __builtin_amdgcn_sqrtf(one_m) * ii * accU[j];
                    H = aa * H + dd; P = P * aa; hl[j] = H; pc[j] = P; }
                gP[g] = P; gH[g] = H;
            }
            float cp = 1.f, ch = 0.f;
#pragma unroll
            for (int g = 0; g < 4; ++g) {
                const auto sp = __builtin_amdgcn_permlane32_swap(__float_as_uint(gP[g]), __float_as_uint(gP[g]), false, false);
                const auto sh = __builtin_amdgcn_permlane32_swap(__float_as_uint(gH[g]), __float_as_uint(gH[g]), false, false);
                const float oP = __uint_as_float(hh ? sp[0] : sp[1]), oH = __uint_as_float(hh ? sh[0] : sh[1]);
                const float P = gP[g], H = gH[g];
                const float A1 = hh ? oP : P, H1 = hh ? oH : H, A2 = hh ? P : oP, H2 = hh ? H : oH;
                const float cp1 = cp * A1, ch1 = A1 * ch + H1;
                const float inP = hh ? cp1 : cp, inH = hh ? ch1 : ch;
#pragma unroll
                for (int i = 0; i < 4; ++i) { const int j = 4 * g + i; hl[j] += pc[j] * inH; pc[j] *= inP; }
                cp = cp1 * A2; ch = A2 * ch1 + H2;
            }
            if (hh == 0) *(LAS f32x2*)(lds + L_AGG + ((n * 8 + wave) * 64 + 32 * n + r) * 8) = (f32x2){cp, ch};
#if !GL_EARLY
            if (n == 1) LOAD_GL();
#endif
            if (nsplit > 1 && seg > 0 && wave == 0) {
                unsigned spins = 0;
                while (__builtin_amdgcn_readfirstlane(__hip_atomic_load(flags + (seg - 1) * 2 + n, __ATOMIC_RELAXED, __HIP_MEMORY_SCOPE_AGENT)) == 0u) { __builtin_amdgcn_s_sleep(2); if (++spins > (1u << 22)) break; }
                asm volatile("" ::: "memory");
            }
            __syncthreads();
            float c = carry[n];
            if (nsplit > 1 && seg > 0) {
                const unsigned long long pw = __hip_atomic_load(aggg + (size_t)(seg - 1) * 64 + n * 32 + r, __ATOMIC_RELAXED, __HIP_MEMORY_SCOPE_AGENT);
                c = __uint_as_float((unsigned)pw) * c + __uint_as_float((unsigned)(pw >> 32));
            }
            float cin = 0.f, iP = 1.f, iH = 0.f;
#pragma unroll
            for (int w = 0; w < 8; ++w) {
                const f32x2 ag = *(LAS const f32x2*)(lds + L_AGG + ((n * 8 + w) * 64 + 32 * n + r) * 8);
                cin = (w == wave) ? c : cin; c = ag.x * c + ag.y; iH = ag.x * iH + ag.y; iP *= ag.x; }
            carry[n] = c;
            if (nsplit > 1 && wave == 0) {
                if (hh == 0) __hip_atomic_store(aggg + (size_t)seg * 64 + n * 32 + r, ((unsigned long long)__float_as_uint(iH) << 32) | __float_as_uint(iP), __ATOMIC_RELAXED, __HIP_MEMORY_SCOPE_AGENT);
                asm volatile("s_waitcnt vmcnt(0)" ::: "memory");
                if (lane == 0) __hip_atomic_store(flags + seg * 2 + n, 1u, __ATOMIC_RELAXED, __HIP_MEMORY_SCOPE_AGENT);
            }
#pragma unroll
            for (int j = 0; j < 16; ++j) { const int row = (j & 3) + 8 * (j >> 2) + 4 * hh;
                *(LAS float*)(wt + row * 272 + (32 * n + r) * 4) = hl[j] + pc[j] * cin; }
        }
        asm volatile("s_waitcnt lgkmcnt(0)" ::: "memory");
#pragma unroll
        for (int i = 0; i < 4; ++i) {
            const int tok = (lane >> 3) + 8 * i, c = lane & 7;
            const f32x4 h0 = *(LAS const f32x4*)(wt + tok * 272 + c * 32), h1 = *(LAS const f32x4*)(wt + tok * 272 + c * 32 + 16);
            const f32x4 g0 = *(LAS const f32x4*)(cw + 512 + c * 8), g1 = *(LAS const f32x4*)(cw + 512 + c * 8 + 4);
            float ss = (h0[0] * h0[0] + h0[1] * h0[1]) + (h0[2] * h0[2] + h0[3] * h0[3]) + (h1[0] * h1[0] + h1[1] * h1[1]) + (h1[2] * h1[2] + h1[3] * h1[3]);
            ss = DPP_ADD(ss, 0xB1); ss = DPP_ADD(ss, 0x4E); ss = DPP_ADD(ss, 0x141);
            const float rstd = __builtin_amdgcn_rsqf(ss * (1.f / 64.f) + RMS_EPS);
            float fg[8]; unpack8(gl[i], fg);
            float o[8];
            o[0] = h0[0] * rstd * g0[0]; o[1] = h0[1] * rstd * g0[1]; o[2] = h0[2] * rstd * g0[2]; o[3] = h0[3] * rstd * g0[3];
            o[4] = h1[0] * rstd * g1[0]; o[5] = h1[1] * rstd * g1[1]; o[6] = h1[2] * rstd * g1[2]; o[7] = h1[3] * rstd * g1[3];
#pragma unroll
            for (int j = 0; j < 8; ++j) o[j] *= fg[j] * sigmoid_fast(fg[j]);
            u32x4 w; w.x = cvt_pk_bf16(o[0], o[1]); w.y = cvt_pk_bf16(o[2], o[3]); w.z = cvt_pk_bf16(o[4], o[5]); w.w = cvt_pk_bf16(o[6], o[7]);
            *(u32x4*)(obase + (size_t)(b * SEQ + s0 + tok) * ostride + h * 64 + c * 8) = w;
        }
        asm volatile("s_waitcnt lgkmcnt(0)" ::: "memory");
    }
#undef LOAD_X
    __syncthreads();
}

__global__ void __launch_bounds__(NTHREADS, 2) hymba_fwd(Args a) {
    extern __shared__ __attribute__((aligned(16))) unsigned char lds_raw[];
    LAS unsigned char* lds = (LAS unsigned char*)lds_raw;
    cg::grid_group grid = cg::this_grid();
    if (gridDim.y == 0x7fffu) grid.sync();
    volatile LAS unsigned* bst = (volatile LAS unsigned*)(lds + LDS_CTL + 64);
    if (threadIdx.x == 0) { bst[0] = 0u; bst[1] = 0u; }
    __syncthreads();
    const XcdBarrier bar = xcd_barrier_post((unsigned*)(a.ws + WS_CTL + 32768), bst);
    const int tid = threadIdx.x, lane = tid & 63, wave = __builtin_amdgcn_readfirstlane(tid >> 6);
    bf16_t* proj = (bf16_t*)(a.ws + WS_PROJ); bf16_t* projg = (bf16_t*)(a.ws + WS_PROJG);

#pragma unroll
    for (int rep = 0; rep < REP0; ++rep) {
#ifndef SKIP_P0
    phase0(a, lds, wave, lane);
#endif

    xcd_barrier(bar); }
#pragma unroll
    for (int rep = 0; rep < REP1; ++rep) {
        pg8::Gemm g{(const bf16_t*)(a.ws + WS_XN), (const bf16_t*)(a.ws + WS_WIN), T_TOK, NPROJ, DM, DM, SKEW1};
        pg8::StaticOrder S; S.init(T_TOK, NPROJ, (int)gridDim.x, (int)blockIdx.x);
        pg8::EpiBf16 E{proj, LDPA, projg, LDPG, lds + LDS_EST + wave * 2048};
#ifndef SKIP_G1
        pg8::gemm_phase<pg8::EpiBf16>(lds, g, S, E);
#endif
    xcd_barrier(bar); }
    {
#ifndef SKIP_LRU
        if (gridDim.x >= 256) { if (blockIdx.x < 256) lru_item(a, proj, projg, projg + 1024, LDPG, lds, (int)blockIdx.x >> 1, (int)blockIdx.x & 1, 2, tid, wave, lane); }
        else for (int it = blockIdx.x; it < 128; it += gridDim.x) lru_item(a, proj, projg, projg + 1024, LDPG, lds, it, 0, 1, tid, wave, lane);
#endif
        LAS unsigned* qs = (LAS unsigned*)(lds + LDS_CTL);
        unsigned* qctr = (unsigned*)(a.ws + WS_CTL);
        for (;;) {
            if (tid == 0) qs[0] = atomicAdd(qctr, 1u);
            __syncthreads();
            const unsigned it = qs[0];
            __syncthreads();
            if (it >= (unsigned)(T_TOK / (4 * CONV_R))) break;
#ifndef SKIP_CONV
            conv_item(a, proj, projg, projg, LDPG, (int)it, wave, lane);
#endif
        }
    }
    xcd_barrier(bar);
#pragma unroll
    for (int rep = 0; rep < REP3; ++rep) {
        pg8::Gemm g{projg, (const bf16_t*)(a.ws + WS_WOUT), T_TOK, DM, DMIX, LDPG, SKEW3};
        pg8::StaticOrder S; S.init(T_TOK, DM, (int)gridDim.x, (int)blockIdx.x);
        pg8::EpiResidNorm E{a.in[I_X], a.out, (unsigned*)(a.ws + WS_SS), (unsigned*)(a.ws + WS_CTL + 65536), a.in[I_FG], lds + LDS_EST + wave * 2048};
#ifndef SKIP_G2
        pg8::gemm_phase<pg8::EpiResidNorm>(lds, g, S, E);
#endif
    }
}

extern "C" void kernel_launch(void* const* d_in, const int* in_sizes, int n_in, void* d_out, int out_size, void* d_ws, size_t ws_size, hipStream_t stream) {
    static int grid = 0;
    if (grid == 0) {
        if (n_in != 15 || out_size != T_TOK * DM || ws_size < WS_END) { fprintf(stderr, "kernel_launch: unexpected shapes (n_in %d out %d ws %zu)\n", n_in, out_size, ws_size); grid = -1; return; }
        int dev = 0, cus = 0, per_cu = 0;
        hipGetDevice(&dev);
        hipDeviceGetAttribute(&cus, hipDeviceAttributeMultiprocessorCount, dev);
        if (hipFuncSetAttribute((const void*)hymba_fwd, hipFuncAttributeMaxDynamicSharedMemorySize, LDS_BYTES) != hipSuccess) { fprintf(stderr, "kernel_launch: hipFuncSetAttribute failed\n"); grid = -1; return; }
        if (hipOccupancyMaxActiveBlocksPerMultiprocessor(&per_cu, (const void*)hymba_fwd, NTHREADS, LDS_BYTES) != hipSuccess || per_cu < 1) { fprintf(stderr, "kernel_launch: occupancy query says %d\n", per_cu); per_cu = 1; }
        (void)hipGetLastError();
        grid = cus;
        if (grid != 256) { fprintf(stderr, "kernel_launch: built for a 256-CU device (got %d)\n", cus); grid = -1; return; }
    }
    if (grid < 0) return;
    hipMemsetAsync((char*)d_ws + WS_CTL, 0, CTL_BYTES, stream);
    Args a{};
    for (int i = 0; i < 15; ++i) a.in[i] = (const float*)d_in[i];
    a.out = (float*)d_out; a.ws = (unsigned char*)d_ws;
    void* args[] = {&a};
    hipError_t e = hipLaunchCooperativeKernel((const void*)hymba_fwd, dim3(grid), dim3(NTHREADS), args, LDS_BYTES, stream);
    if (e != hipSuccess) fprintf(stderr, "kernel_launch: cooperative launch failed: %s (grid %d)\n", hipGetErrorString(e), grid);
}
```
